# Optimizing an MI355X kernel written in HIP

```python
import math
import jax, jax.numpy as jnp
from jax import lax
import numpy as np

D_MODEL = 1024
BATCH = 32
SEQ = 2048
DEPTH = 2

N_A_LAYERS = (DEPTH + 1) // 2
N_B_LAYERS = DEPTH - N_A_LAYERS
HEAD_DIM = 64
N_HEADS = D_MODEL // HEAD_DIM
N_KV = 4
GQA_R = N_HEADS // N_KV
KV_DIM = N_KV * HEAD_DIM
NUM_BUCKETS = 32
MAX_DISTANCE = 2048
CMP_BLOCK = 32
CMP_STRIDE = 16
CMP_HIDDEN = 256
SEL_BLOCK = 64
SEL_TOPN = 8
SEL_Q_CHUNK = 16
FORCE_BONUS = 100.0
WIN = 256
BAND_BLOCK = 128
DILATIONS = ((128, 1), (512, 4), (2048, 16))
N_DIL = len(DILATIONS)
FFN_HIDDEN = -(-8 * D_MODEL // (3 * 256)) * 256
RMS_EPS = 1e-6
NEG_INF = -1e30
A_IN_DIM = D_MODEL + 6 * KV_DIM + 3 * N_HEADS
B_Q_DIM = N_DIL * D_MODEL
SHARED_KV_DIM = N_DIL * 2 * KV_DIM

kernel_name = "yoco_nsa_dilated_hybrid"


def rmsnorm(x, g):
    x32 = x.astype(jnp.float32)
    y = x32 * lax.rsqrt(jnp.mean(x32 * x32, axis=-1, keepdims=True) + RMS_EPS)
    return (y * g.astype(jnp.float32)).astype(x.dtype)


def t5_bucket(dist):
    max_exact = NUM_BUCKETS // 2
    d = jnp.maximum(dist, 0)
    log_ratio = jnp.log(jnp.maximum(d, max_exact).astype(jnp.float32) / max_exact) / math.log(MAX_DISTANCE / max_exact)
    large = max_exact + (log_ratio * (NUM_BUCKETS - max_exact)).astype(jnp.int32)
    return jnp.where(d < max_exact, d, jnp.minimum(large, NUM_BUCKETS - 1))


def masked_softmax(s, mask):
    s = jnp.where(mask, s.astype(jnp.float32), NEG_INF)
    m = jnp.max(s, axis=-1, keepdims=True)
    p = jnp.where(mask, jnp.exp(s - m), 0.0)
    return p, jnp.sum(p, axis=-1, keepdims=True), m


def banded_attention(q, k, v, max_dist, dist_scale, rel_bias):
    n, L, G, R, dh = q.shape
    nb = L // BAND_BLOCK
    n_prev = -(-max_dist // BAND_BLOCK)
    pad = n_prev * BAND_BLOCK
    kw_len = (n_prev + 1) * BAND_BLOCK

    def windows(t):
        tp = jnp.pad(t, ((0, 0), (pad, 0), (0, 0), (0, 0))).reshape(n, nb + n_prev, BAND_BLOCK, G, dh)
        return jnp.concatenate([tp[:, j:j + nb] for j in range(n_prev + 1)], axis=2)

    kw, vw = windows(k), windows(v)
    qb = q.reshape(n, nb, BAND_BLOCK, G, R, dh)
    s = jnp.einsum('nbqgrd,nbkgd->nbgrqk', qb, kw).astype(jnp.float32) * dh ** -0.5
    qi = jnp.arange(BAND_BLOCK)[:, None]
    ki = jnp.arange(kw_len)[None, :]
    dist = pad + qi - ki
    key_pos = jnp.arange(nb)[:, None, None] * BAND_BLOCK - pad + ki[None]
    mask = (dist >= 0) & (dist <= max_dist) & (key_pos >= 0)
    bias = rel_bias[t5_bucket(dist * dist_scale)].reshape(BAND_BLOCK, kw_len, G, R).transpose(2, 3, 0, 1)
    p, denom, m = masked_softmax(s + bias, mask[None, :, None, None])
    o = jnp.einsum('nbgrqk,nbkgd->nbqgrd', p, vw.astype(jnp.float32))
    o = o / denom[..., 0].transpose(0, 1, 4, 2, 3)[..., None]
    lse = (jnp.log(denom) + m)[..., 0].transpose(0, 1, 4, 2, 3).reshape(n, L, G, R)
    return o.reshape(n, L, G, R, dh), lse


def dilated_group_attention(q, k, v, dilation, window, rel_bias):
    B, S = q.shape[:2]
    L = S // dilation
    Lp = -(-L // BAND_BLOCK) * BAND_BLOCK

    def to_sub(t):
        rest = t.shape[2:]
        t = t.reshape((B, L, dilation) + rest)
        t = jnp.moveaxis(t, 2, 1).reshape((B * dilation, L) + rest)
        return jnp.pad(t, ((0, 0), (0, Lp - L)) + ((0, 0),) * len(rest))

    def from_sub(t):
        rest = t.shape[2:]
        t = t[:, :L].reshape((B, dilation, L) + rest)
        return jnp.moveaxis(t, 1, 2).reshape((B, S) + rest)

    o, lse = banded_attention(to_sub(q), to_sub(k), to_sub(v), window // dilation, dilation, rel_bias)
    return from_sub(o), from_sub(lse)


def nsa_attention(h, w_in, b_gate, pe_k, w1_k, w2_k, pe_v, w1_v, w2_v, w_out, rel_bias):
    B, S, _ = h.shape
    proj = h @ w_in
    splits = [D_MODEL + i * KV_DIM for i in range(7)]
    q, kc, vc, ks, vs, kwn, vwn, gl = jnp.split(proj, splits, axis=-1)
    q = q.reshape(B, S, N_KV, GQA_R, HEAD_DIM)
    kvh = lambda t: t.reshape(B, S, N_KV, HEAD_DIM)
    scale = HEAD_DIM ** -0.5
    t_pos = jnp.arange(S)

    n_c = (S - CMP_BLOCK) // CMP_STRIDE + 1
    starts = jnp.arange(n_c) * CMP_STRIDE
    tok_idx = starts[:, None] + jnp.arange(CMP_BLOCK)[None, :]

    def compress(t, pe, w1, w2):
        blk = t[:, tok_idx] + pe[:, None, :]
        blk = jnp.moveaxis(blk, 3, 2).reshape(B, n_c, N_KV, CMP_BLOCK * HEAD_DIM)
        return jax.nn.gelu(blk @ w1) @ w2

    k_cmp = compress(kvh(kc), pe_k, w1_k, w2_k)
    v_cmp = compress(kvh(vc), pe_v, w1_v, w2_v)
    dist_c = t_pos[:, None] - (starts + CMP_BLOCK - 1)[None, :]
    bias_c = rel_bias[t5_bucket(dist_c)].reshape(S, n_c, N_KV, GQA_R).transpose(2, 3, 0, 1)
    s = jnp.einsum('bsgrd,bngd->bgrsn', q, k_cmp).astype(jnp.float32) * scale
    p, denom, _ = masked_softmax(s + bias_c, dist_c >= 0)
    p_cmp = p / jnp.maximum(denom, 1e-30)
    o_cmp = jnp.einsum('bgrsn,bngd->bsgrd', p_cmp, v_cmp.astype(jnp.float32))

    n_sel = S // SEL_BLOCK
    top_n = min(SEL_TOPN, n_sel)
    ci = jnp.arange(n_c)[:, None] * CMP_STRIDE
    sj = jnp.arange(n_sel)[None, :] * SEL_BLOCK
    overlap = ((ci < sj + SEL_BLOCK) & (ci + CMP_BLOCK > sj)).astype(jnp.float32)
    imp = jnp.einsum('bgrsn,nj->bgsj', p_cmp, overlap)
    blk_j = jnp.arange(n_sel)[None, :]
    cur = (t_pos // SEL_BLOCK)[:, None]
    forced = (blk_j == 0) | (blk_j == cur) | (blk_j == cur - 1)
    score = jnp.where(forced, imp + FORCE_BONUS, jnp.where(blk_j <= cur, imp, -1.0))
    _, sel_idx = lax.top_k(score, top_n)

    k_blocks = kvh(ks).reshape(B, n_sel, SEL_BLOCK, N_KV, HEAD_DIM).transpose(0, 3, 1, 2, 4)
    v_blocks = kvh(vs).reshape(B, n_sel, SEL_BLOCK, N_KV, HEAD_DIM).transpose(0, 3, 1, 2, 4)
    n_chunk = S // SEL_Q_CHUNK
    q_ch = jnp.moveaxis(q.reshape(B, n_chunk, SEL_Q_CHUNK, N_KV, GQA_R, HEAD_DIM), 1, 0)
    idx_ch = jnp.moveaxis(sel_idx.reshape(B, N_KV, n_chunk, SEL_Q_CHUNK, top_n), 2, 0)
    c0 = jnp.arange(n_chunk) * SEL_Q_CHUNK
    b_ix = jnp.arange(B)[:, None, None, None]
    g_ix = jnp.arange(N_KV)[None, :, None, None]
    rb_g = rel_bias.reshape(NUM_BUCKETS, N_KV, GQA_R).transpose(1, 0, 2)
    n_keys = top_n * SEL_BLOCK

    def sel_chunk(args):
        qc, ic, start = args
        kg = k_blocks[b_ix, g_ix, ic].reshape(B, N_KV, SEL_Q_CHUNK, n_keys, HEAD_DIM)
        vg = v_blocks[b_ix, g_ix, ic].reshape(B, N_KV, SEL_Q_CHUNK, n_keys, HEAD_DIM)
        kpos = (ic[..., None] * SEL_BLOCK + jnp.arange(SEL_BLOCK)).reshape(B, N_KV, SEL_Q_CHUNK, n_keys)
        dist = (start + jnp.arange(SEL_Q_CHUNK))[:, None] - kpos
        bias = jnp.moveaxis(rb_g[g_ix, t5_bucket(dist)], -1, 3)
        s_sel = jnp.einsum('bcgrd,bgckd->bgcrk', qc, kg).astype(jnp.float32) * scale + bias
        p_sel, den, _ = masked_softmax(s_sel, (dist >= 0)[:, :, :, None, :])
        return jnp.einsum('bgcrk,bgckd->bcgrd', p_sel / jnp.maximum(den, 1e-30), vg.astype(jnp.float32))

    o_sel = jnp.moveaxis(lax.map(sel_chunk, (q_ch, idx_ch, c0)), 0, 1).reshape(B, S, N_KV, GQA_R, HEAD_DIM)

    o_win, _ = banded_attention(q, kvh(kwn), kvh(vwn), WIN - 1, 1, rel_bias)

    g = jax.nn.sigmoid((gl + b_gate).astype(jnp.float32)).reshape(B, S, N_KV, GQA_R, 3)
    o = g[..., 0:1] * o_cmp + g[..., 1:2] * o_sel + g[..., 2:3] * o_win
    return o.reshape(B, S, D_MODEL).astype(h.dtype) @ w_out


def dilated_attention(h, w_q, k_shared, v_shared, w_out, rel_bias):
    B, S, _ = h.shape
    q = (h @ w_q).reshape(B, S, N_DIL, N_KV, GQA_R, HEAD_DIM)
    outs, lses = [], []
    for gi, (window, dilation) in enumerate(DILATIONS):
        o, lse = dilated_group_attention(q[:, :, gi], k_shared[:, :, gi], v_shared[:, :, gi], dilation, window, rel_bias)
        outs.append(o)
        lses.append(lse)
    alpha = jax.nn.softmax(jnp.stack(lses, axis=-1), axis=-1)
    o = jnp.einsum('bsgrdi,bsgri->bsgrd', jnp.stack(outs, axis=-1), alpha)
    return o.reshape(B, S, D_MODEL).astype(h.dtype) @ w_out


def swiglu(h, w_up, w_down):
    a, b = jnp.split(h @ w_up, 2, axis=-1)
    return (jax.nn.silu(a) * b) @ w_down


def setup_inputs(seed: int = 0) -> dict:
    key = jax.random.key(seed)
    ks = jax.random.split(key, 20)
    f32 = jnp.float32
    nrm = lambda k, shape, s: s * jax.random.normal(k, shape, f32)
    w = lambda k, shape, fan_in: jax.random.normal(k, shape, f32) * fan_in ** -0.5
    gain = lambda k, shape: 1.0 + 0.05 * jax.random.normal(k, shape, f32)
    cmp_in = CMP_BLOCK * HEAD_DIM
    return {
        "x": jax.random.normal(ks[0], (BATCH, SEQ, D_MODEL), f32),
        "rel_bias": nrm(ks[1], (NUM_BUCKETS, N_HEADS), 0.5),
        "norm_mix": gain(ks[2], (DEPTH, D_MODEL)),
        "norm_ffn": gain(ks[3], (DEPTH, D_MODEL)),
        "a_w_in": w(ks[4], (N_A_LAYERS, D_MODEL, A_IN_DIM), D_MODEL),
        "a_b_gate": nrm(ks[5], (N_A_LAYERS, 3 * N_HEADS), 0.1),
        "a_pe_k": nrm(ks[6], (N_A_LAYERS, CMP_BLOCK, HEAD_DIM), 0.1),
        "a_w1_k": w(ks[7], (N_A_LAYERS, cmp_in, CMP_HIDDEN), cmp_in),
        "a_w2_k": w(ks[8], (N_A_LAYERS, CMP_HIDDEN, HEAD_DIM), CMP_HIDDEN),
        "a_pe_v": nrm(ks[9], (N_A_LAYERS, CMP_BLOCK, HEAD_DIM), 0.1),
        "a_w1_v": w(ks[10], (N_A_LAYERS, cmp_in, CMP_HIDDEN), cmp_in),
        "a_w2_v": w(ks[11], (N_A_LAYERS, CMP_HIDDEN, HEAD_DIM), CMP_HIDDEN),
        "a_w_out": w(ks[12], (N_A_LAYERS, D_MODEL, D_MODEL), D_MODEL),
        "kv_norm": gain(ks[13], (D_MODEL,)),
        "kv_w": w(ks[14], (D_MODEL, SHARED_KV_DIM), D_MODEL),
        "b_w_q": w(ks[15], (N_B_LAYERS, D_MODEL, B_Q_DIM), D_MODEL),
        "b_w_out": w(ks[16], (N_B_LAYERS, D_MODEL, D_MODEL), D_MODEL),
        "ffn_w_up": w(ks[17], (DEPTH, D_MODEL, 2 * FFN_HIDDEN), D_MODEL),
        "ffn_w_down": w(ks[18], (DEPTH, FFN_HIDDEN, D_MODEL), FFN_HIDDEN),
        "final_norm": gain(ks[19], (D_MODEL,)),
    }


def reference(x, rel_bias, norm_mix, norm_ffn, a_w_in, a_b_gate, a_pe_k, a_w1_k, a_w2_k, a_pe_v, a_w1_v, a_w2_v,
              a_w_out, kv_norm, kv_w, b_w_q, b_w_out, ffn_w_up, ffn_w_down, final_norm):
    B, S, _ = x.shape
    k_shared = v_shared = None
    for layer in range(DEPTH):
        h = rmsnorm(x, norm_mix[layer])
        if layer < N_A_LAYERS:
            i = layer
            mix = nsa_attention(h, a_w_in[i], a_b_gate[i], a_pe_k[i], a_w1_k[i], a_w2_k[i],
                                a_pe_v[i], a_w1_v[i], a_w2_v[i], a_w_out[i], rel_bias)
        else:
            if layer == N_A_LAYERS:
                kv = (rmsnorm(x, kv_norm) @ kv_w).reshape(B, S, N_DIL, 2, N_KV, HEAD_DIM)
                k_shared, v_shared = kv[:, :, :, 0], kv[:, :, :, 1]
            j = layer - N_A_LAYERS
            mix = dilated_attention(h, b_w_q[j], k_shared, v_shared, b_w_out[j], rel_bias)
        x = x + mix.astype(x.dtype)
        x = x + swiglu(rmsnorm(x, norm_ffn[layer]), ffn_w_up[layer], ffn_w_down[layer]).astype(x.dtype)
    return rmsnorm(x, final_norm)
```

```cpp
#include <hip/hip_runtime.h>
#include <hip/hip_cooperative_groups.h>
#include <cstdio>
namespace cg = cooperative_groups;

#define LAS __attribute__((address_space(3)))
typedef unsigned short bf16_t;
typedef short bf16x8 __attribute__((ext_vector_type(8)));
typedef float f32x4 __attribute__((ext_vector_type(4)));
typedef float f32x16 __attribute__((ext_vector_type(16)));
typedef unsigned u32x4 __attribute__((ext_vector_type(4)));
typedef unsigned u32x2 __attribute__((ext_vector_type(2)));
typedef unsigned long long u64;

constexpr int T_TOK = 65536, DM = 1024, SEQ = 2048, FFH = 2816;
constexpr size_t MiB = 1ull << 20;
constexpr size_t OFF_WIN = 0, OFF_WOUTA = 6 * MiB, OFF_WUP0 = 8 * MiB, OFF_WUP1 = 19 * MiB, OFF_WDN0 = 30 * MiB, OFF_WDN1 = 36 * MiB,
                 OFF_WQKVB = 42 * MiB, OFF_WOUTB = 51 * MiB, OFF_W1 = 53 * MiB  , OFF_W2 = 55 * MiB  ,
                 OFF_BIASP = 55 * MiB + 128 * 1024, OFF_KCMP = 56 * MiB, OFF_VCMPT = 58 * MiB, OFF_GATE = 60 * MiB, OFF_H = 72 * MiB,
                 OFF_O = 200 * MiB, OFF_BIG = 328 * MiB, WS_NEED = 1024 * MiB;
constexpr size_t OFF_QA = OFF_BIG, OFF_BRA = OFF_BIG + 128 * MiB  , OFF_ACT = OFF_BIG,
                 OFF_QB = OFF_BIG, OFF_KVB = OFF_BIG + 384 * MiB  , OFF_G1 = OFF_O;
constexpr int LDS_STAGE = 131072, LDS_LUT = LDS_STAGE, LDS_BIAS = LDS_STAGE + 2048, LDS_TOTAL = LDS_STAGE + 2048 + 2048;
constexpr float LOG2E = 1.4426950408889634f;
constexpr float SC2 = 0.125f * LOG2E;

struct Params { const float* in[20]; float* out; unsigned char* ws; };

__device__ __forceinline__ unsigned cvt_pk_bf16(float lo, float hi) { unsigned r; asm volatile("v_cvt_pk_bf16_f32 %0, %1, %2" : "=v"(r) : "v"(lo), "v"(hi)); return r; }
__device__ __forceinline__ bf16_t f2bf(float f) { return (bf16_t)(cvt_pk_bf16(f, 0.f) & 0xffffu); }
__device__ __forceinline__ u32x4 pack8(f32x4 a, f32x4 b) { u32x4 o; o.x = cvt_pk_bf16(a[0], a[1]); o.y = cvt_pk_bf16(a[2], a[3]); o.z = cvt_pk_bf16(b[0], b[1]); o.w = cvt_pk_bf16(b[2], b[3]); return o; }
__device__ __forceinline__ float fexp2(float x) { return __builtin_amdgcn_exp2f(x); }
__device__ __forceinline__ float frcp(float x) { return __builtin_amdgcn_rcpf(x); }
__device__ __forceinline__ float sigmoidf_(float x) { return frcp(1.f + fexp2(-x * LOG2E)); }
__device__ __forceinline__ float wave_sum(float v) {
#pragma unroll
    for (int o = 1; o < 64; o <<= 1) v += __shfl_xor(v, o);
    return v;
}
__device__ __forceinline__ f32x16 mfma32(bf16x8 a, bf16x8 b, f32x16 c) { return __builtin_amdgcn_mfma_f32_32x32x16_bf16(a, b, c, 0, 0, 0); }
#define LDS_WAIT() asm volatile("s_waitcnt lgkmcnt(0)" ::: "memory")

namespace pg8 {
constexpr int BM = 256, BK = 64, HALF = 128, HTB = HALF * BK * 2, NXCD = 8, WGM = 8;
__device__ __forceinline__ int lds_byte(int r, int c) { const int st = (r >> 4) * 2 + (c >> 5), rr = r & 15, cc = c & 31, ob = rr * 64 + cc * 2; return st * 1024 + (ob ^ (((ob >> 9) & 1) << 5)); }
__device__ __forceinline__ void stage_rc(int b, int& R, int& C) { const int st = b / 1024, sb = b % 1024, swz = sb ^ (((sb >> 9) & 1) << 5); R = (st >> 1) * 16 + swz / 64; C = (st & 1) * 32 + (swz % 64) / 2; }
__device__ __forceinline__ int perm32(int rho) { const int n = rho >> 4, i = rho & 15; return 8 * (i >> 2) + 4 * n + (i & 3); }
struct Unit { int pm, pn; };
struct Gemm { const char* A; const char* Bt; int K; int lda; int amode; size_t a_pn_step; };
struct StaticOrder {
    int nM, nN, nwg, G, c;
    __device__ void init(int nM_, int nN_, int G_, int c_) { nM = nM_; nN = nN_; nwg = nM * nN; G = G_; c = c_; }
    __device__ bool next(int i, Unit& u) const {
        const long L = (long)i * G + c; if (L >= nwg) return false;
        int wgid = (int)L; { const int q = nwg / NXCD, r = nwg % NXCD, xcd = wgid % NXCD, off = wgid / NXCD; wgid = (xcd < r ? xcd * (q + 1) : r * (q + 1) + (xcd - r) * q) + off; }
        const int nig = WGM * nN, gid = wgid / nig, fm = gid * WGM, gsz = (nM - fm) < WGM ? (nM - fm) : WGM;
        u.pm = fm + ((wgid % nig) % gsz); u.pn = (wgid % nig) / gsz; return true;
    }
};

template <class Epi>
__device__ __forceinline__ void gemm_phase(LAS unsigned char* lds, const Gemm g, const StaticOrder& S, const Epi& E) {
    const int tid = threadIdx.x, wid = __builtin_amdgcn_readfirstlane(tid >> 6), lane = tid & 63, wr = wid >> 2, wc = wid & 3, fr = lane & 15, fq = lane >> 4;
    const int K = g.K, nt = K / BK;
    unsigned voffA[2], voffB[2];
#pragma unroll
    for (int i = 0; i < 2; ++i) { int R, C; stage_rc(tid * 16 + i * 8192, R, C); const int Rb = (R & ~31) + perm32(R & 31);
        voffA[i] = g.amode ? (unsigned)((R >> 2) * 8192 + (R & 3) * 128 + C * 2) : (unsigned)(R * g.lda + C) * 2u;
        voffB[i] = (unsigned)(Rb * K + C) * 2u; }
    const size_t kstepA = g.amode ? 512 : (size_t)(BK * 2), kstepB = (size_t)(BK * 2);
    const size_t hstepA = g.amode ? (size_t)262144 : (size_t)HALF * g.lda * 2, hstepB = (size_t)HALF * K * 2;
    const size_t tstepA = 2 * hstepA, tstepB = 2 * hstepB;
    const unsigned ldsw = (unsigned)wid * 1024u;
    const int aoff = lds_byte(wr * 64 + fr, fq * 8), boff = lds_byte(wc * 32 + fr, fq * 8);
#define PG8_SA(b, h) (((b) * 2 + (h)) * HTB)
#define PG8_SB(b, h) ((4 + (b) * 2 + (h)) * HTB)
#define PG8_STAGE(bufoff, gbase, voff) do { _Pragma("unroll") for (int _i = 0; _i < 2; ++_i) \
        __builtin_amdgcn_global_load_lds((const unsigned*)((const char*)(gbase) + (voff)[_i]), (LAS unsigned*)(lds + (bufoff) + ldsw + _i * 8192), 16, 0, 0); } while (0)
#define PG8_LDA(dst, b, h) do { _Pragma("unroll") for (int m = 0; m < 4; ++m) _Pragma("unroll") for (int k = 0; k < 2; ++k) dst[m][k] = *(const LAS bf16x8*)(lds + PG8_SA(b, h) + aoff + m * 2048 + k * 1024); } while (0)
#define PG8_LDB(dst, b, h) do { _Pragma("unroll") for (int n = 0; n < 2; ++n) _Pragma("unroll") for (int k = 0; k < 2; ++k) dst[n][k] = *(const LAS bf16x8*)(lds + PG8_SB(b, h) + boff + n * 2048 + k * 1024); } while (0)
#define PG8_MMA(ai, bj, At, Bt) do { __builtin_amdgcn_s_setprio(1); _Pragma("unroll") for (int m = 0; m < 4; ++m) _Pragma("unroll") for (int n = 0; n < 2; ++n) _Pragma("unroll") for (int k = 0; k < 2; ++k) \
        acc[ai][bj][m][n] = __builtin_amdgcn_mfma_f32_16x16x32_bf16(Bt[n][k], At[m][k], acc[ai][bj][m][n], 0, 0, 0); __builtin_amdgcn_s_setprio(0); } while (0)
#define PG8_WAIT_V(n) asm volatile("s_waitcnt vmcnt(" #n ")" ::: "memory")
#define PG8_WAIT_L(n) asm volatile("s_waitcnt lgkmcnt(" #n ")" ::: "memory")
#define PG8_BAR __builtin_amdgcn_s_barrier()
#define PG8_SCHED __builtin_amdgcn_sched_barrier(0)
    Unit cur, nxt; int ui = 0;
    if (!S.next(0, cur)) return;
    f32x4 acc[2][2][4][2];
#pragma unroll
    for (int a = 0; a < 2; ++a)
#pragma unroll
        for (int b = 0; b < 2; ++b)
#pragma unroll
            for (int m = 0; m < 4; ++m)
#pragma unroll
                for (int n = 0; n < 2; ++n) acc[a][b][m][n] = (f32x4){0.f, 0.f, 0.f, 0.f};
    bf16x8 At[4][2], B0[2][2], B1[2][2];
    const char* cA = g.A + (size_t)cur.pm * tstepA + (size_t)cur.pn * g.a_pn_step; const char* cB = g.Bt + (size_t)cur.pn * tstepB;
    PG8_STAGE(PG8_SB(0, 0), cB, voffB); PG8_STAGE(PG8_SA(0, 0), cA, voffA); PG8_STAGE(PG8_SB(0, 1), cB + hstepB, voffB); PG8_STAGE(PG8_SA(0, 1), cA + hstepA, voffA);
    if (wr == 1) PG8_BAR;
    PG8_WAIT_V(4); PG8_BAR;
    PG8_STAGE(PG8_SB(1, 0), cB + kstepB, voffB); PG8_STAGE(PG8_SA(1, 0), cA + kstepA, voffA); PG8_STAGE(PG8_SB(1, 1), cB + hstepB + kstepB, voffB);
    PG8_WAIT_V(6); PG8_BAR;
    for (;;) {
        const bool has_next = S.next(ui + 1, nxt);
        const char* nA = has_next ? g.A + (size_t)nxt.pm * tstepA + (size_t)nxt.pn * g.a_pn_step : cA; const char* nB = has_next ? g.Bt + (size_t)nxt.pn * tstepB : cB;
        for (int t = 0; t < nt; t += 2) {
            const bool last = (t == nt - 2);
            const char* a1 = cA + (size_t)(t + 1) * kstepA;
            const char* a2 = last ? nA : cA + (size_t)(t + 2) * kstepA; const char* b2 = last ? nB : cB + (size_t)(t + 2) * kstepB;
            const char* a3 = a2 + kstepA; const char* b3 = b2 + kstepB;
            PG8_LDB(B0, 0, 0); PG8_SCHED; PG8_LDA(At, 0, 0); PG8_STAGE(PG8_SA(1, 1), a1 + hstepA, voffA);
            PG8_WAIT_L(8); PG8_BAR; PG8_WAIT_L(0); PG8_MMA(0, 0, At, B0); PG8_BAR; PG8_SCHED;
            PG8_LDB(B1, 0, 1); PG8_STAGE(PG8_SB(0, 0), b2, voffB);
            PG8_BAR; PG8_WAIT_L(0); PG8_MMA(0, 1, At, B1); PG8_BAR;
            PG8_LDA(At, 0, 1); PG8_STAGE(PG8_SA(0, 0), a2, voffA);
            PG8_BAR; PG8_WAIT_L(0); PG8_MMA(1, 0, At, B0); PG8_BAR; PG8_SCHED;
            PG8_STAGE(PG8_SB(0, 1), b2 + hstepB, voffB);
            PG8_WAIT_V(6); PG8_BAR; PG8_MMA(1, 1, At, B1); PG8_BAR;
            PG8_LDB(B0, 1, 0); PG8_SCHED; PG8_LDA(At, 1, 0); PG8_STAGE(PG8_SA(0, 1), a2 + hstepA, voffA);
            PG8_WAIT_L(8); PG8_BAR; PG8_WAIT_L(0); PG8_MMA(0, 0, At, B0); PG8_BAR; PG8_SCHED;
            PG8_LDB(B1, 1, 1); PG8_STAGE(PG8_SB(1, 0), b3, voffB);
            PG8_BAR; PG8_WAIT_L(0); PG8_MMA(0, 1, At, B1); PG8_BAR;
            PG8_LDA(At, 1, 1); PG8_STAGE(PG8_SA(1, 0), a3, voffA);
            PG8_BAR; PG8_WAIT_L(0); PG8_MMA(1, 0, At, B0); PG8_BAR; PG8_SCHED;
            PG8_STAGE(PG8_SB(1, 1), b3 + hstepB, voffB);
            PG8_WAIT_V(6); PG8_BAR; PG8_MMA(1, 1, At, B1); PG8_BAR;
        }
        E(acc, cur, wr, wc, fr, fq);
        if (!has_next) break;
#pragma unroll
        for (int a = 0; a < 2; ++a)
#pragma unroll
            for (int b = 0; b < 2; ++b)
#pragma unroll
                for (int m = 0; m < 4; ++m)
#pragma unroll
                    for (int n = 0; n < 2; ++n) acc[a][b][m][n] = (f32x4){0.f, 0.f, 0.f, 0.f};
        cur = nxt; cA = nA; cB = nB; ++ui;
    }
    PG8_WAIT_V(0);
    if (wr == 0) PG8_BAR;
    PG8_BAR;
#undef PG8_SA
#undef PG8_SB
#undef PG8_STAGE
#undef PG8_LDA
#undef PG8_LDB
#undef PG8_MMA
#undef PG8_WAIT_V
#undef PG8_WAIT_L
#undef PG8_BAR
#undef PG8_SCHED
}
}
using pg8::Unit;
typedef f32x4 Acc[2][2][4][2];

#define OPAQUE(v) asm volatile("" : "+v"(v))
struct EpiWin {
    unsigned char* ws; const float* b_gate;
    __device__ __forceinline__ void operator()(const Acc& acc, const Unit& u, int wr, int wc, int fr, int fq) const {
        const int pn = u.pn; const unsigned rl = wr * 64 + fr, cw = wc * 32 + 8 * fq; const size_t rowt = (size_t)u.pm * 256;
        if (pn < 4) {
            unsigned char* base = ws + OFF_QA + (rowt * 1024 + pn * 256) * 2; unsigned lo = (rl * 1024 + cw) * 2; OPAQUE(lo);
#pragma unroll
            for (int ai = 0; ai < 2; ++ai)
#pragma unroll
                for (int m = 0; m < 4; ++m)
#pragma unroll
                    for (int bj = 0; bj < 2; ++bj) *(u32x4*)(base + (lo + (unsigned)(((ai * 128 + m * 16) * 1024 + bj * 128) * 2))) = pack8(acc[ai][bj][m][0], acc[ai][bj][m][1]);
        } else if (pn < 10) {
            const int br = pn - 4;
            if (br == 3 || br == 5) {
                const int b = u.pm >> 3, sb = (u.pm & 7) * 256;
                unsigned char* base = ws + OFF_BRA + (size_t)br * 32 * MiB + ((size_t)b * 256 * 2048 + sb) * 2; unsigned lo = (cw * 2048 + rl) * 2; OPAQUE(lo);
#pragma unroll
                for (int ai = 0; ai < 2; ++ai)
#pragma unroll
                    for (int m = 0; m < 4; ++m)
#pragma unroll
                        for (int bj = 0; bj < 2; ++bj) { const f32x4 v0 = acc[ai][bj][m][0], v1 = acc[ai][bj][m][1];
#pragma unroll
                            for (int e = 0; e < 4; ++e) { *(bf16_t*)(base + (lo + (unsigned)(((bj * 128 + e) * 2048 + ai * 128 + m * 16) * 2))) = f2bf(v0[e]);
                                *(bf16_t*)(base + (lo + (unsigned)(((bj * 128 + e + 4) * 2048 + ai * 128 + m * 16) * 2))) = f2bf(v1[e]); } }
            } else {
                unsigned char* base = ws + OFF_BRA + (size_t)br * 32 * MiB + rowt * 256 * 2; unsigned lo = (rl * 256 + cw) * 2; OPAQUE(lo);
#pragma unroll
                for (int ai = 0; ai < 2; ++ai)
#pragma unroll
                    for (int m = 0; m < 4; ++m)
#pragma unroll
                        for (int bj = 0; bj < 2; ++bj) *(u32x4*)(base + (lo + (unsigned)(((ai * 128 + m * 16) * 256 + bj * 128) * 2))) = pack8(acc[ai][bj][m][0], acc[ai][bj][m][1]);
            }
        } else {
            if (cw < 48) {
                unsigned char* base = ws + OFF_GATE + rowt * 48 * 4; unsigned lo = (rl * 48 + cw) * 4; OPAQUE(lo);
                float bg[8];
#pragma unroll
                for (int e = 0; e < 8; ++e) bg[e] = (cw + e < 48) ? b_gate[cw + e] : 0.f;
#pragma unroll
                for (int ai = 0; ai < 2; ++ai)
#pragma unroll
                    for (int m = 0; m < 4; ++m) { const f32x4 v0 = acc[ai][0][m][0], v1 = acc[ai][0][m][1];
#pragma unroll
                        for (int e = 0; e < 4; ++e) { if (cw + e < 48) *(float*)(base + (lo + (unsigned)(((ai * 128 + m * 16) * 48 + e) * 4))) = sigmoidf_(v0[e] + bg[e]);
                            if (cw + 4 + e < 48) *(float*)(base + (lo + (unsigned)(((ai * 128 + m * 16) * 48 + e + 4) * 4))) = sigmoidf_(v1[e] + bg[4 + e]); } }
            }
        }
    }
};
struct EpiQKVB {
    unsigned char* ws;
    __device__ __forceinline__ void operator()(const Acc& acc, const Unit& u, int wr, int wc, int fr, int fq) const {
        const int pn = u.pn; const unsigned rl = wr * 64 + fr, cw = wc * 32 + 8 * fq; const size_t rowt = (size_t)u.pm * 256;
        if (pn < 12) {
            unsigned char* base = ws + OFF_QB + (rowt * 3072 + pn * 256) * 2; unsigned lo = (rl * 3072 + cw) * 2; OPAQUE(lo);
#pragma unroll
            for (int ai = 0; ai < 2; ++ai)
#pragma unroll
                for (int m = 0; m < 4; ++m)
#pragma unroll
                    for (int bj = 0; bj < 2; ++bj) *(u32x4*)(base + (lo + (unsigned)(((ai * 128 + m * 16) * 3072 + bj * 128) * 2))) = pack8(acc[ai][bj][m][0], acc[ai][bj][m][1]);
        } else {
            const int idx = pn - 12, gi = idx >> 1, isV = idx & 1, dsh = 2 * gi, lsh = 11 - dsh, b = u.pm >> 3, sb = ((u.pm & 7) * 256) >> dsh;
            const unsigned posl = ((rl & ((1u << dsh) - 1u)) << lsh) + (rl >> dsh);
            if (isV) {
                unsigned char* base = ws + OFF_KVB + (size_t)idx * 32 * MiB + ((size_t)b * 256 * 2048 + sb) * 2; unsigned lo = (cw * 2048 + posl) * 2; OPAQUE(lo);
#pragma unroll
                for (int ai = 0; ai < 2; ++ai)
#pragma unroll
                    for (int m = 0; m < 4; ++m) { const unsigned ro = (unsigned)((ai * 128 + m * 16) >> dsh) * 2u;
#pragma unroll
                        for (int bj = 0; bj < 2; ++bj) { const f32x4 v0 = acc[ai][bj][m][0], v1 = acc[ai][bj][m][1];
#pragma unroll
                            for (int e = 0; e < 4; ++e) { *(bf16_t*)(base + (lo + ro + (unsigned)(((bj * 128 + e) * 2048) * 2))) = f2bf(v0[e]);
                                *(bf16_t*)(base + (lo + ro + (unsigned)(((bj * 128 + e + 4) * 2048) * 2))) = f2bf(v1[e]); } } }
            } else {
                unsigned char* base = ws + OFF_KVB + (size_t)idx * 32 * MiB + (((size_t)b * 4 * 2048 + sb) * 64) * 2; unsigned lo = ((cw >> 6) * 2048 * 64 + posl * 64 + (cw & 63)) * 2; OPAQUE(lo);
#pragma unroll
                for (int ai = 0; ai < 2; ++ai)
#pragma unroll
                    for (int m = 0; m < 4; ++m) { const unsigned ro = (unsigned)((ai * 128 + m * 16) >> dsh) * 128u;
#pragma unroll
                        for (int bj = 0; bj < 2; ++bj) *(u32x4*)(base + (lo + ro + (unsigned)(bj * 2 * 2048 * 64 * 2))) = pack8(acc[ai][bj][m][0], acc[ai][bj][m][1]); }
            }
        }
    }
};
struct EpiResid {
    const float* xin; float* xout;
    __device__ __forceinline__ void operator()(const Acc& acc, const Unit& u, int wr, int wc, int fr, int fq) const {
        const unsigned rl = wr * 64 + fr, cw = wc * 32 + 8 * fq; const size_t t0 = ((size_t)u.pm * 256 * 1024 + u.pn * 256) * 4;
        const unsigned char* bi = (const unsigned char*)xin + t0; unsigned char* bo = (unsigned char*)xout + t0; unsigned lo = (rl * 1024 + cw) * 4; OPAQUE(lo);
#pragma unroll
        for (int ai = 0; ai < 2; ++ai)
#pragma unroll
            for (int m = 0; m < 4; ++m)
#pragma unroll
                for (int bj = 0; bj < 2; ++bj) { const unsigned o = lo + (unsigned)(((ai * 128 + m * 16) * 1024 + bj * 128) * 4);
                    const f32x4 a = *(const f32x4*)(bi + o), c = *(const f32x4*)(bi + o + 16);
                    *(f32x4*)(bo + o) = a + acc[ai][bj][m][0]; *(f32x4*)(bo + o + 16) = c + acc[ai][bj][m][1]; }
    }
};
struct EpiSwiglu {
    unsigned char* act;
    __device__ __forceinline__ void operator()(const Acc& acc, const Unit& u, int wr, int wc, int fr, int fq) const {
        const unsigned rl = wr * 64 + fr, cw = wc * 32 + 8 * fq; unsigned char* base = act + ((size_t)u.pm * 256 * FFH + u.pn * 128) * 2; unsigned lo = (rl * FFH + cw) * 2; OPAQUE(lo);
#pragma unroll
        for (int ai = 0; ai < 2; ++ai)
#pragma unroll
            for (int m = 0; m < 4; ++m) { f32x4 h0, h1;
#pragma unroll
                for (int e = 0; e < 4; ++e) { const float a0 = acc[ai][0][m][0][e], a1 = acc[ai][0][m][1][e];
                    h0[e] = a0 * sigmoidf_(a0) * acc[ai][1][m][0][e]; h1[e] = a1 * sigmoidf_(a1) * acc[ai][1][m][1][e]; }
                *(u32x4*)(base + (lo + (unsigned)((ai * 128 + m * 16) * FFH * 2))) = pack8(h0, h1); }
    }
};
struct EpiCmp1 {
    unsigned char* ws;
    __device__ __forceinline__ void operator()(const Acc& acc, const Unit& u, int wr, int wc, int fr, int fq) const {
        const int kv = u.pn; const unsigned rl = wr * 64 + fr, cw = wc * 32 + 8 * fq;
        unsigned char* base = ws + OFF_G1 + (((size_t)kv * 16384 + (size_t)u.pm * 256) * 256) * 2; unsigned lo = (rl * 256 + cw) * 2; OPAQUE(lo);
        const unsigned char* bp = ws + OFF_BIASP + (size_t)kv * 8 * 256 * 4; unsigned blo = cw * 4; OPAQUE(blo);
#pragma unroll
        for (int bj = 0; bj < 2; ++bj) {
            float bias[8];
#pragma unroll
            for (int e = 0; e < 8; ++e) { float sb = 0.f;
#pragma unroll
                for (int q = 0; q < 8; ++q) sb += *(const float*)(bp + (blo + (unsigned)((q * 256 + bj * 128 + e) * 4))); bias[e] = sb; }
#pragma unroll
            for (int ai = 0; ai < 2; ++ai)
#pragma unroll
                for (int m = 0; m < 4; ++m) { f32x4 h0, h1;
#pragma unroll
                    for (int e = 0; e < 4; ++e) {
                        const float x0 = acc[ai][bj][m][0][e] + bias[e], x1 = acc[ai][bj][m][1][e] + bias[4 + e];
                        const float u0 = 0.7978845608028654f * (x0 + 0.044715f * x0 * x0 * x0), u1 = 0.7978845608028654f * (x1 + 0.044715f * x1 * x1 * x1);
                        h0[e] = x0 * sigmoidf_(2.f * u0); h1[e] = x1 * sigmoidf_(2.f * u1); }
                    *(u32x4*)(base + (lo + (unsigned)(((ai * 128 + m * 16) * 256 + bj * 128) * 2))) = pack8(h0, h1); }
        }
    }
};

__device__ __forceinline__ void conv_weight(const float* W, int K, int N, const float* gain, bf16_t* WT, int row_off, int mode, LAS float* scr, int gw, int NGW, int lane) {
    const int nnb = (N + 31) / 32, nitems = (K / 64) * nnb;
    for (int item = gw; item < nitems; item += NGW) {
        const int kb = item / nnb, nb = item % nnb, k0 = 64 * kb, n0 = 32 * nb;
#pragma unroll 8
        for (int i = 0; i < 32; ++i) { const int kk = 2 * i + (lane >> 5), n = n0 + (lane & 31);
            float v = (n < N) ? W[(size_t)(k0 + kk) * N + n] : 0.f; if (gain) v *= gain[k0 + kk]; scr[kk * 33 + (lane & 31)] = v; }
        LDS_WAIT();
        int dr0 = row_off + n0;
        if (mode == 1) dr0 = (n0 < FFH) ? ((n0 >> 7) * 256 + (n0 & 127)) : ((((n0 - FFH) >> 7) * 256) + 128 + ((n0 - FFH) & 127));
        const int c = lane & 7;
#pragma unroll
        for (int j = 0; j < 4; ++j) { const int nn = (lane >> 3) + 8 * j; const LAS float* s = scr + (8 * c) * 33 + nn;
            u32x4 o; o.x = cvt_pk_bf16(s[0 * 33], s[1 * 33]); o.y = cvt_pk_bf16(s[2 * 33], s[3 * 33]); o.z = cvt_pk_bf16(s[4 * 33], s[5 * 33]); o.w = cvt_pk_bf16(s[6 * 33], s[7 * 33]);
            if (n0 + nn < N) *(u32x4*)(WT + (size_t)(dr0 + nn) * K + k0 + 8 * c) = o; }
        LDS_WAIT();
    }
}
__device__ __forceinline__ void norm_rows(const float* x, bf16_t* h, int gw, int NGW, int lane) {
    for (int row = gw; row < T_TOK; row += NGW) {
        const f32x4* xr = (const f32x4*)(x + (size_t)row * DM) + lane; f32x4 v[4]; float s = 0.f;
#pragma unroll
        for (int j = 0; j < 4; ++j) { v[j] = xr[64 * j]; s += (v[j][0] * v[j][0] + v[j][1] * v[j][1]) + (v[j][2] * v[j][2] + v[j][3] * v[j][3]); }
        const float r = 1.f / sqrtf(wave_sum(s) * (1.f / DM) + 1e-6f);
        u32x2* o = (u32x2*)(h + (size_t)row * DM) + lane;
#pragma unroll
        for (int j = 0; j < 4; ++j) { u32x2 w; w.x = cvt_pk_bf16(v[j][0] * r, v[j][1] * r); w.y = cvt_pk_bf16(v[j][2] * r, v[j][3] * r); o[64 * j] = w; }
    }
}
__device__ __forceinline__ void final_norm_rows(float* x, const float* gain, int gw, int NGW, int lane) {
    f32x4 gv[4];
#pragma unroll
    for (int j = 0; j < 4; ++j) gv[j] = ((const f32x4*)gain)[lane + 64 * j];
    for (int row = gw; row < T_TOK; row += NGW) {
        f32x4* xr = (f32x4*)(x + (size_t)row * DM) + lane; f32x4 v[4]; float s = 0.f;
#pragma unroll
        for (int j = 0; j < 4; ++j) { v[j] = xr[64 * j]; s += (v[j][0] * v[j][0] + v[j][1] * v[j][1]) + (v[j][2] * v[j][2] + v[j][3] * v[j][3]); }
        const float r = 1.f / sqrtf(wave_sum(s) * (1.f / DM) + 1e-6f);
#pragma unroll
        for (int j = 0; j < 4; ++j) xr[64 * j] = v[j] * r * gv[j];
    }
}

struct SoftState { float m, l; f32x16 o0, o1; };
__device__ __forceinline__ bf16x8 ld_v8(const char* p) { const u64 lo = *(const u64*)p, hi = *(const u64*)(p + 16); u32x4 t; t.x = (unsigned)lo; t.y = (unsigned)(lo >> 32); t.z = (unsigned)hi; t.w = (unsigned)(hi >> 32); return __builtin_bit_cast(bf16x8, t); }
__device__ __forceinline__ bf16x8 pk_lo(const f32x16& p) { u32x4 t; t.x = cvt_pk_bf16(p[0], p[1]); t.y = cvt_pk_bf16(p[2], p[3]); t.z = cvt_pk_bf16(p[4], p[5]); t.w = cvt_pk_bf16(p[6], p[7]); return __builtin_bit_cast(bf16x8, t); }
__device__ __forceinline__ bf16x8 pk_hi(const f32x16& p) { u32x4 t; t.x = cvt_pk_bf16(p[8], p[9]); t.y = cvt_pk_bf16(p[10], p[11]); t.z = cvt_pk_bf16(p[12], p[13]); t.w = cvt_pk_bf16(p[14], p[15]); return __builtin_bit_cast(bf16x8, t); }

__device__ __forceinline__ void tile_step(SoftState& st, const bf16x8 (&qf)[4], const char* Kb, int kstride, const char* Vt, int vstride, int kbase, int qpos, int max_dist, int dscale,
                                          bool extra, const LAS unsigned char* lut, const LAS float* bias2h, int r, int h) {
    const char* kp = Kb + (size_t)(kbase + r) * kstride + h * 16;
    const bf16x8 k0 = *(const bf16x8*)kp, k1 = *(const bf16x8*)(kp + 32), k2 = *(const bf16x8*)(kp + 64), k3 = *(const bf16x8*)(kp + 96);
    const char* vp0 = Vt + (size_t)r * vstride + (size_t)(kbase + 4 * h) * 2; const char* vp1 = vp0 + (size_t)32 * vstride;
    const bf16x8 v00 = ld_v8(vp0), v01 = ld_v8(vp0 + 32), v10 = ld_v8(vp1), v11 = ld_v8(vp1 + 32);
    f32x16 s = {0.f, 0.f, 0.f, 0.f, 0.f, 0.f, 0.f, 0.f, 0.f, 0.f, 0.f, 0.f, 0.f, 0.f, 0.f, 0.f};
    s = mfma32(k0, qf[0], s); s = mfma32(k1, qf[1], s); s = mfma32(k2, qf[2], s); s = mfma32(k3, qf[3], s);
    float mx = -1e30f;
#pragma unroll
    for (int i = 0; i < 16; ++i) { const int kk = (i & 3) + 8 * (i >> 2) + 4 * h, dist = qpos - (kbase + kk); const bool valid = extra && dist >= 0 && dist <= max_dist;
        int idx = dist * dscale; idx = idx < 0 ? 0 : (idx > 2047 ? 2047 : idx);
        const float t = valid ? s[i] * SC2 + bias2h[(int)lut[idx] * 16] : -1e30f; s[i] = t; mx = fmaxf(mx, t); }
    mx = fmaxf(mx, __shfl_xor(mx, 32)); const float mnew = fmaxf(mx, st.m), alpha = fexp2(st.m - mnew); float ls = 0.f;
#pragma unroll
    for (int i = 0; i < 16; ++i) { const float pv = s[i] > -1e29f ? fexp2(s[i] - mnew) : 0.f; s[i] = pv; ls += pv; }
    st.l = st.l * alpha + ls; st.m = mnew; st.o0 *= alpha; st.o1 *= alpha;
    const bf16x8 pb0 = pk_lo(s), pb1 = pk_hi(s);
    st.o0 = mfma32(v00, pb0, st.o0); st.o0 = mfma32(v01, pb1, st.o0); st.o1 = mfma32(v10, pb0, st.o1); st.o1 = mfma32(v11, pb1, st.o1);
}
__device__ __forceinline__ void soft_init(SoftState& st) { st.m = -1e30f; st.l = 0.f;
#pragma unroll
    for (int i = 0; i < 16; ++i) { st.o0[i] = 0.f; st.o1[i] = 0.f; } }

__device__ __forceinline__ void phaseA_attn(unsigned char* ws, LAS unsigned char* lds, int gw, int NGW, int lane) {
    const int r = lane & 31, h = lane >> 5, tk = r >> 2, rr = r & 3;
    const LAS unsigned char* lut = lds + LDS_LUT; const LAS float* bias2 = (const LAS float*)(lds + LDS_BIAS);
    for (int item = gw; item < 32768; item += NGW) {
        const int bg = item >> 8, ti = ((item & 255) + 16 * (item >> 11)) & 255, b = bg >> 2, g = bg & 3, s0 = ti * 8, s = s0 + tk, head = g * 4 + rr, cur = s0 >> 6;
        const size_t tok = (size_t)b * 2048 + s;
        const LAS float* bias2h = bias2 + head;
        bf16x8 qf[4];
        { const char* qp = (const char*)ws + OFF_QA + (tok * 1024 + head * 64 + 8 * h) * 2;
#pragma unroll
          for (int ks = 0; ks < 4; ++ks) qf[ks] = *(const bf16x8*)(qp + 32 * ks); }
        const float* gp = (const float*)(ws + OFF_GATE) + tok * 48 + head * 3; const float g_cmp = gp[0], g_sel = gp[1], g_win = gp[2];
        f32x16 tot0, tot1; unsigned sel;
        {
            const char* Kc = (const char*)ws + OFF_KCMP + (size_t)bg * 128 * 128; const char* Vc = (const char*)ws + OFF_VCMPT + (size_t)bg * 64 * 256;
            f32x16 sc[4];
#pragma unroll
            for (int c = 0; c < 4; ++c) { const char* kp = Kc + (32 * c + r) * 128 + 16 * h; f32x16 a = {0.f, 0.f, 0.f, 0.f, 0.f, 0.f, 0.f, 0.f, 0.f, 0.f, 0.f, 0.f, 0.f, 0.f, 0.f, 0.f};
#pragma unroll
                for (int ks = 0; ks < 4; ++ks) a = mfma32(*(const bf16x8*)(kp + 32 * ks), qf[ks], a); sc[c] = a; }
            float mx = -1e30f;
#pragma unroll
            for (int c = 0; c < 4; ++c)
#pragma unroll
                for (int i = 0; i < 16; ++i) { const int n = 32 * c + (i & 3) + 8 * (i >> 2) + 4 * h, dist = s - 16 * n - 31; const bool valid = dist >= 0; const int idx = dist < 0 ? 0 : dist;
                    const float t = valid ? sc[c][i] * SC2 + bias2h[(int)lut[idx] * 16] : -1e30f; sc[c][i] = t; mx = fmaxf(mx, t); }
            mx = fmaxf(mx, __shfl_xor(mx, 32)); float l = 0.f;
#pragma unroll
            for (int c = 0; c < 4; ++c)
#pragma unroll
                for (int i = 0; i < 16; ++i) { const float pv = sc[c][i] > -1e29f ? fexp2(sc[c][i] - mx) : 0.f; sc[c][i] = pv; l += pv; }
            l += __shfl_xor(l, 32); const float inv = 1.f / fmaxf(l, 1e-30f);
#pragma unroll
            for (int c = 0; c < 4; ++c) sc[c] *= inv;
            f32x16 oc0 = {0.f, 0.f, 0.f, 0.f, 0.f, 0.f, 0.f, 0.f, 0.f, 0.f, 0.f, 0.f, 0.f, 0.f, 0.f, 0.f}, oc1 = oc0;
#pragma unroll
            for (int c = 0; c < 4; ++c) { const bf16x8 pb0 = pk_lo(sc[c]), pb1 = pk_hi(sc[c]); const char* vp0 = Vc + r * 256 + (32 * c + 4 * h) * 2; const char* vp1 = vp0 + 32 * 256;
                oc0 = mfma32(ld_v8(vp0), pb0, oc0); oc0 = mfma32(ld_v8(vp0 + 32), pb1, oc0); oc1 = mfma32(ld_v8(vp1), pb0, oc1); oc1 = mfma32(ld_v8(vp1 + 32), pb1, oc1); }
            tot0 = oc0 * g_cmp; tot1 = oc1 * g_cmp;
            float own[16], oth[16], pl[16];
#pragma unroll
            for (int cgi = 0; cgi < 16; ++cgi) pl[cgi] = __shfl_xor(sc[cgi >> 2][4 * (cgi & 3) + 3], 32);
#pragma unroll
            for (int cgi = 0; cgi < 16; ++cgi) { const int c = cgi >> 2, q4 = 4 * (cgi & 3); float v = (sc[c][q4] + sc[c][q4 + 1]) + (sc[c][q4 + 2] + sc[c][q4 + 3]);
                const float prevh0 = cgi > 0 ? pl[cgi > 0 ? cgi - 1 : 0] : 0.f; v += h ? pl[cgi] : prevh0;
                v += __shfl_xor(v, 1); v += __shfl_xor(v, 2); own[cgi] = v; }
#pragma unroll
            for (int cgi = 0; cgi < 16; ++cgi) oth[cgi] = __shfl_xor(own[cgi], 32);
            sel = 1u | (1u << cur) | (cur > 0 ? (1u << (cur - 1)) : 0u);
#pragma unroll 1
            for (int round = 0; round < 5; ++round) { float best = -1.f; int bjx = -1;
#pragma unroll
                for (int cgi = 0; cgi < 16; ++cgi) { const float ve = h ? oth[cgi] : own[cgi], vo = h ? own[cgi] : oth[cgi];
                    { const int j = 2 * cgi; const bool ok = j >= 1 && j <= cur - 2 && !((sel >> j) & 1u); const float v = ok ? ve : -2.f; if (v > best) { best = v; bjx = j; } }
                    { const int j = 2 * cgi + 1; const bool ok = j <= cur - 2 && !((sel >> j) & 1u); const float v = ok ? vo : -2.f; if (v > best) { best = v; bjx = j; } } }
                if (bjx >= 0) sel |= 1u << bjx; }
        }
        {
            unsigned um = sel; um |= __shfl_xor(um, 4); um |= __shfl_xor(um, 8); um |= __shfl_xor(um, 16); um = __builtin_amdgcn_readfirstlane(um);
            const char* Kb = (const char*)ws + OFF_BRA + 2 * 32 * MiB + ((size_t)b * 2048 * 256 + g * 64) * 2; const char* Vt = (const char*)ws + OFF_BRA + 3 * 32 * MiB + (size_t)bg * 64 * 4096;
            SoftState st; soft_init(st);
            while (um) { const int jb = __builtin_ctz(um); um &= um - 1; const bool ex = (sel >> jb) & 1u;
                tile_step(st, qf, Kb, 512, Vt, 4096, 64 * jb, s, 4096, 1, ex, lut, bias2h, r, h);
                tile_step(st, qf, Kb, 512, Vt, 4096, 64 * jb + 32, s, 4096, 1, ex, lut, bias2h, r, h); }
            const float lt = st.l + __shfl_xor(st.l, 32), sc = g_sel / fmaxf(lt, 1e-30f);
            tot0 += st.o0 * sc; tot1 += st.o1 * sc;
        }
        {
            const char* Kb = (const char*)ws + OFF_BRA + 4 * 32 * MiB + ((size_t)b * 2048 * 256 + g * 64) * 2; const char* Vt = (const char*)ws + OFF_BRA + 5 * 32 * MiB + (size_t)bg * 64 * 4096;
            SoftState st; soft_init(st);
            const int lo = s0 - 255, kt_lo = lo < 0 ? 0 : (lo >> 5), kt_hi = (s0 + 7) >> 5;
            for (int kt = kt_lo; kt <= kt_hi; ++kt) tile_step(st, qf, Kb, 512, Vt, 4096, 32 * kt, s, 255, 1, true, lut, bias2h, r, h);
            const float lt = st.l + __shfl_xor(st.l, 32), sc = g_win / fmaxf(lt, 1e-30f);
            tot0 += st.o0 * sc; tot1 += st.o1 * sc;
        }
        { unsigned char* op = ws + OFF_O + (tok * 1024 + head * 64 + 4 * h) * 2;
#pragma unroll
          for (int q = 0; q < 4; ++q) { u32x2 w; w.x = cvt_pk_bf16(tot0[4 * q], tot0[4 * q + 1]); w.y = cvt_pk_bf16(tot0[4 * q + 2], tot0[4 * q + 3]); *(u32x2*)(op + 16 * q) = w;
              u32x2 w2; w2.x = cvt_pk_bf16(tot1[4 * q], tot1[4 * q + 1]); w2.y = cvt_pk_bf16(tot1[4 * q + 2], tot1[4 * q + 3]); *(u32x2*)(op + 64 + 16 * q) = w2; } }
    }
}

__device__ __forceinline__ void phaseB_attn(unsigned char* ws, LAS unsigned char* lds, int gw, int NGW, int lane) {
    const int r = lane & 31, h = lane >> 5, tk = r >> 2, rr = r & 3;
    const LAS unsigned char* lut = lds + LDS_LUT; const LAS float* bias2 = (const LAS float*)(lds + LDS_BIAS);
    for (int item = gw; item < 32768; item += NGW) {
        const int bg = item >> 8, cc = (item >> 4) & 15, r16 = item & 15, b = bg >> 2, g = bg & 3, s0 = cc * 128 + r16, s = s0 + 16 * tk, head = g * 4 + rr;
        const size_t tok = (size_t)b * 2048 + s;
        const LAS float* bias2h = bias2 + head;
        SoftState st; soft_init(st);
#pragma unroll 1
        for (int gi = 0; gi < 3; ++gi) {
            const int dsh = 2 * gi, lsh = 11 - dsh, res = s0 & ((1 << dsh) - 1);
            bf16x8 qf[4];
            { const char* qp = (const char*)ws + OFF_QB + (tok * 3072 + gi * 1024 + head * 64 + 8 * h) * 2;
#pragma unroll
              for (int ks = 0; ks < 4; ++ks) qf[ks] = *(const bf16x8*)(qp + 32 * ks); }
            const char* Kb = (const char*)ws + OFF_KVB + (size_t)(gi * 2) * 32 * MiB + ((size_t)bg * 2048 + ((size_t)res << lsh)) * 128;
            const char* Vt = (const char*)ws + OFF_KVB + (size_t)(gi * 2 + 1) * 32 * MiB + (size_t)bg * 64 * 4096 + ((size_t)res << lsh) * 2;
            const int ql = s >> dsh, ql_lo = (s0 >> dsh) - 128, kt_lo = ql_lo < 0 ? 0 : (ql_lo >> 5), kt_hi = ((s0 + 112) >> dsh) >> 5;
            for (int kt = kt_lo; kt <= kt_hi; ++kt) tile_step(st, qf, Kb, 128, Vt, 4096, 32 * kt, ql, 128, 1 << dsh, true, lut, bias2h, r, h);
        }
        const float lt = st.l + __shfl_xor(st.l, 32), sc = 1.f / fmaxf(lt, 1e-30f);
        const f32x16 tot0 = st.o0 * sc, tot1 = st.o1 * sc;
        { unsigned char* op = ws + OFF_O + (tok * 1024 + head * 64 + 4 * h) * 2;
#pragma unroll
          for (int q = 0; q < 4; ++q) { u32x2 w; w.x = cvt_pk_bf16(tot0[4 * q], tot0[4 * q + 1]); w.y = cvt_pk_bf16(tot0[4 * q + 2], tot0[4 * q + 3]); *(u32x2*)(op + 16 * q) = w;
              u32x2 w2; w2.x = cvt_pk_bf16(tot1[4 * q], tot1[4 * q + 1]); w2.y = cvt_pk_bf16(tot1[4 * q + 2], tot1[4 * q + 3]); *(u32x2*)(op + 64 + 16 * q) = w2; } }
    }
}

__device__ __forceinline__ void phase_cmp2(unsigned char* ws, int gw, int NGW, int lane) {
    const int r = lane & 31, h = lane >> 5;
    for (int item = gw; item < 1024; item += NGW) {
        const int kv = item >> 9, rt = item & 511;
        const char* ap = (const char*)ws + OFF_G1 + (((size_t)kv * 16384 + rt * 32 + r) * 256 + 8 * h) * 2;
        const char* bp = (const char*)ws + OFF_W2 + (size_t)kv * 32768 + ((size_t)r * 256 + 8 * h) * 2;
        f32x16 a0 = {0.f, 0.f, 0.f, 0.f, 0.f, 0.f, 0.f, 0.f, 0.f, 0.f, 0.f, 0.f, 0.f, 0.f, 0.f, 0.f}, a1 = a0;
#pragma unroll
        for (int ks = 0; ks < 16; ++ks) { const bf16x8 a = *(const bf16x8*)(ap + 32 * ks);
            a0 = mfma32(a, *(const bf16x8*)(bp + 32 * ks), a0); a1 = mfma32(a, *(const bf16x8*)(bp + 32 * 256 * 2 + 32 * ks), a1); }
#pragma unroll
        for (int i = 0; i < 16; ++i) { const int row = rt * 32 + (i & 3) + 8 * (i >> 2) + 4 * h, gq = row & 3, n = (row >> 2) & 127, b = row >> 9, bgi = b * 4 + gq;
            if (kv == 0) { bf16_t* o = (bf16_t*)(ws + OFF_KCMP) + ((size_t)bgi * 128 + n) * 64; o[r] = f2bf(a0[i]); o[r + 32] = f2bf(a1[i]); }
            else { bf16_t* o = (bf16_t*)(ws + OFF_VCMPT) + (size_t)bgi * 64 * 128 + n; o[(size_t)r * 128] = f2bf(a0[i]); o[(size_t)(r + 32) * 128] = f2bf(a1[i]); } }
    }
}

__global__ __launch_bounds__(512, 2) void yoco_mega(Params p) {
    extern __shared__ __attribute__((aligned(16))) unsigned char shm[];
    cg::grid_group grid = cg::this_grid();
    LAS unsigned char* lds = (LAS unsigned char*)shm;
    const int tid = threadIdx.x, lane = tid & 63, wave = __builtin_amdgcn_readfirstlane(tid >> 6), gw = blockIdx.x * 8 + wave, NGW = gridDim.x * 8;
    unsigned char* ws = p.ws;
    const float* x_in = p.in[0];
    float* X = p.out;
    { LAS unsigned char* lut = lds + LDS_LUT; LAS float* bias2 = (LAS float*)(lds + LDS_BIAS);
      for (int d = tid; d < 2048; d += 512) { int bk = d; if (d >= 16) bk = 16 + (d >= 22) + (d >= 30) + (d >= 40) + (d >= 54) + (d >= 73) + (d >= 99) + (d >= 134) + (d >= 182) + (d >= 246) + (d >= 332) + (d >= 450) + (d >= 609) + (d >= 825) + (d >= 1117) + (d >= 1513); lut[d] = (unsigned char)bk; }
      bias2[tid] = p.in[1][tid] * LOG2E;
      __syncthreads(); }
    {
        LAS float* scr = (LAS float*)(lds + wave * 8448);
        const float* nm = p.in[2]; const float* nf = p.in[3];
        conv_weight(p.in[4], 1024, 2608, nm, (bf16_t*)(ws + OFF_WIN), 0, 0, scr, gw, NGW, lane);
        conv_weight(p.in[7], 2048, 256, nullptr, (bf16_t*)(ws + OFF_W1), 0, 0, scr, gw, NGW, lane);
        conv_weight(p.in[10], 2048, 256, nullptr, (bf16_t*)(ws + OFF_W1), 256, 0, scr, gw, NGW, lane);
        conv_weight(p.in[8], 256, 64, nullptr, (bf16_t*)(ws + OFF_W2), 0, 0, scr, gw, NGW, lane);
        conv_weight(p.in[11], 256, 64, nullptr, (bf16_t*)(ws + OFF_W2), 64, 0, scr, gw, NGW, lane);
        conv_weight(p.in[12], 1024, 1024, nullptr, (bf16_t*)(ws + OFF_WOUTA), 0, 0, scr, gw, NGW, lane);
        conv_weight(p.in[15], 1024, 3072, nm + 1024, (bf16_t*)(ws + OFF_WQKVB), 0, 0, scr, gw, NGW, lane);
        conv_weight(p.in[14], 1024, 1536, p.in[13], (bf16_t*)(ws + OFF_WQKVB), 3072, 0, scr, gw, NGW, lane);
        conv_weight(p.in[16], 1024, 1024, nullptr, (bf16_t*)(ws + OFF_WOUTB), 0, 0, scr, gw, NGW, lane);
        conv_weight(p.in[17], 1024, 5632, nf, (bf16_t*)(ws + OFF_WUP0), 0, 1, scr, gw, NGW, lane);
        conv_weight(p.in[17] + (size_t)1024 * 5632, 1024, 5632, nf + 1024, (bf16_t*)(ws + OFF_WUP1), 0, 1, scr, gw, NGW, lane);
        conv_weight(p.in[18], 2816, 1024, nullptr, (bf16_t*)(ws + OFF_WDN0), 0, 0, scr, gw, NGW, lane);
        conv_weight(p.in[18] + (size_t)2816 * 1024, 2816, 1024, nullptr, (bf16_t*)(ws + OFF_WDN1), 0, 0, scr, gw, NGW, lane);
        for (int item = gw; item < 64; item += NGW) { const int kv = item >> 5, ksl = (item >> 2) & 7, c = (item & 3) * 64 + lane;
            const float* pe = kv ? p.in[9] : p.in[6]; const float* w1 = kv ? p.in[10] : p.in[7]; float a = 0.f;
#pragma unroll 8
            for (int kk = ksl * 256; kk < ksl * 256 + 256; ++kk) a += pe[kk] * w1[(size_t)kk * 256 + c];
            ((float*)(ws + OFF_BIASP))[(kv * 8 + ksl) * 256 + c] = a; }
        norm_rows(x_in, (bf16_t*)(ws + OFF_H), gw, NGW, lane);
    }
    grid.sync();
    pg8::StaticOrder S;
    { pg8::Gemm g{(const char*)ws + OFF_H, (const char*)ws + OFF_WIN, 1024, 1024, 0, 0}; S.init(256, 11, gridDim.x, blockIdx.x); EpiWin E{ws, p.in[5]}; pg8::gemm_phase(lds, g, S, E); }
    grid.sync();
    { pg8::Gemm g{(const char*)ws + OFF_BRA, (const char*)ws + OFF_W1, 2048, 0, 1, 32 * MiB}; S.init(64, 2, gridDim.x, blockIdx.x); EpiCmp1 E{ws}; pg8::gemm_phase(lds, g, S, E); }
    grid.sync();
    phase_cmp2(ws, gw, NGW, lane);
    grid.sync();
    phaseA_attn(ws, lds, gw, NGW, lane);
    grid.sync();
    { pg8::Gemm g{(const char*)ws + OFF_O, (const char*)ws + OFF_WOUTA, 1024, 1024, 0, 0}; S.init(256, 4, gridDim.x, blockIdx.x); EpiResid E{x_in, X}; pg8::gemm_phase(lds, g, S, E); }
    grid.sync();
#define FFN_BLOCK(WUP, WDN) \
    norm_rows(X, (bf16_t*)(ws + OFF_H), gw, NGW, lane); \
    grid.sync(); \
    { pg8::Gemm g{(const char*)ws + OFF_H, (const char*)ws + (WUP), 1024, 1024, 0, 0}; S.init(256, 22, gridDim.x, blockIdx.x); EpiSwiglu E{ws + OFF_ACT}; pg8::gemm_phase(lds, g, S, E); } \
    grid.sync(); \
    { pg8::Gemm g{(const char*)ws + OFF_ACT, (const char*)ws + (WDN), 2816, 2816, 0, 0}; S.init(256, 4, gridDim.x, blockIdx.x); EpiResid E{X, X}; pg8::gemm_phase(lds, g, S, E); } \
    grid.sync();
    FFN_BLOCK(OFF_WUP0, OFF_WDN0)
    norm_rows(X, (bf16_t*)(ws + OFF_H), gw, NGW, lane);
    grid.sync();
    { pg8::Gemm g{(const char*)ws + OFF_H, (const char*)ws + OFF_WQKVB, 1024, 1024, 0, 0}; S.init(256, 18, gridDim.x, blockIdx.x); EpiQKVB E{ws}; pg8::gemm_phase(lds, g, S, E); }
    grid.sync();
    phaseB_attn(ws, lds, gw, NGW, lane);
    grid.sync();
    { pg8::Gemm g{(const char*)ws + OFF_O, (const char*)ws + OFF_WOUTB, 1024, 1024, 0, 0}; S.init(256, 4, gridDim.x, blockIdx.x); EpiResid E{X, X}; pg8::gemm_phase(lds, g, S, E); }
    grid.sync();
    FFN_BLOCK(OFF_WUP1, OFF_WDN1)
    final_norm_rows(X, p.in[19], gw, NGW, lane);
}

extern "C" void kernel_launch(void* const* d_in, const int* in_sizes, int n_in, void* d_out, int out_size, void* d_ws, size_t ws_size, hipStream_t stream) {
    static int grid_blocks = 0;
    if (grid_blocks == 0) {
        if (n_in != 20 || out_size != T_TOK * DM || ws_size < WS_NEED) { fprintf(stderr, "kernel_launch: unexpected shapes (n_in %d out %d ws %zu)\n", n_in, out_size, ws_size); grid_blocks = -1; return; }
        int dev = 0, cus = 0, per_cu = 0;
        hipGetDevice(&dev); hipDeviceGetAttribute(&cus, hipDeviceAttributeMultiprocessorCount, dev);
        if (hipFuncSetAttribute((const void*)yoco_mega, hipFuncAttributeMaxDynamicSharedMemorySize, LDS_TOTAL) != hipSuccess) { fprintf(stderr, "kernel_launch: hipFuncSetAttribute failed\n"); grid_blocks = -1; return; }
        if (hipOccupancyMaxActiveBlocksPerMultiprocessor(&per_cu, (const void*)yoco_mega, 512, LDS_TOTAL) != hipSuccess || per_cu < 1) { fprintf(stderr, "kernel_launch: occupancy query gave %d\n", per_cu); per_cu = 1; }
        (void)hipGetLastError();
        grid_blocks = cus * 1;
    }
    if (grid_blocks < 0) return;
    Params p{};
    for (int i = 0; i < 20; ++i) p.in[i] = (const float*)d_in[i];
    p.out = (float*)d_out; p.ws = (unsigned char*)d_ws;
    void* args[] = {&p};
    hipError_t e = hipLaunchCooperativeKernel((const void*)yoco_mega, dim3(grid_blocks), dim3(512), args, LDS_TOTAL, stream);
    if (e != hipSuccess) fprintf(stderr, "cooperative launch failed: %s (grid %d)\n", hipGetErrorString(e), grid_blocks);
}
```

```cpp
#include <hip/hip_runtime.h>
#include <hip/hip_cooperative_groups.h>
#include <cstdio>
namespace cg = cooperative_groups;

#define LAS __attribute__((address_space(3)))
typedef unsigned short bf16_t;
typedef short bf16x8 __attribute__((ext_vector_type(8)));
typedef float f32x4 __attribute__((ext_vector_type(4)));
typedef float f32x16 __attribute__((ext_vector_type(16)));
typedef unsigned u32x4 __attribute__((ext_vector_type(4)));
typedef unsigned u32x2 __attribute__((ext_vector_type(2)));
typedef unsigned long long u64;

constexpr int T_TOK = 65536, DM = 1024, SEQ = 2048, FFH = 2816;
constexpr size_t MiB = 1ull << 20;
constexpr size_t OFF_WIN = 0, OFF_WOUTA = 6 * MiB, OFF_WUP0 = 8 * MiB, OFF_WUP1 = 19 * MiB, OFF_WDN0 = 30 * MiB, OFF_WDN1 = 36 * MiB,
                 OFF_WQKVB = 42 * MiB, OFF_WOUTB = 51 * MiB, OFF_W1 = 53 * MiB  , OFF_W2 = 55 * MiB  ,
                 OFF_BIASP = 55 * MiB + 128 * 1024, OFF_KCMP = 56 * MiB, OFF_VCMPT = 58 * MiB, OFF_GATE = 60 * MiB, OFF_H = 72 * MiB,
                 OFF_O = 200 * MiB, OFF_BIG = 328 * MiB, WS_NEED = 1024 * MiB;
constexpr size_t OFF_QA = OFF_BIG, OFF_BRA = OFF_BIG + 128 * MiB  , OFF_ACT = OFF_BIG,
                 OFF_QB = OFF_BIG, OFF_KVB = OFF_BIG + 384 * MiB  , OFF_G1 = OFF_O;
constexpr int LDS_STAGE = 131072, LDS_NEG = 132608  , LDS_LUT = 133120, LDS_BIAS = LDS_LUT + 2048, LDS_TOTAL = LDS_BIAS + 2048;
constexpr float LOG2E = 1.4426950408889634f;
constexpr float SC2 = 0.125f * LOG2E;

struct Params { const float* in[20]; float* out; unsigned char* ws; };

__device__ __forceinline__ unsigned cvt_pk_bf16(float lo, float hi) { unsigned r; asm volatile("v_cvt_pk_bf16_f32 %0, %1, %2" : "=v"(r) : "v"(lo), "v"(hi)); return r; }
__device__ __forceinline__ bf16_t f2bf(float f) { return (bf16_t)(cvt_pk_bf16(f, 0.f) & 0xffffu); }
__device__ __forceinline__ u32x4 pack8(f32x4 a, f32x4 b) { u32x4 o; o.x = cvt_pk_bf16(a[0], a[1]); o.y = cvt_pk_bf16(a[2], a[3]); o.z = cvt_pk_bf16(b[0], b[1]); o.w = cvt_pk_bf16(b[2], b[3]); return o; }
__device__ __forceinline__ float fexp2(float x) { return __builtin_amdgcn_exp2f(x); }
__device__ __forceinline__ float frcp(float x) { return __builtin_amdgcn_rcpf(x); }
__device__ __forceinline__ float sigmoidf_(float x) { return frcp(1.f + fexp2(-x * LOG2E)); }
__device__ __forceinline__ float wave_sum(float v) {
#pragma unroll
    for (int o = 1; o < 64; o <<= 1) v += __shfl_xor(v, o);
    return v;
}
__device__ __forceinline__ f32x16 mfma32(bf16x8 a, bf16x8 b, f32x16 c) { return __builtin_amdgcn_mfma_f32_32x32x16_bf16(a, b, c, 0, 0, 0); }
#define LDS_WAIT() asm volatile("s_waitcnt lgkmcnt(0)" ::: "memory")

namespace pg8 {
constexpr int BM = 256, BK = 64, HALF = 128, HTB = HALF * BK * 2, NXCD = 8, WGM = 8;
__device__ __forceinline__ int lds_byte(int r, int c) { const int st = (r >> 4) * 2 + (c >> 5), rr = r & 15, cc = c & 31, ob = rr * 64 + cc * 2; return st * 1024 + (ob ^ (((ob >> 9) & 1) << 5)); }
__device__ __forceinline__ void stage_rc(int b, int& R, int& C) { const int st = b / 1024, sb = b % 1024, swz = sb ^ (((sb >> 9) & 1) << 5); R = (st >> 1) * 16 + swz / 64; C = (st & 1) * 32 + (swz % 64) / 2; }
__device__ __forceinline__ int perm32(int rho) { const int n = rho >> 4, i = rho & 15; return 8 * (i >> 2) + 4 * n + (i & 3); }
struct Unit { int pm, pn; };
struct Gemm { const char* A; const char* Bt; int K; int lda; int amode; size_t a_pn_step; };
struct StaticOrder {
    int nM, nN, nwg, G, c;
    __device__ void init(int nM_, int nN_, int G_, int c_) { nM = nM_; nN = nN_; nwg = nM * nN; G = G_; c = c_; }
    __device__ bool next(int i, Unit& u) const {
        const long L = (long)i * G + c; if (L >= nwg) return false;
        int wgid = (int)L; { const int q = nwg / NXCD, r = nwg % NXCD, xcd = wgid % NXCD, off = wgid / NXCD; wgid = (xcd < r ? xcd * (q + 1) : r * (q + 1) + (xcd - r) * q) + off; }
        const int nig = WGM * nN, gid = wgid / nig, fm = gid * WGM, gsz = (nM - fm) < WGM ? (nM - fm) : WGM;
        u.pm = fm + ((wgid % nig) % gsz); u.pn = (wgid % nig) / gsz; return true;
    }
};

template <class Epi>
__device__ __forceinline__ void gemm_phase(LAS unsigned char* lds, const Gemm g, const StaticOrder& S, const Epi& E) {
    const int tid = threadIdx.x, wid = __builtin_amdgcn_readfirstlane(tid >> 6), lane = tid & 63, wr = wid >> 2, wc = wid & 3, fr = lane & 15, fq = lane >> 4;
    const int K = g.K, nt = K / BK;
    unsigned voffA[2], voffB[2];
#pragma unroll
    for (int i = 0; i < 2; ++i) { int R, C; stage_rc(tid * 16 + i * 8192, R, C); const int Rb = (R & ~31) + perm32(R & 31);
        voffA[i] = g.amode ? (unsigned)((R >> 2) * 8192 + (R & 3) * 128 + C * 2) : (unsigned)(R * g.lda + C) * 2u;
        voffB[i] = (unsigned)(Rb * K + C) * 2u; }
    const size_t kstepA = g.amode ? 512 : (size_t)(BK * 2), kstepB = (size_t)(BK * 2);
    const size_t hstepA = g.amode ? (size_t)262144 : (size_t)HALF * g.lda * 2, hstepB = (size_t)HALF * K * 2;
    const size_t tstepA = 2 * hstepA, tstepB = 2 * hstepB;
    const unsigned ldsw = (unsigned)wid * 1024u;
    const int aoff = lds_byte(wr * 64 + fr, fq * 8), boff = lds_byte(wc * 32 + fr, fq * 8);
#define PG8_SA(b, h) (((b) * 2 + (h)) * HTB)
#define PG8_SB(b, h) ((4 + (b) * 2 + (h)) * HTB)
#define PG8_STAGE(bufoff, gbase, voff) do { _Pragma("unroll") for (int _i = 0; _i < 2; ++_i) \
        __builtin_amdgcn_global_load_lds((const unsigned*)((const char*)(gbase) + (voff)[_i]), (LAS unsigned*)(lds + (bufoff) + ldsw + _i * 8192), 16, 0, 0); } while (0)
#define PG8_LDA(dst, b, h) do { _Pragma("unroll") for (int m = 0; m < 4; ++m) _Pragma("unroll") for (int k = 0; k < 2; ++k) dst[m][k] = *(const LAS bf16x8*)(lds + PG8_SA(b, h) + aoff + m * 2048 + k * 1024); } while (0)
#define PG8_LDB(dst, b, h) do { _Pragma("unroll") for (int n = 0; n < 2; ++n) _Pragma("unroll") for (int k = 0; k < 2; ++k) dst[n][k] = *(const LAS bf16x8*)(lds + PG8_SB(b, h) + boff + n * 2048 + k * 1024); } while (0)
#define PG8_MMA(ai, bj, At, Bt) do { __builtin_amdgcn_s_setprio(1); _Pragma("unroll") for (int m = 0; m < 4; ++m) _Pragma("unroll") for (int n = 0; n < 2; ++n) _Pragma("unroll") for (int k = 0; k < 2; ++k) \
        acc[ai][bj][m][n] = __builtin_amdgcn_mfma_f32_16x16x32_bf16(Bt[n][k], At[m][k], acc[ai][bj][m][n], 0, 0, 0); __builtin_amdgcn_s_setprio(0); } while (0)
#define PG8_WAIT_V(n) asm volatile("s_waitcnt vmcnt(" #n ")" ::: "memory")
#define PG8_WAIT_L(n) asm volatile("s_waitcnt lgkmcnt(" #n ")" ::: "memory")
#define PG8_BAR __builtin_amdgcn_s_barrier()
#define PG8_SCHED __builtin_amdgcn_sched_barrier(0)
    Unit cur, nxt; int ui = 0;
    if (!S.next(0, cur)) return;
    f32x4 acc[2][2][4][2];
#pragma unroll
    for (int a = 0; a < 2; ++a)
#pragma unroll
        for (int b = 0; b < 2; ++b)
#pragma unroll
            for (int m = 0; m < 4; ++m)
#pragma unroll
                for (int n = 0; n < 2; ++n) acc[a][b][m][n] = (f32x4){0.f, 0.f, 0.f, 0.f};
    bf16x8 At[4][2], B0[2][2], B1[2][2];
    const char* cA = g.A + (size_t)cur.pm * tstepA + (size_t)cur.pn * g.a_pn_step; const char* cB = g.Bt + (size_t)cur.pn * tstepB;
    PG8_STAGE(PG8_SB(0, 0), cB, voffB); PG8_STAGE(PG8_SA(0, 0), cA, voffA); PG8_STAGE(PG8_SB(0, 1), cB + hstepB, voffB); PG8_STAGE(PG8_SA(0, 1), cA + hstepA, voffA);
    if (wr == 1) PG8_BAR;
    PG8_WAIT_V(4); PG8_BAR;
    PG8_STAGE(PG8_SB(1, 0), cB + kstepB, voffB); PG8_STAGE(PG8_SA(1, 0), cA + kstepA, voffA); PG8_STAGE(PG8_SB(1, 1), cB + hstepB + kstepB, voffB);
    PG8_WAIT_V(6); PG8_BAR;
    for (;;) {
        const bool has_next = S.next(ui + 1, nxt);
        const char* nA = has_next ? g.A + (size_t)nxt.pm * tstepA + (size_t)nxt.pn * g.a_pn_step : cA; const char* nB = has_next ? g.Bt + (size_t)nxt.pn * tstepB : cB;
        for (int t = 0; t < nt; t += 2) {
            const bool last = (t == nt - 2);
            const char* a1 = cA + (size_t)(t + 1) * kstepA;
            const char* a2 = last ? nA : cA + (size_t)(t + 2) * kstepA; const char* b2 = last ? nB : cB + (size_t)(t + 2) * kstepB;
            const char* a3 = a2 + kstepA; const char* b3 = b2 + kstepB;
            PG8_LDB(B0, 0, 0); PG8_SCHED; PG8_LDA(At, 0, 0); PG8_STAGE(PG8_SA(1, 1), a1 + hstepA, voffA);
            PG8_WAIT_L(8); PG8_BAR; PG8_WAIT_L(0); PG8_MMA(0, 0, At, B0); PG8_BAR; PG8_SCHED;
            PG8_LDB(B1, 0, 1); PG8_STAGE(PG8_SB(0, 0), b2, voffB);
            PG8_BAR; PG8_WAIT_L(0); PG8_MMA(0, 1, At, B1); PG8_BAR;
            PG8_LDA(At, 0, 1); PG8_STAGE(PG8_SA(0, 0), a2, voffA);
            PG8_BAR; PG8_WAIT_L(0); PG8_MMA(1, 0, At, B0); PG8_BAR; PG8_SCHED;
            PG8_STAGE(PG8_SB(0, 1), b2 + hstepB, voffB);
            PG8_WAIT_V(6); PG8_BAR; PG8_MMA(1, 1, At, B1); PG8_BAR;
            PG8_LDB(B0, 1, 0); PG8_SCHED; PG8_LDA(At, 1, 0); PG8_STAGE(PG8_SA(0, 1), a2 + hstepA, voffA);
            PG8_WAIT_L(8); PG8_BAR; PG8_WAIT_L(0); PG8_MMA(0, 0, At, B0); PG8_BAR; PG8_SCHED;
            PG8_LDB(B1, 1, 1); PG8_STAGE(PG8_SB(1, 0), b3, voffB);
            PG8_BAR; PG8_WAIT_L(0); PG8_MMA(0, 1, At, B1); PG8_BAR;
            PG8_LDA(At, 1, 1); PG8_STAGE(PG8_SA(1, 0), a3, voffA);
            PG8_BAR; PG8_WAIT_L(0); PG8_MMA(1, 0, At, B0); PG8_BAR; PG8_SCHED;
            PG8_STAGE(PG8_SB(1, 1), b3 + hstepB, voffB);
            PG8_WAIT_V(6); PG8_BAR; PG8_MMA(1, 1, At, B1); PG8_BAR;
        }
        E(acc, cur, wr, wc, fr, fq);
        if (!has_next) break;
#pragma unroll
        for (int a = 0; a < 2; ++a)
#pragma unroll
            for (int b = 0; b < 2; ++b)
#pragma unroll
                for (int m = 0; m < 4; ++m)
#pragma unroll
                    for (int n = 0; n < 2; ++n) acc[a][b][m][n] = (f32x4){0.f, 0.f, 0.f, 0.f};
        cur = nxt; cA = nA; cB = nB; ++ui;
    }
    PG8_WAIT_V(0);
    if (wr == 0) PG8_BAR;
    PG8_BAR;
#undef PG8_SA
#undef PG8_SB
#undef PG8_STAGE
#undef PG8_LDA
#undef PG8_LDB
#undef PG8_MMA
#undef PG8_WAIT_V
#undef PG8_WAIT_L
#undef PG8_BAR
#undef PG8_SCHED
}
}
using pg8::Unit;
typedef f32x4 Acc[2][2][4][2];

#define OPAQUE(v) asm volatile("" : "+v"(v))
struct EpiWin {
    unsigned char* ws; const float* b_gate;
    __device__ __forceinline__ void operator()(const Acc& acc, const Unit& u, int wr, int wc, int fr, int fq) const {
        const int pn = u.pn; const unsigned rl = wr * 64 + fr, cw = wc * 32 + 8 * fq; const size_t rowt = (size_t)u.pm * 256;
        if (pn < 4) {
            unsigned char* base = ws + OFF_QA + (rowt * 1024 + pn * 256) * 2; unsigned lo = (rl * 1024 + cw) * 2; OPAQUE(lo);
#pragma unroll
            for (int ai = 0; ai < 2; ++ai)
#pragma unroll
                for (int m = 0; m < 4; ++m)
#pragma unroll
                    for (int bj = 0; bj < 2; ++bj) *(u32x4*)(base + (lo + (unsigned)(((ai * 128 + m * 16) * 1024 + bj * 128) * 2))) = pack8(acc[ai][bj][m][0], acc[ai][bj][m][1]);
        } else if (pn < 10) {
            const int br = pn - 4;
            if (br == 3 || br == 5) {
                const int b = u.pm >> 3, sb = (u.pm & 7) * 256;
                unsigned char* base = ws + OFF_BRA + (size_t)br * 32 * MiB + ((size_t)b * 256 * 2048 + sb) * 2; unsigned lo = (cw * 2048 + rl) * 2; OPAQUE(lo);
#pragma unroll
                for (int ai = 0; ai < 2; ++ai)
#pragma unroll
                    for (int m = 0; m < 4; ++m)
#pragma unroll
                        for (int bj = 0; bj < 2; ++bj) { const f32x4 v0 = acc[ai][bj][m][0], v1 = acc[ai][bj][m][1];
#pragma unroll
                            for (int e = 0; e < 4; ++e) { *(bf16_t*)(base + (lo + (unsigned)(((bj * 128 + e) * 2048 + ai * 128 + m * 16) * 2))) = f2bf(v0[e]);
                                *(bf16_t*)(base + (lo + (unsigned)(((bj * 128 + e + 4) * 2048 + ai * 128 + m * 16) * 2))) = f2bf(v1[e]); } }
            } else {
                unsigned char* base = ws + OFF_BRA + (size_t)br * 32 * MiB + rowt * 256 * 2; unsigned lo = (rl * 256 + cw) * 2; OPAQUE(lo);
#pragma unroll
                for (int ai = 0; ai < 2; ++ai)
#pragma unroll
                    for (int m = 0; m < 4; ++m)
#pragma unroll
                        for (int bj = 0; bj < 2; ++bj) *(u32x4*)(base + (lo + (unsigned)(((ai * 128 + m * 16) * 256 + bj * 128) * 2))) = pack8(acc[ai][bj][m][0], acc[ai][bj][m][1]);
            }
        } else {
            if (cw < 48) {
                unsigned char* base = ws + OFF_GATE + rowt * 48 * 4; unsigned lo = (rl * 48 + cw) * 4; OPAQUE(lo);
                float bg[8];
#pragma unroll
                for (int e = 0; e < 8; ++e) bg[e] = (cw + e < 48) ? b_gate[cw + e] : 0.f;
#pragma unroll
                for (int ai = 0; ai < 2; ++ai)
#pragma unroll
                    for (int m = 0; m < 4; ++m) { const f32x4 v0 = acc[ai][0][m][0], v1 = acc[ai][0][m][1];
#pragma unroll
                        for (int e = 0; e < 4; ++e) { if (cw + e < 48) *(float*)(base + (lo + (unsigned)(((ai * 128 + m * 16) * 48 + e) * 4))) = sigmoidf_(v0[e] + bg[e]);
                            if (cw + 4 + e < 48) *(float*)(base + (lo + (unsigned)(((ai * 128 + m * 16) * 48 + e + 4) * 4))) = sigmoidf_(v1[e] + bg[4 + e]); } }
            }
        }
    }
};
struct EpiQKVB {
    unsigned char* ws;
    __device__ __forceinline__ void operator()(const Acc& acc, const Unit& u, int wr, int wc, int fr, int fq) const {
        const int pn = u.pn; const unsigned rl = wr * 64 + fr, cw = wc * 32 + 8 * fq; const size_t rowt = (size_t)u.pm * 256;
        if (pn < 12) {
            unsigned char* base = ws + OFF_QB + (rowt * 3072 + pn * 256) * 2; unsigned lo = (rl * 3072 + cw) * 2; OPAQUE(lo);
#pragma unroll
            for (int ai = 0; ai < 2; ++ai)
#pragma unroll
                for (int m = 0; m < 4; ++m)
#pragma unroll
                    for (int bj = 0; bj < 2; ++bj) *(u32x4*)(base + (lo + (unsigned)(((ai * 128 + m * 16) * 3072 + bj * 128) * 2))) = pack8(acc[ai][bj][m][0], acc[ai][bj][m][1]);
        } else {
            const int idx = pn - 12, gi = idx >> 1, isV = idx & 1, dsh = 2 * gi, lsh = 11 - dsh, b = u.pm >> 3, sb = ((u.pm & 7) * 256) >> dsh;
            const unsigned posl = ((rl & ((1u << dsh) - 1u)) << lsh) + (rl >> dsh);
            if (isV) {
                unsigned char* base = ws + OFF_KVB + (size_t)idx * 32 * MiB + ((size_t)b * 256 * 2048 + sb) * 2; unsigned lo = (cw * 2048 + posl) * 2; OPAQUE(lo);
#pragma unroll
                for (int ai = 0; ai < 2; ++ai)
#pragma unroll
                    for (int m = 0; m < 4; ++m) { const unsigned ro = (unsigned)((ai * 128 + m * 16) >> dsh) * 2u;
#pragma unroll
                        for (int bj = 0; bj < 2; ++bj) { const f32x4 v0 = acc[ai][bj][m][0], v1 = acc[ai][bj][m][1];
#pragma unroll
                            for (int e = 0; e < 4; ++e) { *(bf16_t*)(base + (lo + ro + (unsigned)(((bj * 128 + e) * 2048) * 2))) = f2bf(v0[e]);
                                *(bf16_t*)(base + (lo + ro + (unsigned)(((bj * 128 + e + 4) * 2048) * 2))) = f2bf(v1[e]); } } }
            } else {
                unsigned char* base = ws + OFF_KVB + (size_t)idx * 32 * MiB + (((size_t)b * 4 * 2048 + sb) * 64) * 2; unsigned lo = ((cw >> 6) * 2048 * 64 + posl * 64 + (cw & 63)) * 2; OPAQUE(lo);
#pragma unroll
                for (int ai = 0; ai < 2; ++ai)
#pragma unroll
                    for (int m = 0; m < 4; ++m) { const unsigned ro = (unsigned)((ai * 128 + m * 16) >> dsh) * 128u;
#pragma unroll
                        for (int bj = 0; bj < 2; ++bj) *(u32x4*)(base + (lo + ro + (unsigned)(bj * 2 * 2048 * 64 * 2))) = pack8(acc[ai][bj][m][0], acc[ai][bj][m][1]); }
            }
        }
    }
};
struct EpiResid {
    const float* xin; float* xout;
    __device__ __forceinline__ void operator()(const Acc& acc, const Unit& u, int wr, int wc, int fr, int fq) const {
        const unsigned rl = wr * 64 + fr, cw = wc * 32 + 8 * fq; const size_t t0 = ((size_t)u.pm * 256 * 1024 + u.pn * 256) * 4;
        const unsigned char* bi = (const unsigned char*)xin + t0; unsigned char* bo = (unsigned char*)xout + t0; unsigned lo = (rl * 1024 + cw) * 4; OPAQUE(lo);
#pragma unroll
        for (int ai = 0; ai < 2; ++ai)
#pragma unroll
            for (int m = 0; m < 4; ++m)
#pragma unroll
                for (int bj = 0; bj < 2; ++bj) { const unsigned o = lo + (unsigned)(((ai * 128 + m * 16) * 1024 + bj * 128) * 4);
                    const f32x4 a = *(const f32x4*)(bi + o), c = *(const f32x4*)(bi + o + 16);
                    *(f32x4*)(bo + o) = a + acc[ai][bj][m][0]; *(f32x4*)(bo + o + 16) = c + acc[ai][bj][m][1]; }
    }
};
struct EpiSwiglu {
    unsigned char* act;
    __device__ __forceinline__ void operator()(const Acc& acc, const Unit& u, int wr, int wc, int fr, int fq) const {
        const unsigned rl = wr * 64 + fr, cw = wc * 32 + 8 * fq; unsigned char* base = act + ((size_t)u.pm * 256 * FFH + u.pn * 128) * 2; unsigned lo = (rl * FFH + cw) * 2; OPAQUE(lo);
#pragma unroll
        for (int ai = 0; ai < 2; ++ai)
#pragma unroll
            for (int m = 0; m < 4; ++m) { f32x4 h0, h1;
#pragma unroll
                for (int e = 0; e < 4; ++e) { const float a0 = acc[ai][0][m][0][e], a1 = acc[ai][0][m][1][e];
                    h0[e] = a0 * sigmoidf_(a0) * acc[ai][1][m][0][e]; h1[e] = a1 * sigmoidf_(a1) * acc[ai][1][m][1][e]; }
                *(u32x4*)(base + (lo + (unsigned)((ai * 128 + m * 16) * FFH * 2))) = pack8(h0, h1); }
    }
};
struct EpiCmp1 {
    unsigned char* ws;
    __device__ __forceinline__ void operator()(const Acc& acc, const Unit& u, int wr, int wc, int fr, int fq) const {
        const int kv = u.pn; const unsigned rl = wr * 64 + fr, cw = wc * 32 + 8 * fq;
        unsigned char* base = ws + OFF_G1 + (((size_t)kv * 16384 + (size_t)u.pm * 256) * 256) * 2; unsigned lo = (rl * 256 + cw) * 2; OPAQUE(lo);
        const unsigned char* bp = ws + OFF_BIASP + (size_t)kv * 8 * 256 * 4; unsigned blo = cw * 4; OPAQUE(blo);
#pragma unroll
        for (int bj = 0; bj < 2; ++bj) {
            float bias[8];
#pragma unroll
            for (int e = 0; e < 8; ++e) { float sb = 0.f;
#pragma unroll
                for (int q = 0; q < 8; ++q) sb += *(const float*)(bp + (blo + (unsigned)((q * 256 + bj * 128 + e) * 4))); bias[e] = sb; }
#pragma unroll
            for (int ai = 0; ai < 2; ++ai)
#pragma unroll
                for (int m = 0; m < 4; ++m) { f32x4 h0, h1;
#pragma unroll
                    for (int e = 0; e < 4; ++e) {
                        const float x0 = acc[ai][bj][m][0][e] + bias[e], x1 = acc[ai][bj][m][1][e] + bias[4 + e];
                        const float u0 = 0.7978845608028654f * (x0 + 0.044715f * x0 * x0 * x0), u1 = 0.7978845608028654f * (x1 + 0.044715f * x1 * x1 * x1);
                        h0[e] = x0 * sigmoidf_(2.f * u0); h1[e] = x1 * sigmoidf_(2.f * u1); }
                    *(u32x4*)(base + (lo + (unsigned)(((ai * 128 + m * 16) * 256 + bj * 128) * 2))) = pack8(h0, h1); }
        }
    }
};

__device__ __forceinline__ void conv_weight(const float* W, int K, int N, const float* gain, bf16_t* WT, int row_off, int mode, LAS float* scr, int gw, int NGW, int lane) {
    const int nnb = (N + 31) / 32, nitems = (K / 64) * nnb;
    for (int item = gw; item < nitems; item += NGW) {
        const int kb = item / nnb, nb = item % nnb, k0 = 64 * kb, n0 = 32 * nb;
#pragma unroll 8
        for (int i = 0; i < 32; ++i) { const int kk = 2 * i + (lane >> 5), n = n0 + (lane & 31);
            float v = (n < N) ? W[(size_t)(k0 + kk) * N + n] : 0.f; if (gain) v *= gain[k0 + kk]; scr[kk * 33 + (lane & 31)] = v; }
        LDS_WAIT();
        int dr0 = row_off + n0;
        if (mode == 1) dr0 = (n0 < FFH) ? ((n0 >> 7) * 256 + (n0 & 127)) : ((((n0 - FFH) >> 7) * 256) + 128 + ((n0 - FFH) & 127));
        const int c = lane & 7;
#pragma unroll
        for (int j = 0; j < 4; ++j) { const int nn = (lane >> 3) + 8 * j; const LAS float* s = scr + (8 * c) * 33 + nn;
            u32x4 o; o.x = cvt_pk_bf16(s[0 * 33], s[1 * 33]); o.y = cvt_pk_bf16(s[2 * 33], s[3 * 33]); o.z = cvt_pk_bf16(s[4 * 33], s[5 * 33]); o.w = cvt_pk_bf16(s[6 * 33], s[7 * 33]);
            if (n0 + nn < N) *(u32x4*)(WT + (size_t)(dr0 + nn) * K + k0 + 8 * c) = o; }
        LDS_WAIT();
    }
}
__device__ __forceinline__ void norm_rows(const float* x, bf16_t* h, int gw, int NGW, int lane) {
    for (int row = gw; row < T_TOK; row += NGW) {
        const f32x4* xr = (const f32x4*)(x + (size_t)row * DM) + lane; f32x4 v[4]; float s = 0.f;
#pragma unroll
        for (int j = 0; j < 4; ++j) { v[j] = xr[64 * j]; s += (v[j][0] * v[j][0] + v[j][1] * v[j][1]) + (v[j][2] * v[j][2] + v[j][3] * v[j][3]); }
        const float r = 1.f / sqrtf(wave_sum(s) * (1.f / DM) + 1e-6f);
        u32x2* o = (u32x2*)(h + (size_t)row * DM) + lane;
#pragma unroll
        for (int j = 0; j < 4; ++j) { u32x2 w; w.x = cvt_pk_bf16(v[j][0] * r, v[j][1] * r); w.y = cvt_pk_bf16(v[j][2] * r, v[j][3] * r); o[64 * j] = w; }
    }
}
__device__ __forceinline__ void final_norm_rows(float* x, const float* gain, int gw, int NGW, int lane) {
    f32x4 gv[4];
#pragma unroll
    for (int j = 0; j < 4; ++j) gv[j] = ((const f32x4*)gain)[lane + 64 * j];
    for (int row = gw; row < T_TOK; row += NGW) {
        f32x4* xr = (f32x4*)(x + (size_t)row * DM) + lane; f32x4 v[4]; float s = 0.f;
#pragma unroll
        for (int j = 0; j < 4; ++j) { v[j] = xr[64 * j]; s += (v[j][0] * v[j][0] + v[j][1] * v[j][1]) + (v[j][2] * v[j][2] + v[j][3] * v[j][3]); }
        const float r = 1.f / sqrtf(wave_sum(s) * (1.f / DM) + 1e-6f);
#pragma unroll
        for (int j = 0; j < 4; ++j) xr[64 * j] = v[j] * r * gv[j];
    }
}

struct SoftState { float m, l; f32x16 o0, o1; };
struct KFrag { bf16x8 k0, k1, k2, k3; };
__device__ __forceinline__ bf16x8 ld_v8(const char* p) { const u64 lo = *(const u64*)p, hi = *(const u64*)(p + 16); u32x4 t; t.x = (unsigned)lo; t.y = (unsigned)(lo >> 32); t.z = (unsigned)hi; t.w = (unsigned)(hi >> 32); return __builtin_bit_cast(bf16x8, t); }
__device__ __forceinline__ bf16x8 pk_lo(const f32x16& p) { u32x4 t; t.x = cvt_pk_bf16(p[0], p[1]); t.y = cvt_pk_bf16(p[2], p[3]); t.z = cvt_pk_bf16(p[4], p[5]); t.w = cvt_pk_bf16(p[6], p[7]); return __builtin_bit_cast(bf16x8, t); }
__device__ __forceinline__ bf16x8 pk_hi(const f32x16& p) { u32x4 t; t.x = cvt_pk_bf16(p[8], p[9]); t.y = cvt_pk_bf16(p[10], p[11]); t.z = cvt_pk_bf16(p[12], p[13]); t.w = cvt_pk_bf16(p[14], p[15]); return __builtin_bit_cast(bf16x8, t); }
__device__ __forceinline__ void load_k(KFrag& f, const char* kp) { f.k0 = *(const bf16x8*)kp; f.k1 = *(const bf16x8*)(kp + 32); f.k2 = *(const bf16x8*)(kp + 64); f.k3 = *(const bf16x8*)(kp + 96); }
__device__ __forceinline__ void tile_compute(SoftState& st, const bf16x8 (&qf)[4], const KFrag& f, const char* vp, size_t v32, const LAS unsigned char* lds, unsigned vb, int dist0, int max_dist, bool masked) {
    const bf16x8 v00 = ld_v8(vp), v01 = ld_v8(vp + 32), v10 = ld_v8(vp + v32), v11 = ld_v8(vp + v32 + 32);
    f32x16 s = {0.f, 0.f, 0.f, 0.f, 0.f, 0.f, 0.f, 0.f, 0.f, 0.f, 0.f, 0.f, 0.f, 0.f, 0.f, 0.f};
    s = mfma32(f.k0, qf[0], s); s = mfma32(f.k1, qf[1], s); s = mfma32(f.k2, qf[2], s); s = mfma32(f.k3, qf[3], s);
    f32x16 t;
#pragma unroll
    for (int i = 0; i < 16; ++i) t[i] = s[i] * SC2 + *(const LAS float*)(lds + vb + 4 * (27 - ((i & 3) + 8 * (i >> 2))));
    if (masked) {
#pragma unroll
        for (int i = 0; i < 16; ++i) t[i] = ((unsigned)(dist0 - ((i & 3) + 8 * (i >> 2))) <= (unsigned)max_dist) ? t[i] : -__builtin_inff();
    }
    float mx = fmaxf(fmaxf(fmaxf(t[0], t[1]), fmaxf(t[2], t[3])), fmaxf(fmaxf(t[4], t[5]), fmaxf(t[6], t[7])));
    mx = fmaxf(mx, fmaxf(fmaxf(fmaxf(t[8], t[9]), fmaxf(t[10], t[11])), fmaxf(fmaxf(t[12], t[13]), fmaxf(t[14], t[15]))));
    mx = fmaxf(mx, __shfl_xor(mx, 32));
    if (__builtin_amdgcn_ballot_w64(mx > st.m) != 0ull) { const float mnew = fmaxf(mx, st.m), alpha = fexp2(st.m - mnew); st.l *= alpha; st.o0 *= alpha; st.o1 *= alpha; st.m = mnew; }
    float ls = 0.f;
#pragma unroll
    for (int i = 0; i < 16; ++i) { t[i] = fexp2(t[i] - st.m); ls += t[i]; }
    st.l += ls;
    const bf16x8 pb0 = pk_lo(t), pb1 = pk_hi(t);
    st.o0 = mfma32(v00, pb0, st.o0); st.o0 = mfma32(v01, pb1, st.o0); st.o1 = mfma32(v10, pb0, st.o1); st.o1 = mfma32(v11, pb1, st.o1);
}
__device__ __forceinline__ void soft_init(SoftState& st) { st.m = -1e30f; st.l = 0.f;
#pragma unroll
    for (int i = 0; i < 16; ++i) { st.o0[i] = 0.f; st.o1[i] = 0.f; } }

__device__ __forceinline__ void run_range(SoftState& st, const bf16x8 (&qf)[4], const char* Kl, int kstride, const char* Vl, size_t v32, int kt_lo, int kt_hi,
                                          int qpos, int qmin, int qmax, int max_dist, unsigned tb_head, const LAS unsigned char* lds, int h) {
    KFrag A, B;
    load_k(A, Kl + (size_t)kt_lo * 32 * kstride);
#pragma unroll 1
    for (int kt = kt_lo; kt <= kt_hi; ++kt) {
        if (kt + 1 <= kt_hi) load_k(B, Kl + (size_t)(kt + 1) * 32 * kstride);
        const int kbase = 32 * kt, dist0 = qpos - kbase - 4 * h; const unsigned vb = tb_head + (unsigned)(4 * (dist0 - 27));
        const bool masked = !(qmin - kbase - 31 >= 0 && qmax - kbase <= max_dist);
        tile_compute(st, qf, A, Vl + kt * 64, v32, lds, vb, dist0, max_dist, masked);
        A = B;
    }
}

constexpr int ATT_TAB = 1024  , ATT_HS_A = 2056  , ATT_HS_B = 136  , ATT_NEG = LDS_NEG;

__device__ __forceinline__ void phaseA_attn(unsigned char* ws, LAS unsigned char* lds, int gw, int NGW, int lane) {
    const int r = lane & 31, h = lane >> 5, tk = r >> 2, rr = r & 3;
    const LAS unsigned char* lut = lds + LDS_LUT; const LAS float* bias2 = (const LAS float*)(lds + LDS_BIAS);
    { LAS float* tab = (LAS float*)(lds + ATT_TAB);
      for (int i = threadIdx.x; i < 16 * ATT_HS_A; i += 512) { const int hd = i / ATT_HS_A, d = i - hd * ATT_HS_A; tab[i] = d < 2048 ? bias2[(int)lut[d] * 16 + hd] : 0.f; }
      if (threadIdx.x < 256) ((LAS float*)lds)[threadIdx.x] = 0.f;
      if (threadIdx.x < 64) ((LAS float*)(lds + ATT_NEG))[threadIdx.x] = -__builtin_inff();
      __syncthreads(); }
    for (int item = gw; item < 32768; item += NGW) {
        const int bg = item >> 8, ti = ((item & 255) + 16 * (item >> 11)) & 255, b = bg >> 2, g = bg & 3, s0 = ti * 8, s = s0 + tk, head = g * 4 + rr, cur = s0 >> 6;
        const size_t tok = (size_t)b * 2048 + s;
        const LAS float* bias2h = bias2 + head;
        const unsigned tb_head = (unsigned)(ATT_TAB + head * ATT_HS_A * 4);
        bf16x8 qf[4];
        { const char* qp = (const char*)ws + OFF_QA + (tok * 1024 + head * 64 + 8 * h) * 2;
#pragma unroll
          for (int ks = 0; ks < 4; ++ks) qf[ks] = *(const bf16x8*)(qp + 32 * ks); }
        const float* gp = (const float*)(ws + OFF_GATE) + tok * 48 + head * 3; const float g_cmp = gp[0], g_sel = gp[1], g_win = gp[2];
        unsigned tp[16]; unsigned sel;
        {
            const char* Kc = (const char*)ws + OFF_KCMP + (size_t)bg * 128 * 128; const char* Vc = (const char*)ws + OFF_VCMPT + (size_t)bg * 64 * 256;
            f32x16 sc[4];
#pragma unroll
            for (int c = 0; c < 4; ++c) { const char* kp = Kc + (32 * c + r) * 128 + 16 * h; f32x16 a = {0.f, 0.f, 0.f, 0.f, 0.f, 0.f, 0.f, 0.f, 0.f, 0.f, 0.f, 0.f, 0.f, 0.f, 0.f, 0.f};
#pragma unroll
                for (int ks = 0; ks < 4; ++ks) a = mfma32(*(const bf16x8*)(kp + 32 * ks), qf[ks], a); sc[c] = a; }
            __builtin_amdgcn_sched_barrier(0);
            float mx = -1e30f;
#pragma unroll
            for (int c = 0; c < 4; ++c)
#pragma unroll
                for (int i = 0; i < 16; ++i) { const int n = 32 * c + (i & 3) + 8 * (i >> 2) + 4 * h, dist = s - 16 * n - 31; const bool valid = dist >= 0; const int idx = dist < 0 ? 0 : dist;
                    const float t = valid ? sc[c][i] * SC2 + bias2h[(int)lut[idx] * 16] : -1e30f; sc[c][i] = t; mx = fmaxf(mx, t); }
            mx = fmaxf(mx, __shfl_xor(mx, 32)); float l = 0.f;
#pragma unroll
            for (int c = 0; c < 4; ++c)
#pragma unroll
                for (int i = 0; i < 16; ++i) { const float pv = sc[c][i] > -1e29f ? fexp2(sc[c][i] - mx) : 0.f; sc[c][i] = pv; l += pv; }
            l += __shfl_xor(l, 32); const float inv = 1.f / fmaxf(l, 1e-30f);
#pragma unroll
            for (int c = 0; c < 4; ++c) sc[c] *= inv;
            __builtin_amdgcn_sched_barrier(0);
            f32x16 oc0 = {0.f, 0.f, 0.f, 0.f, 0.f, 0.f, 0.f, 0.f, 0.f, 0.f, 0.f, 0.f, 0.f, 0.f, 0.f, 0.f}, oc1 = oc0;
#pragma unroll
            for (int c = 0; c < 4; ++c) { const bf16x8 pb0 = pk_lo(sc[c]), pb1 = pk_hi(sc[c]); const char* vp0 = Vc + r * 256 + (32 * c + 4 * h) * 2; const char* vp1 = vp0 + 32 * 256;
                oc0 = mfma32(ld_v8(vp0), pb0, oc0); oc0 = mfma32(ld_v8(vp0 + 32), pb1, oc0); oc1 = mfma32(ld_v8(vp1), pb0, oc1); oc1 = mfma32(ld_v8(vp1 + 32), pb1, oc1); }
            oc0 *= g_cmp; oc1 *= g_cmp;
#pragma unroll
            for (int q = 0; q < 8; ++q) { tp[q] = cvt_pk_bf16(oc0[2 * q], oc0[2 * q + 1]); tp[8 + q] = cvt_pk_bf16(oc1[2 * q], oc1[2 * q + 1]); }
            __builtin_amdgcn_sched_barrier(0);
            float own[16], oth[16], pl[16];
#pragma unroll
            for (int cgi = 0; cgi < 16; ++cgi) pl[cgi] = __shfl_xor(sc[cgi >> 2][4 * (cgi & 3) + 3], 32);
#pragma unroll
            for (int cgi = 0; cgi < 16; ++cgi) { const int c = cgi >> 2, q4 = 4 * (cgi & 3); float v = (sc[c][q4] + sc[c][q4 + 1]) + (sc[c][q4 + 2] + sc[c][q4 + 3]);
                const float prevh0 = cgi > 0 ? pl[cgi > 0 ? cgi - 1 : 0] : 0.f; v += h ? pl[cgi] : prevh0;
                v += __shfl_xor(v, 1); v += __shfl_xor(v, 2); own[cgi] = v; }
#pragma unroll
            for (int cgi = 0; cgi < 16; ++cgi) oth[cgi] = __shfl_xor(own[cgi], 32);
            __builtin_amdgcn_sched_barrier(0);
            float cand[32];
#pragma unroll
            for (int cgi = 0; cgi < 16; ++cgi) { const float ve = h ? oth[cgi] : own[cgi], vo = h ? own[cgi] : oth[cgi];
                cand[2 * cgi] = (2 * cgi >= 1 && 2 * cgi <= cur - 2) ? ve : -2.f; cand[2 * cgi + 1] = (2 * cgi + 1 <= cur - 2) ? vo : -2.f; }
            float prev = 3.0e38f;
#pragma unroll 1
            for (int round = 0; round < 5; ++round) { float best = -1.f;
#pragma unroll
                for (int j = 0; j < 32; ++j) { const float v = cand[j] < prev ? cand[j] : -2.f; best = fmaxf(best, v); }
                prev = best; }
            const float thr = fmaxf(prev, 0.f);
            sel = 1u | (1u << cur) | (cur > 0 ? (1u << (cur - 1)) : 0u);
#pragma unroll
            for (int j = 1; j < 32; ++j) sel |= (cand[j] >= thr) ? (1u << j) : 0u;
        }
        {
            unsigned um = sel; um |= __shfl_xor(um, 4); um |= __shfl_xor(um, 8); um |= __shfl_xor(um, 16); um = __builtin_amdgcn_readfirstlane(um);
            const char* Kl = (const char*)ws + OFF_BRA + 2 * 32 * MiB + ((size_t)b * 2048 * 256 + g * 64) * 2 + r * 512 + 16 * h;
            const char* Vl = (const char*)ws + OFF_BRA + 3 * 32 * MiB + (size_t)bg * 64 * 4096 + r * 4096 + 8 * h;
            SoftState st; soft_init(st);
            KFrag A, B; int half = 0, kb = 64 * __builtin_ctz(um), kbn = 0; bool has;
            load_k(A, Kl + (size_t)kb * 512);
#pragma unroll 1
            for (;;) {
                if (half) um &= um - 1; half ^= 1; has = um != 0u; if (has) { kbn = 64 * __builtin_ctz(um) + 32 * half; load_k(B, Kl + (size_t)kbn * 512); }
                { const int jb = kb >> 6, dist0 = s - kb - 4 * h; const unsigned vb = ((sel >> jb) & 1u) ? tb_head + (unsigned)(4 * (dist0 - 27)) : (unsigned)ATT_NEG;
                  tile_compute(st, qf, A, Vl + kb * 2, 32 * 4096, lds, vb, dist0, 1 << 20, jb >= cur); }
                if (!has) break; kb = kbn; A = B;
            }
            const float lt = st.l + __shfl_xor(st.l, 32), sc = g_sel / fmaxf(lt, 1e-30f);
#pragma unroll
            for (int q = 0; q < 8; ++q) { tp[q] = cvt_pk_bf16(__uint_as_float(tp[q] << 16) + st.o0[2 * q] * sc, __uint_as_float(tp[q] & 0xffff0000u) + st.o0[2 * q + 1] * sc);
                tp[8 + q] = cvt_pk_bf16(__uint_as_float(tp[8 + q] << 16) + st.o1[2 * q] * sc, __uint_as_float(tp[8 + q] & 0xffff0000u) + st.o1[2 * q + 1] * sc); }
        }
        {
            const char* Kl = (const char*)ws + OFF_BRA + 4 * 32 * MiB + ((size_t)b * 2048 * 256 + g * 64) * 2 + r * 512 + 16 * h;
            const char* Vl = (const char*)ws + OFF_BRA + 5 * 32 * MiB + (size_t)bg * 64 * 4096 + r * 4096 + 8 * h;
            SoftState st; soft_init(st);
            const int lo = s0 - 255, kt_lo = lo < 0 ? 0 : (lo >> 5), kt_hi = (s0 + 7) >> 5;
            run_range(st, qf, Kl, 512, Vl, 32 * 4096, kt_lo, kt_hi, s, s0, s0 + 7, 255, tb_head, lds, h);
            const float lt = st.l + __shfl_xor(st.l, 32), sc = g_win / fmaxf(lt, 1e-30f);
#pragma unroll
            for (int q = 0; q < 8; ++q) { tp[q] = cvt_pk_bf16(__uint_as_float(tp[q] << 16) + st.o0[2 * q] * sc, __uint_as_float(tp[q] & 0xffff0000u) + st.o0[2 * q + 1] * sc);
                tp[8 + q] = cvt_pk_bf16(__uint_as_float(tp[8 + q] << 16) + st.o1[2 * q] * sc, __uint_as_float(tp[8 + q] & 0xffff0000u) + st.o1[2 * q + 1] * sc); }
        }
        { unsigned char* op = ws + OFF_O + (tok * 1024 + head * 64 + 4 * h) * 2;
#pragma unroll
          for (int q = 0; q < 4; ++q) { u32x2 w; w.x = tp[2 * q]; w.y = tp[2 * q + 1]; *(u32x2*)(op + 16 * q) = w; u32x2 w2; w2.x = tp[8 + 2 * q]; w2.y = tp[8 + 2 * q + 1]; *(u32x2*)(op + 64 + 16 * q) = w2; } }
    }
}

__device__ __forceinline__ void phaseB_attn(unsigned char* ws, LAS unsigned char* lds, int gw, int NGW, int lane) {
    const int r = lane & 31, h = lane >> 5, tk = r >> 2, rr = r & 3;
    const LAS unsigned char* lut = lds + LDS_LUT; const LAS float* bias2 = (const LAS float*)(lds + LDS_BIAS);
    { LAS float* tab = (LAS float*)(lds + ATT_TAB);
      for (int i = threadIdx.x; i < 3 * 16 * ATT_HS_B; i += 512) { const int gh = i / ATT_HS_B, d = i - gh * ATT_HS_B, gi = gh >> 4, hd = gh & 15; int td = d << (2 * gi); td = td > 2047 ? 2047 : td;
          tab[i] = bias2[(int)lut[td] * 16 + hd]; }
      if (threadIdx.x < 256) ((LAS float*)lds)[threadIdx.x] = 0.f;
      __syncthreads(); }
    for (int item = gw; item < 32768; item += NGW) {
        const int bg = item >> 8, cc = (item >> 4) & 15, r16 = item & 15, b = bg >> 2, g = bg & 3, s0 = cc * 128 + r16, s = s0 + 16 * tk, head = g * 4 + rr;
        const size_t tok = (size_t)b * 2048 + s;
        SoftState st; soft_init(st);
#pragma unroll 1
        for (int gi = 0; gi < 3; ++gi) {
            const int dsh = 2 * gi, lsh = 11 - dsh, res = s0 & ((1 << dsh) - 1);
            bf16x8 qf[4];
            { const char* qp = (const char*)ws + OFF_QB + (tok * 3072 + gi * 1024 + head * 64 + 8 * h) * 2;
#pragma unroll
              for (int ks = 0; ks < 4; ++ks) qf[ks] = *(const bf16x8*)(qp + 32 * ks); }
            const char* Kl = (const char*)ws + OFF_KVB + (size_t)(gi * 2) * 32 * MiB + ((size_t)bg * 2048 + ((size_t)res << lsh)) * 128 + r * 128 + 16 * h;
            const char* Vl = (const char*)ws + OFF_KVB + (size_t)(gi * 2 + 1) * 32 * MiB + (size_t)bg * 64 * 4096 + ((size_t)res << lsh) * 2 + r * 4096 + 8 * h;
            const int ql = s >> dsh, qmin = s0 >> dsh, qmax = (s0 + 112) >> dsh, ql_lo = qmin - 128, kt_lo = ql_lo < 0 ? 0 : (ql_lo >> 5), kt_hi = qmax >> 5;
            const unsigned tb_head = (unsigned)(ATT_TAB + (gi * 16 + head) * ATT_HS_B * 4);
            run_range(st, qf, Kl, 128, Vl, 32 * 4096, kt_lo, kt_hi, ql, qmin, qmax, 128, tb_head, lds, h);
        }
        const float lt = st.l + __shfl_xor(st.l, 32), sc = 1.f / fmaxf(lt, 1e-30f);
        const f32x16 tot0 = st.o0 * sc, tot1 = st.o1 * sc;
        { unsigned char* op = ws + OFF_O + (tok * 1024 + head * 64 + 4 * h) * 2;
#pragma unroll
          for (int q = 0; q < 4; ++q) { u32x2 w; w.x = cvt_pk_bf16(tot0[4 * q], tot0[4 * q + 1]); w.y = cvt_pk_bf16(tot0[4 * q + 2], tot0[4 * q + 3]); *(u32x2*)(op + 16 * q) = w;
              u32x2 w2; w2.x = cvt_pk_bf16(tot1[4 * q], tot1[4 * q + 1]); w2.y = cvt_pk_bf16(tot1[4 * q + 2], tot1[4 * q + 3]); *(u32x2*)(op + 64 + 16 * q) = w2; } }
    }
}

__device__ __forceinline__ void phase_cmp2(unsigned char* ws, int gw, int NGW, int lane) {
    const int r = lane & 31, h = lane >> 5;
    for (int item = gw; item < 1024; item += NGW) {
        const int kv = item >> 9, rt = item & 511;
        const char* ap = (const char*)ws + OFF_G1 + (((size_t)kv * 16384 + rt * 32 + r) * 256 + 8 * h) * 2;
        const char* bp = (const char*)ws + OFF_W2 + (size_t)kv * 32768 + ((size_t)r * 256 + 8 * h) * 2;
        f32x16 a0 = {0.f, 0.f, 0.f, 0.f, 0.f, 0.f, 0.f, 0.f, 0.f, 0.f, 0.f, 0.f, 0.f, 0.f, 0.f, 0.f}, a1 = a0;
#pragma unroll
        for (int ks = 0; ks < 16; ++ks) { const bf16x8 a = *(const bf16x8*)(ap + 32 * ks);
            a0 = mfma32(a, *(const bf16x8*)(bp + 32 * ks), a0); a1 = mfma32(a, *(const bf16x8*)(bp + 32 * 256 * 2 + 32 * ks), a1); }
#pragma unroll
        for (int i = 0; i < 16; ++i) { const int row = rt * 32 + (i & 3) + 8 * (i >> 2) + 4 * h, gq = row & 3, n = (row >> 2) & 127, b = row >> 9, bgi = b * 4 + gq;
            if (kv == 0) { bf16_t* o = (bf16_t*)(ws + OFF_KCMP) + ((size_t)bgi * 128 + n) * 64; o[r] = f2bf(a0[i]); o[r + 32] = f2bf(a1[i]); }
            else { bf16_t* o = (bf16_t*)(ws + OFF_VCMPT) + (size_t)bgi * 64 * 128 + n; o[(size_t)r * 128] = f2bf(a0[i]); o[(size_t)(r + 32) * 128] = f2bf(a1[i]); } }
    }
}

__global__ __launch_bounds__(512, 2) void yoco_mega(Params p) {
    extern __shared__ __attribute__((aligned(16))) unsigned char shm[];
    cg::grid_group grid = cg::this_grid();
    LAS unsigned char* lds = (LAS unsigned char*)shm;
    const int tid = threadIdx.x, lane = tid & 63, wave = __builtin_amdgcn_readfirstlane(tid >> 6), gw = blockIdx.x * 8 + wave, NGW = gridDim.x * 8;
    unsigned char* ws = p.ws;
    const float* x_in = p.in[0];
    float* X = p.out;
    { LAS unsigned char* lut = lds + LDS_LUT; LAS float* bias2 = (LAS float*)(lds + LDS_BIAS);
      for (int d = tid; d < 2048; d += 512) { int bk = d; if (d >= 16) bk = 16 + (d >= 22) + (d >= 30) + (d >= 40) + (d >= 54) + (d >= 73) + (d >= 99) + (d >= 134) + (d >= 182) + (d >= 246) + (d >= 332) + (d >= 450) + (d >= 609) + (d >= 825) + (d >= 1117) + (d >= 1513); lut[d] = (unsigned char)bk; }
      bias2[tid] = p.in[1][tid] * LOG2E;
      __syncthreads(); }
    {
        LAS float* scr = (LAS float*)(lds + wave * 8448);
        const float* nm = p.in[2]; const float* nf = p.in[3];
        conv_weight(p.in[4], 1024, 2608, nm, (bf16_t*)(ws + OFF_WIN), 0, 0, scr, gw, NGW, lane);
        conv_weight(p.in[7], 2048, 256, nullptr, (bf16_t*)(ws + OFF_W1), 0, 0, scr, gw, NGW, lane);
        conv_weight(p.in[10], 2048, 256, nullptr, (bf16_t*)(ws + OFF_W1), 256, 0, scr, gw, NGW, lane);
        conv_weight(p.in[8], 256, 64, nullptr, (bf16_t*)(ws + OFF_W2), 0, 0, scr, gw, NGW, lane);
        conv_weight(p.in[11], 256, 64, nullptr, (bf16_t*)(ws + OFF_W2), 64, 0, scr, gw, NGW, lane);
        conv_weight(p.in[12], 1024, 1024, nullptr, (bf16_t*)(ws + OFF_WOUTA), 0, 0, scr, gw, NGW, lane);
        conv_weight(p.in[15], 1024, 3072, nm + 1024, (bf16_t*)(ws + OFF_WQKVB), 0, 0, scr, gw, NGW, lane);
        conv_weight(p.in[14], 1024, 1536, p.in[13], (bf16_t*)(ws + OFF_WQKVB), 3072, 0, scr, gw, NGW, lane);
        conv_weight(p.in[16], 1024, 1024, nullptr, (bf16_t*)(ws + OFF_WOUTB), 0, 0, scr, gw, NGW, lane);
        conv_weight(p.in[17], 1024, 5632, nf, (bf16_t*)(ws + OFF_WUP0), 0, 1, scr, gw, NGW, lane);
        conv_weight(p.in[17] + (size_t)1024 * 5632, 1024, 5632, nf + 1024, (bf16_t*)(ws + OFF_WUP1), 0, 1, scr, gw, NGW, lane);
        conv_weight(p.in[18], 2816, 1024, nullptr, (bf16_t*)(ws + OFF_WDN0), 0, 0, scr, gw, NGW, lane);
        conv_weight(p.in[18] + (size_t)2816 * 1024, 2816, 1024, nullptr, (bf16_t*)(ws + OFF_WDN1), 0, 0, scr, gw, NGW, lane);
        for (int item = gw; item < 64; item += NGW) { const int kv = item >> 5, ksl = (item >> 2) & 7, c = (item & 3) * 64 + lane;
            const float* pe = kv ? p.in[9] : p.in[6]; const float* w1 = kv ? p.in[10] : p.in[7]; float a = 0.f;
#pragma unroll 8
            for (int kk = ksl * 256; kk < ksl * 256 + 256; ++kk) a += pe[kk] * w1[(size_t)kk * 256 + c];
            ((float*)(ws + OFF_BIASP))[(kv * 8 + ksl) * 256 + c] = a; }
        norm_rows(x_in, (bf16_t*)(ws + OFF_H), gw, NGW, lane);
    }
    grid.sync();
    pg8::StaticOrder S;
    { pg8::Gemm g{(const char*)ws + OFF_H, (const char*)ws + OFF_WIN, 1024, 1024, 0, 0}; S.init(256, 11, gridDim.x, blockIdx.x); EpiWin E{ws, p.in[5]}; pg8::gemm_phase(lds, g, S, E); }
    grid.sync();
    { pg8::Gemm g{(const char*)ws + OFF_BRA, (const char*)ws + OFF_W1, 2048, 0, 1, 32 * MiB}; S.init(64, 2, gridDim.x, blockIdx.x); EpiCmp1 E{ws}; pg8::gemm_phase(lds, g, S, E); }
    grid.sync();
    phase_cmp2(ws, gw, NGW, lane);
    grid.sync();
    phaseA_attn(ws, lds, gw, NGW, lane);
    grid.sync();
    { pg8::Gemm g{(const char*)ws + OFF_O, (const char*)ws + OFF_WOUTA, 1024, 1024, 0, 0}; S.init(256, 4, gridDim.x, blockIdx.x); EpiResid E{x_in, X}; pg8::gemm_phase(lds, g, S, E); }
    grid.sync();
#define FFN_BLOCK(WUP, WDN) \
    norm_rows(X, (bf16_t*)(ws + OFF_H), gw, NGW, lane); \
    grid.sync(); \
    { pg8::Gemm g{(const char*)ws + OFF_H, (const char*)ws + (WUP), 1024, 1024, 0, 0}; S.init(256, 22, gridDim.x, blockIdx.x); EpiSwiglu E{ws + OFF_ACT}; pg8::gemm_phase(lds, g, S, E); } \
    grid.sync(); \
    { pg8::Gemm g{(const char*)ws + OFF_ACT, (const char*)ws + (WDN), 2816, 2816, 0, 0}; S.init(256, 4, gridDim.x, blockIdx.x); EpiResid E{X, X}; pg8::gemm_phase(lds, g, S, E); } \
    grid.sync();
    FFN_BLOCK(OFF_WUP0, OFF_WDN0)
    norm_rows(X, (bf16_t*)(ws + OFF_H), gw, NGW, lane);
    grid.sync();
    { pg8::Gemm g{(const char*)ws + OFF_H, (const char*)ws + OFF_WQKVB, 1024, 1024, 0, 0}; S.init(256, 18, gridDim.x, blockIdx.x); EpiQKVB E{ws}; pg8::gemm_phase(lds, g, S, E); }
    grid.sync();
    phaseB_attn(ws, lds, gw, NGW, lane);
    grid.sync();
    { pg8::Gemm g{(const char*)ws + OFF_O, (const char*)ws + OFF_WOUTB, 1024, 1024, 0, 0}; S.init(256, 4, gridDim.x, blockIdx.x); EpiResid E{X, X}; pg8::gemm_phase(lds, g, S, E); }
    grid.sync();
    FFN_BLOCK(OFF_WUP1, OFF_WDN1)
    final_norm_rows(X, p.in[19], gw, NGW, lane);
}

extern "C" void kernel_launch(void* const* d_in, const int* in_sizes, int n_in, void* d_out, int out_size, void* d_ws, size_t ws_size, hipStream_t stream) {
    static int grid_blocks = 0;
    if (grid_blocks == 0) {
        if (n_in != 20 || out_size != T_TOK * DM || ws_size < WS_NEED) { fprintf(stderr, "kernel_launch: unexpected shapes (n_in %d out %d ws %zu)\n", n_in, out_size, ws_size); grid_blocks = -1; return; }
        int dev = 0, cus = 0, per_cu = 0;
        hipGetDevice(&dev); hipDeviceGetAttribute(&cus, hipDeviceAttributeMultiprocessorCount, dev);
        if (hipFuncSetAttribute((const void*)yoco_mega, hipFuncAttributeMaxDynamicSharedMemorySize, LDS_TOTAL) != hipSuccess) { fprintf(stderr, "kernel_launch: hipFuncSetAttribute failed\n"); grid_blocks = -1; return; }
        if (hipOccupancyMaxActiveBlocksPerMultiprocessor(&per_cu, (const void*)yoco_mega, 512, LDS_TOTAL) != hipSuccess || per_cu < 1) { fprintf(stderr, "kernel_launch: occupancy query gave %d\n", per_cu); per_cu = 1; }
        (void)hipGetLastError();
        grid_blocks = cus * 1;
    }
    if (grid_blocks < 0) return;
    Params p{};
    for (int i = 0; i < 20; ++i) p.in[i] = (const float*)d_in[i];
    p.out = (float*)d_out; p.ws = (unsigned char*)d_ws;
    void* args[] = {&p};
    hipError_t e = hipLaunchCooperativeKernel((const void*)yoco_mega, dim3(grid_blocks), dim3(512), args, LDS_TOTAL, stream);
    if (e != hipSuccess) fprintf(stderr, "cooperative launch failed: %s (grid %d)\n", hipGetErrorString(e), grid_blocks);
}
```

```cpp
#include <hip/hip_runtime.h>
#include <hip/hip_cooperative_groups.h>
#include <cstdio>
namespace cg = cooperative_groups;

#define LAS __attribute__((address_space(3)))
typedef unsigned short bf16_t;
typedef short bf16x8 __attribute__((ext_vector_type(8)));
typedef float f32x4 __attribute__((ext_vector_type(4)));
typedef float f32x16 __attribute__((ext_vector_type(16)));
typedef unsigned u32x4 __attribute__((ext_vector_type(4)));
typedef unsigned u32x2 __attribute__((ext_vector_type(2)));
typedef unsigned long long u64;

constexpr int T_TOK = 65536, DM = 1024, SEQ = 2048, FFH = 2816;
constexpr size_t MiB = 1ull << 20;
constexpr size_t OFF_WIN = 0, OFF_WOUTA = 6 * MiB, OFF_WUP0 = 8 * MiB, OFF_WUP1 = 19 * MiB, OFF_WDN0 = 30 * MiB, OFF_WDN1 = 36 * MiB,
                 OFF_WQKVB = 42 * MiB, OFF_WOUTB = 51 * MiB, OFF_W1 = 53 * MiB  , OFF_W2 = 55 * MiB  ,
                 OFF_BIASP = 55 * MiB + 128 * 1024, OFF_KCMP = 56 * MiB, OFF_VCMPT = 58 * MiB, OFF_GATE = 60 * MiB, OFF_H = 72 * MiB,
                 OFF_O = 200 * MiB, OFF_BIG = 328 * MiB, WS_NEED = 1024 * MiB;
constexpr size_t OFF_QA = OFF_BIG, OFF_BRA = OFF_BIG + 128 * MiB  , OFF_ACT = OFF_BIG,
                 OFF_QB = OFF_BIG, OFF_KVB = OFF_BIG + 384 * MiB  , OFF_G1 = OFF_O;
constexpr int LDS_STAGE = 131072, LDS_NEG = 132608  , LDS_LUT = 133120, LDS_BIAS = LDS_LUT + 2048, LDS_TOTAL = LDS_BIAS + 2048;
constexpr float LOG2E = 1.4426950408889634f;
constexpr float SC2 = 0.125f * LOG2E;

struct Params { const float* in[20]; float* out; unsigned char* ws; };

__device__ __forceinline__ unsigned cvt_pk_bf16(float lo, float hi) { unsigned r; asm volatile("v_cvt_pk_bf16_f32 %0, %1, %2" : "=v"(r) : "v"(lo), "v"(hi)); return r; }
__device__ __forceinline__ bf16_t f2bf(float f) { return (bf16_t)(cvt_pk_bf16(f, 0.f) & 0xffffu); }
__device__ __forceinline__ u32x4 pack8(f32x4 a, f32x4 b) { u32x4 o; o.x = cvt_pk_bf16(a[0], a[1]); o.y = cvt_pk_bf16(a[2], a[3]); o.z = cvt_pk_bf16(b[0], b[1]); o.w = cvt_pk_bf16(b[2], b[3]); return o; }
__device__ __forceinline__ float fexp2(float x) { return __builtin_amdgcn_exp2f(x); }
__device__ __forceinline__ float frcp(float x) { return __builtin_amdgcn_rcpf(x); }
__device__ __forceinline__ float sigmoidf_(float x) { return frcp(1.f + fexp2(-x * LOG2E)); }
__device__ __forceinline__ float wave_sum(float v) {
#pragma unroll
    for (int o = 1; o < 64; o <<= 1) v += __shfl_xor(v, o);
    return v;
}
__device__ __forceinline__ f32x16 mfma32(bf16x8 a, bf16x8 b, f32x16 c) { return __builtin_amdgcn_mfma_f32_32x32x16_bf16(a, b, c, 0, 0, 0); }
#define LDS_WAIT() asm volatile("s_waitcnt lgkmcnt(0)" ::: "memory")

namespace pg8 {
constexpr int BM = 256, BK = 64, HALF = 128, HTB = HALF * BK * 2, NXCD = 8, WGM = 8;
__device__ __forceinline__ int lds_byte(int r, int c) { const int st = (r >> 4) * 2 + (c >> 5), rr = r & 15, cc = c & 31, ob = rr * 64 + cc * 2; return st * 1024 + (ob ^ (((ob >> 9) & 1) << 5)); }
__device__ __forceinline__ void stage_rc(int b, int& R, int& C) { const int st = b / 1024, sb = b % 1024, swz = sb ^ (((sb >> 9) & 1) << 5); R = (st >> 1) * 16 + swz / 64; C = (st & 1) * 32 + (swz % 64) / 2; }
__device__ __forceinline__ int perm32(int rho) { const int n = rho >> 4, i = rho & 15; return 8 * (i >> 2) + 4 * n + (i & 3); }
struct Unit { int pm, pn; };
struct Gemm { const char* A; const char* Bt; int K; int lda; int amode; size_t a_pn_step; };
struct StaticOrder {
    int nM, nN, nwg, G, c;
    __device__ void init(int nM_, int nN_, int G_, int c_) { nM = nM_; nN = nN_; nwg = nM * nN; G = G_; c = c_; }
    __device__ bool next(int i, Unit& u) const {
        const long L = (long)i * G + c; if (L >= nwg) return false;
        int wgid = (int)L; { const int q = nwg / NXCD, r = nwg % NXCD, xcd = wgid % NXCD, off = wgid / NXCD; wgid = (xcd < r ? xcd * (q + 1) : r * (q + 1) + (xcd - r) * q) + off; }
        const int nig = WGM * nN, gid = wgid / nig, fm = gid * WGM, gsz = (nM - fm) < WGM ? (nM - fm) : WGM;
        u.pm = fm + ((wgid % nig) % gsz); u.pn = (wgid % nig) / gsz; return true;
    }
};

template <class Epi>
__device__ __forceinline__ void gemm_phase(LAS unsigned char* lds, const Gemm g, const StaticOrder& S, const Epi& E) {
    const int tid = threadIdx.x, wid = __builtin_amdgcn_readfirstlane(tid >> 6), lane = tid & 63, wr = wid >> 2, wc = wid & 3, fr = lane & 15, fq = lane >> 4;
    const int K = g.K, nt = K / BK;
    unsigned voffA[2], voffB[2];
#pragma unroll
    for (int i = 0; i < 2; ++i) { int R, C; stage_rc(tid * 16 + i * 8192, R, C); const int Rb = (R & ~31) + perm32(R & 31);
        voffA[i] = g.amode ? (unsigned)((R >> 2) * 8192 + (R & 3) * 128 + C * 2) : (unsigned)(R * g.lda + C) * 2u;
        voffB[i] = (unsigned)(Rb * K + C) * 2u; }
    const size_t kstepA = g.amode ? 512 : (size_t)(BK * 2), kstepB = (size_t)(BK * 2);
    const size_t hstepA = g.amode ? (size_t)262144 : (size_t)HALF * g.lda * 2, hstepB = (size_t)HALF * K * 2;
    const size_t tstepA = 2 * hstepA, tstepB = 2 * hstepB;
    const unsigned ldsw = (unsigned)wid * 1024u;
    const int aoff = lds_byte(wr * 64 + fr, fq * 8), boff = lds_byte(wc * 32 + fr, fq * 8);
#define PG8_SA(b, h) (((b) * 2 + (h)) * HTB)
#define PG8_SB(b, h) ((4 + (b) * 2 + (h)) * HTB)
#define PG8_STAGE(bufoff, gbase, voff) do { _Pragma("unroll") for (int _i = 0; _i < 2; ++_i) \
        __builtin_amdgcn_global_load_lds((const unsigned*)((const char*)(gbase) + (voff)[_i]), (LAS unsigned*)(lds + (bufoff) + ldsw + _i * 8192), 16, 0, 0); } while (0)
#define PG8_LDA(dst, b, h) do { _Pragma("unroll") for (int m = 0; m < 4; ++m) _Pragma("unroll") for (int k = 0; k < 2; ++k) dst[m][k] = *(const LAS bf16x8*)(lds + PG8_SA(b, h) + aoff + m * 2048 + k * 1024); } while (0)
#define PG8_LDB(dst, b, h) do { _Pragma("unroll") for (int n = 0; n < 2; ++n) _Pragma("unroll") for (int k = 0; k < 2; ++k) dst[n][k] = *(const LAS bf16x8*)(lds + PG8_SB(b, h) + boff + n * 2048 + k * 1024); } while (0)
#define PG8_MMA(ai, bj, At, Bt) do { __builtin_amdgcn_s_setprio(1); _Pragma("unroll") for (int m = 0; m < 4; ++m) _Pragma("unroll") for (int n = 0; n < 2; ++n) _Pragma("unroll") for (int k = 0; k < 2; ++k) \
        acc[ai][bj][m][n] = __builtin_amdgcn_mfma_f32_16x16x32_bf16(Bt[n][k], At[m][k], acc[ai][bj][m][n], 0, 0, 0); __builtin_amdgcn_s_setprio(0); } while (0)
#define PG8_WAIT_V(n) asm volatile("s_waitcnt vmcnt(" #n ")" ::: "memory")
#define PG8_WAIT_L(n) asm volatile("s_waitcnt lgkmcnt(" #n ")" ::: "memory")
#define PG8_BAR __builtin_amdgcn_s_barrier()
#define PG8_SCHED __builtin_amdgcn_sched_barrier(0)
    Unit cur, nxt; int ui = 0;
    if (!S.next(0, cur)) return;
    f32x4 acc[2][2][4][2];
#pragma unroll
    for (int a = 0; a < 2; ++a)
#pragma unroll
        for (int b = 0; b < 2; ++b)
#pragma unroll
            for (int m = 0; m < 4; ++m)
#pragma unroll
                for (int n = 0; n < 2; ++n) acc[a][b][m][n] = (f32x4){0.f, 0.f, 0.f, 0.f};
    bf16x8 At[4][2], B0[2][2], B1[2][2];
    const char* cA = g.A + (size_t)cur.pm * tstepA + (size_t)cur.pn * g.a_pn_step; const char* cB = g.Bt + (size_t)cur.pn * tstepB;
    PG8_STAGE(PG8_SB(0, 0), cB, voffB); PG8_STAGE(PG8_SA(0, 0), cA, voffA); PG8_STAGE(PG8_SB(0, 1), cB + hstepB, voffB); PG8_STAGE(PG8_SA(0, 1), cA + hstepA, voffA);
    if (wr == 1) PG8_BAR;
    PG8_WAIT_V(4); PG8_BAR;
    PG8_STAGE(PG8_SB(1, 0), cB + kstepB, voffB); PG8_STAGE(PG8_SA(1, 0), cA + kstepA, voffA); PG8_STAGE(PG8_SB(1, 1), cB + hstepB + kstepB, voffB);
    PG8_WAIT_V(6); PG8_BAR;
    for (;;) {
        const bool has_next = S.next(ui + 1, nxt);
        const char* nA = has_next ? g.A + (size_t)nxt.pm * tstepA + (size_t)nxt.pn * g.a_pn_step : cA; const char* nB = has_next ? g.Bt + (size_t)nxt.pn * tstepB : cB;
        for (int t = 0; t < nt; t += 2) {
            const bool last = (t == nt - 2);
            const char* a1 = cA + (size_t)(t + 1) * kstepA;
            const char* a2 = last ? nA : cA + (size_t)(t + 2) * kstepA; const char* b2 = last ? nB : cB + (size_t)(t + 2) * kstepB;
            const char* a3 = a2 + kstepA; const char* b3 = b2 + kstepB;
            PG8_LDB(B0, 0, 0); PG8_SCHED; PG8_LDA(At, 0, 0); PG8_STAGE(PG8_SA(1, 1), a1 + hstepA, voffA);
            PG8_WAIT_L(8); PG8_BAR; PG8_WAIT_L(0); PG8_MMA(0, 0, At, B0); PG8_BAR; PG8_SCHED;
            PG8_LDB(B1, 0, 1); PG8_STAGE(PG8_SB(0, 0), b2, voffB);
            PG8_BAR; PG8_WAIT_L(0); PG8_MMA(0, 1, At, B1); PG8_BAR;
            PG8_LDA(At, 0, 1); PG8_STAGE(PG8_SA(0, 0), a2, voffA);
            PG8_BAR; PG8_WAIT_L(0); PG8_MMA(1, 0, At, B0); PG8_BAR; PG8_SCHED;
            PG8_STAGE(PG8_SB(0, 1), b2 + hstepB, voffB);
            PG8_WAIT_V(6); PG8_BAR; PG8_MMA(1, 1, At, B1); PG8_BAR;
            PG8_LDB(B0, 1, 0); PG8_SCHED; PG8_LDA(At, 1, 0); PG8_STAGE(PG8_SA(0, 1), a2 + hstepA, voffA);
            PG8_WAIT_L(8); PG8_BAR; PG8_WAIT_L(0); PG8_MMA(0, 0, At, B0); PG8_BAR; PG8_SCHED;
            PG8_LDB(B1, 1, 1); PG8_STAGE(PG8_SB(1, 0), b3, voffB);
            PG8_BAR; PG8_WAIT_L(0); PG8_MMA(0, 1, At, B1); PG8_BAR;
            PG8_LDA(At, 1, 1); PG8_STAGE(PG8_SA(1, 0), a3, voffA);
            PG8_BAR; PG8_WAIT_L(0); PG8_MMA(1, 0, At, B0); PG8_BAR; PG8_SCHED;
            PG8_STAGE(PG8_SB(1, 1), b3 + hstepB, voffB);
            PG8_WAIT_V(6); PG8_BAR; PG8_MMA(1, 1, At, B1); PG8_BAR;
        }
        E(acc, cur, wr, wc, fr, fq);
        if (!has_next) break;
#pragma unroll
        for (int a = 0; a < 2; ++a)
#pragma unroll
            for (int b = 0; b < 2; ++b)
#pragma unroll
                for (int m = 0; m < 4; ++m)
#pragma unroll
                    for (int n = 0; n < 2; ++n) acc[a][b][m][n] = (f32x4){0.f, 0.f, 0.f, 0.f};
        cur = nxt; cA = nA; cB = nB; ++ui;
    }
    PG8_WAIT_V(0);
    if (wr == 0) PG8_BAR;
    PG8_BAR;
#undef PG8_SA
#undef PG8_SB
#undef PG8_STAGE
#undef PG8_LDA
#undef PG8_LDB
#undef PG8_MMA
#undef PG8_WAIT_V
#undef PG8_WAIT_L
#undef PG8_BAR
#undef PG8_SCHED
}
}
using pg8::Unit;
typedef f32x4 Acc[2][2][4][2];

#define OPAQUE(v) asm volatile("" : "+v"(v))
struct EpiWin {
    unsigned char* ws; const float* b_gate;
    __device__ __forceinline__ void operator()(const Acc& acc, const Unit& u, int wr, int wc, int fr, int fq) const {
        const int pn = u.pn; const unsigned rl = wr * 64 + fr, cw = wc * 32 + 8 * fq; const size_t rowt = (size_t)u.pm * 256;
        if (pn < 4) {
            unsigned char* base = ws + OFF_QA + (rowt * 1024 + pn * 256) * 2; unsigned lo = (rl * 1024 + cw) * 2; OPAQUE(lo);
#pragma unroll
            for (int ai = 0; ai < 2; ++ai)
#pragma unroll
                for (int m = 0; m < 4; ++m)
#pragma unroll
                    for (int bj = 0; bj < 2; ++bj) *(u32x4*)(base + (lo + (unsigned)(((ai * 128 + m * 16) * 1024 + bj * 128) * 2))) = pack8(acc[ai][bj][m][0], acc[ai][bj][m][1]);
        } else if (pn < 10) {
            const int br = pn - 4;
            const int b = u.pm >> 3, tb = (u.pm & 7) * 8;
            if (br == 3 || br == 5) {
                unsigned char* base = ws + OFF_BRA + (size_t)br * 32 * MiB + ((size_t)b * 4 * 2048 * 64 + (size_t)tb * 2048) * 2;
                unsigned lo = ((cw >> 6) * 2048 * 64 + ((wr * 4 + ((cw & 63) >> 5)) * 128 + ((fr >> 2) & 1) * 32 + (cw & 31)) * 8 + ((fr >> 3) << 2) + (fr & 3)) * 2; OPAQUE(lo);
#pragma unroll
                for (int ai = 0; ai < 2; ++ai)
#pragma unroll
                    for (int m = 0; m < 4; ++m)
#pragma unroll
                        for (int bj = 0; bj < 2; ++bj) { const f32x4 v0 = acc[ai][bj][m][0], v1 = acc[ai][bj][m][1];
                            const unsigned co = (unsigned)((bj * 2 * 2048 * 64 + (((ai * 4 + (m >> 1)) * 4 + (m & 1)) * 64) * 8) * 2);
#pragma unroll
                            for (int e = 0; e < 4; ++e) { *(bf16_t*)(base + (lo + co + (unsigned)(e * 16))) = f2bf(v0[e]); *(bf16_t*)(base + (lo + co + (unsigned)((e + 4) * 16))) = f2bf(v1[e]); } }
            } else if (br == 2 || br == 4) {
                unsigned char* base = ws + OFF_BRA + (size_t)br * 32 * MiB + ((size_t)b * 4 * 2048 * 64 + (size_t)tb * 2048) * 2;
                unsigned lo = ((cw >> 6) * 2048 * 64 + ((wr * 8 + ((cw & 63) >> 4)) * 64 + ((cw >> 3) & 1) * 32 + fr) * 8) * 2; OPAQUE(lo);
#pragma unroll
                for (int ai = 0; ai < 2; ++ai)
#pragma unroll
                    for (int m = 0; m < 4; ++m)
#pragma unroll
                        for (int bj = 0; bj < 2; ++bj) *(u32x4*)(base + (lo + (unsigned)((bj * 2 * 2048 * 64 + ((ai * 4 + (m >> 1)) * 4 * 64 + (m & 1) * 16) * 8) * 2))) = pack8(acc[ai][bj][m][0], acc[ai][bj][m][1]);
            } else {
                unsigned char* base = ws + OFF_BRA + (size_t)br * 32 * MiB + rowt * 256 * 2; unsigned lo = (rl * 256 + cw) * 2; OPAQUE(lo);
#pragma unroll
                for (int ai = 0; ai < 2; ++ai)
#pragma unroll
                    for (int m = 0; m < 4; ++m)
#pragma unroll
                        for (int bj = 0; bj < 2; ++bj) *(u32x4*)(base + (lo + (unsigned)(((ai * 128 + m * 16) * 256 + bj * 128) * 2))) = pack8(acc[ai][bj][m][0], acc[ai][bj][m][1]);
            }
        } else {
            if (cw < 48) {
                unsigned char* base = ws + OFF_GATE + rowt * 48 * 4; unsigned lo = (rl * 48 + cw) * 4; OPAQUE(lo);
                float bg[8];
#pragma unroll
                for (int e = 0; e < 8; ++e) bg[e] = (cw + e < 48) ? b_gate[cw + e] : 0.f;
#pragma unroll
                for (int ai = 0; ai < 2; ++ai)
#pragma unroll
                    for (int m = 0; m < 4; ++m) { const f32x4 v0 = acc[ai][0][m][0], v1 = acc[ai][0][m][1];
#pragma unroll
                        for (int e = 0; e < 4; ++e) { if (cw + e < 48) *(float*)(base + (lo + (unsigned)(((ai * 128 + m * 16) * 48 + e) * 4))) = sigmoidf_(v0[e] + bg[e]);
                            if (cw + 4 + e < 48) *(float*)(base + (lo + (unsigned)(((ai * 128 + m * 16) * 48 + e + 4) * 4))) = sigmoidf_(v1[e] + bg[4 + e]); } }
            }
        }
    }
};
struct EpiQKVB {
    unsigned char* ws;
    __device__ __forceinline__ void operator()(const Acc& acc, const Unit& u, int wr, int wc, int fr, int fq) const {
        const int pn = u.pn; const unsigned rl = wr * 64 + fr, cw = wc * 32 + 8 * fq; const size_t rowt = (size_t)u.pm * 256;
        if (pn < 12) {
            unsigned char* base = ws + OFF_QB + (rowt * 3072 + pn * 256) * 2; unsigned lo = (rl * 3072 + cw) * 2; OPAQUE(lo);
#pragma unroll
            for (int ai = 0; ai < 2; ++ai)
#pragma unroll
                for (int m = 0; m < 4; ++m)
#pragma unroll
                    for (int bj = 0; bj < 2; ++bj) *(u32x4*)(base + (lo + (unsigned)(((ai * 128 + m * 16) * 3072 + bj * 128) * 2))) = pack8(acc[ai][bj][m][0], acc[ai][bj][m][1]);
        } else {
            const int idx = pn - 12, gi = idx >> 1, isV = idx & 1, dsh = 2 * gi, lsh = 11 - dsh, b = u.pm >> 3, sb = ((u.pm & 7) * 256) >> dsh;
            unsigned posl = ((rl & ((1u << dsh) - 1u)) << lsh) + (rl >> dsh) + sb; OPAQUE(posl);
            unsigned char* base = ws + OFF_KVB + (size_t)idx * 32 * MiB + ((size_t)b * 4 * 2048 * 64) * 2;
            if (isV) {
                unsigned lo = ((cw >> 6) * 2048 * 64 + (((cw & 63) >> 5) * 128 + (cw & 31)) * 8) * 2; OPAQUE(lo);
#pragma unroll
                for (int ai = 0; ai < 2; ++ai)
#pragma unroll
                    for (int m = 0; m < 4; ++m) { const unsigned p = posl + (unsigned)((ai * 128 + m * 16) >> dsh), kk = p & 31u, k16 = kk & 15u;
                        const unsigned po = (((p >> 5) * 4 + (kk >> 4)) * 64 + ((k16 >> 2) & 1u) * 32) * 16 + (((k16 >> 3) << 2) + (k16 & 3u)) * 2;
#pragma unroll
                        for (int bj = 0; bj < 2; ++bj) { const f32x4 v0 = acc[ai][bj][m][0], v1 = acc[ai][bj][m][1];
#pragma unroll
                            for (int e = 0; e < 4; ++e) { *(bf16_t*)(base + (lo + po + (unsigned)(bj * 2 * 2048 * 64 * 2 + e * 16))) = f2bf(v0[e]);
                                *(bf16_t*)(base + (lo + po + (unsigned)(bj * 2 * 2048 * 64 * 2 + (e + 4) * 16))) = f2bf(v1[e]); } } }
            } else {
                unsigned lo = ((cw >> 6) * 2048 * 64 + (((cw & 63) >> 4) * 64 + ((cw >> 3) & 1) * 32) * 8) * 2; OPAQUE(lo);
#pragma unroll
                for (int ai = 0; ai < 2; ++ai)
#pragma unroll
                    for (int m = 0; m < 4; ++m) { const unsigned p = posl + (unsigned)((ai * 128 + m * 16) >> dsh), po = ((p >> 5) * 256 + (p & 31u)) * 16;
#pragma unroll
                        for (int bj = 0; bj < 2; ++bj) *(u32x4*)(base + (lo + po + (unsigned)(bj * 2 * 2048 * 64 * 2))) = pack8(acc[ai][bj][m][0], acc[ai][bj][m][1]); }
            }
        }
    }
};
struct EpiResid {
    const float* xin; float* xout;
    __device__ __forceinline__ void operator()(const Acc& acc, const Unit& u, int wr, int wc, int fr, int fq) const {
        const unsigned rl = wr * 64 + fr, cw = wc * 32 + 8 * fq; const size_t t0 = ((size_t)u.pm * 256 * 1024 + u.pn * 256) * 4;
        const unsigned char* bi = (const unsigned char*)xin + t0; unsigned char* bo = (unsigned char*)xout + t0; unsigned lo = (rl * 1024 + cw) * 4; OPAQUE(lo);
#pragma unroll
        for (int ai = 0; ai < 2; ++ai)
#pragma unroll
            for (int m = 0; m < 4; ++m)
#pragma unroll
                for (int bj = 0; bj < 2; ++bj) { const unsigned o = lo + (unsigned)(((ai * 128 + m * 16) * 1024 + bj * 128) * 4);
                    const f32x4 a = *(const f32x4*)(bi + o), c = *(const f32x4*)(bi + o + 16);
                    *(f32x4*)(bo + o) = a + acc[ai][bj][m][0]; *(f32x4*)(bo + o + 16) = c + acc[ai][bj][m][1]; }
    }
};
struct EpiSwiglu {
    unsigned char* act;
    __device__ __forceinline__ void operator()(const Acc& acc, const Unit& u, int wr, int wc, int fr, int fq) const {
        const unsigned rl = wr * 64 + fr, cw = wc * 32 + 8 * fq; unsigned char* base = act + ((size_t)u.pm * 256 * FFH + u.pn * 128) * 2; unsigned lo = (rl * FFH + cw) * 2; OPAQUE(lo);
#pragma unroll
        for (int ai = 0; ai < 2; ++ai)
#pragma unroll
            for (int m = 0; m < 4; ++m) { f32x4 h0, h1;
#pragma unroll
                for (int e = 0; e < 4; ++e) { const float a0 = acc[ai][0][m][0][e], a1 = acc[ai][0][m][1][e];
                    h0[e] = a0 * sigmoidf_(a0) * acc[ai][1][m][0][e]; h1[e] = a1 * sigmoidf_(a1) * acc[ai][1][m][1][e]; }
                *(u32x4*)(base + (lo + (unsigned)((ai * 128 + m * 16) * FFH * 2))) = pack8(h0, h1); }
    }
};
struct EpiCmp1 {
    unsigned char* ws;
    __device__ __forceinline__ void operator()(const Acc& acc, const Unit& u, int wr, int wc, int fr, int fq) const {
        const int kv = u.pn; const unsigned rl = wr * 64 + fr, cw = wc * 32 + 8 * fq;
        unsigned char* base = ws + OFF_G1 + (((size_t)kv * 16384 + (size_t)u.pm * 256) * 256) * 2; unsigned lo = (rl * 256 + cw) * 2; OPAQUE(lo);
        const unsigned char* bp = ws + OFF_BIASP + (size_t)kv * 8 * 256 * 4; unsigned blo = cw * 4; OPAQUE(blo);
#pragma unroll
        for (int bj = 0; bj < 2; ++bj) {
            float bias[8];
#pragma unroll
            for (int e = 0; e < 8; ++e) { float sb = 0.f;
#pragma unroll
                for (int q = 0; q < 8; ++q) sb += *(const float*)(bp + (blo + (unsigned)((q * 256 + bj * 128 + e) * 4))); bias[e] = sb; }
#pragma unroll
            for (int ai = 0; ai < 2; ++ai)
#pragma unroll
                for (int m = 0; m < 4; ++m) { f32x4 h0, h1;
#pragma unroll
                    for (int e = 0; e < 4; ++e) {
                        const float x0 = acc[ai][bj][m][0][e] + bias[e], x1 = acc[ai][bj][m][1][e] + bias[4 + e];
                        const float u0 = 0.7978845608028654f * (x0 + 0.044715f * x0 * x0 * x0), u1 = 0.7978845608028654f * (x1 + 0.044715f * x1 * x1 * x1);
                        h0[e] = x0 * sigmoidf_(2.f * u0); h1[e] = x1 * sigmoidf_(2.f * u1); }
                    *(u32x4*)(base + (lo + (unsigned)(((ai * 128 + m * 16) * 256 + bj * 128) * 2))) = pack8(h0, h1); }
        }
    }
};

__device__ __forceinline__ void conv_weight(const float* W, int K, int N, const float* gain, bf16_t* WT, int row_off, int mode, LAS float* scr, int gw, int NGW, int lane) {
    const int nnb = (N + 31) / 32, nitems = (K / 64) * nnb;
    for (int item = gw; item < nitems; item += NGW) {
        const int kb = item / nnb, nb = item % nnb, k0 = 64 * kb, n0 = 32 * nb;
#pragma unroll 8
        for (int i = 0; i < 32; ++i) { const int kk = 2 * i + (lane >> 5), n = n0 + (lane & 31);
            float v = (n < N) ? W[(size_t)(k0 + kk) * N + n] : 0.f; if (gain) v *= gain[k0 + kk]; scr[kk * 33 + (lane & 31)] = v; }
        LDS_WAIT();
        int dr0 = row_off + n0;
        if (mode == 1) dr0 = (n0 < FFH) ? ((n0 >> 7) * 256 + (n0 & 127)) : ((((n0 - FFH) >> 7) * 256) + 128 + ((n0 - FFH) & 127));
        const int c = lane & 7;
#pragma unroll
        for (int j = 0; j < 4; ++j) { const int nn = (lane >> 3) + 8 * j; const LAS float* s = scr + (8 * c) * 33 + nn;
            u32x4 o; o.x = cvt_pk_bf16(s[0 * 33], s[1 * 33]); o.y = cvt_pk_bf16(s[2 * 33], s[3 * 33]); o.z = cvt_pk_bf16(s[4 * 33], s[5 * 33]); o.w = cvt_pk_bf16(s[6 * 33], s[7 * 33]);
            if (n0 + nn < N) *(u32x4*)(WT + (size_t)(dr0 + nn) * K + k0 + 8 * c) = o; }
        LDS_WAIT();
    }
}
__device__ __forceinline__ void norm_rows(const float* x, bf16_t* h, int gw, int NGW, int lane) {
    for (int row = gw; row < T_TOK; row += NGW) {
        const f32x4* xr = (const f32x4*)(x + (size_t)row * DM) + lane; f32x4 v[4]; float s = 0.f;
#pragma unroll
        for (int j = 0; j < 4; ++j) { v[j] = xr[64 * j]; s += (v[j][0] * v[j][0] + v[j][1] * v[j][1]) + (v[j][2] * v[j][2] + v[j][3] * v[j][3]); }
        const float r = 1.f / sqrtf(wave_sum(s) * (1.f / DM) + 1e-6f);
        u32x2* o = (u32x2*)(h + (size_t)row * DM) + lane;
#pragma unroll
        for (int j = 0; j < 4; ++j) { u32x2 w; w.x = cvt_pk_bf16(v[j][0] * r, v[j][1] * r); w.y = cvt_pk_bf16(v[j][2] * r, v[j][3] * r); o[64 * j] = w; }
    }
}
__device__ __forceinline__ void final_norm_rows(float* x, const float* gain, int gw, int NGW, int lane) {
    f32x4 gv[4];
#pragma unroll
    for (int j = 0; j < 4; ++j) gv[j] = ((const f32x4*)gain)[lane + 64 * j];
    for (int row = gw; row < T_TOK; row += NGW) {
        f32x4* xr = (f32x4*)(x + (size_t)row * DM) + lane; f32x4 v[4]; float s = 0.f;
#pragma unroll
        for (int j = 0; j < 4; ++j) { v[j] = xr[64 * j]; s += (v[j][0] * v[j][0] + v[j][1] * v[j][1]) + (v[j][2] * v[j][2] + v[j][3] * v[j][3]); }
        const float r = 1.f / sqrtf(wave_sum(s) * (1.f / DM) + 1e-6f);
#pragma unroll
        for (int j = 0; j < 4; ++j) xr[64 * j] = v[j] * r * gv[j];
    }
}

struct SoftState { float m, l; f32x16 o0, o1; };
struct KFrag { bf16x8 k0, k1, k2, k3; };
__device__ __forceinline__ bf16x8 ld_v8(const char* p) { const u64 lo = *(const u64*)p, hi = *(const u64*)(p + 16); u32x4 t; t.x = (unsigned)lo; t.y = (unsigned)(lo >> 32); t.z = (unsigned)hi; t.w = (unsigned)(hi >> 32); return __builtin_bit_cast(bf16x8, t); }
__device__ __forceinline__ bf16x8 pk_lo(const f32x16& p) { u32x4 t; t.x = cvt_pk_bf16(p[0], p[1]); t.y = cvt_pk_bf16(p[2], p[3]); t.z = cvt_pk_bf16(p[4], p[5]); t.w = cvt_pk_bf16(p[6], p[7]); return __builtin_bit_cast(bf16x8, t); }
__device__ __forceinline__ bf16x8 pk_hi(const f32x16& p) { u32x4 t; t.x = cvt_pk_bf16(p[8], p[9]); t.y = cvt_pk_bf16(p[10], p[11]); t.z = cvt_pk_bf16(p[12], p[13]); t.w = cvt_pk_bf16(p[14], p[15]); return __builtin_bit_cast(bf16x8, t); }
__device__ __forceinline__ void load_k(KFrag& f, const char* kp) { f.k0 = *(const bf16x8*)kp; f.k1 = *(const bf16x8*)(kp + 1024); f.k2 = *(const bf16x8*)(kp + 2048); f.k3 = *(const bf16x8*)(kp + 3072); }
__device__ __forceinline__ void tile_compute(SoftState& st, const bf16x8 (&qf)[4], const KFrag& f, const char* vp, const LAS unsigned char* lds, unsigned vb, int dist0, int max_dist, bool masked) {
    const bf16x8 v00 = *(const bf16x8*)vp, v01 = *(const bf16x8*)(vp + 1024), v10 = *(const bf16x8*)(vp + 2048), v11 = *(const bf16x8*)(vp + 3072);
    f32x16 s = {0.f, 0.f, 0.f, 0.f, 0.f, 0.f, 0.f, 0.f, 0.f, 0.f, 0.f, 0.f, 0.f, 0.f, 0.f, 0.f};
    s = mfma32(f.k0, qf[0], s); s = mfma32(f.k1, qf[1], s); s = mfma32(f.k2, qf[2], s); s = mfma32(f.k3, qf[3], s);
    f32x16 t;
#pragma unroll
    for (int i = 0; i < 16; ++i) t[i] = s[i] * SC2 + *(const LAS float*)(lds + vb + 4 * (27 - ((i & 3) + 8 * (i >> 2))));
    if (masked) {
#pragma unroll
        for (int i = 0; i < 16; ++i) t[i] = ((unsigned)(dist0 - ((i & 3) + 8 * (i >> 2))) <= (unsigned)max_dist) ? t[i] : -__builtin_inff();
    }
    float mx = fmaxf(fmaxf(fmaxf(t[0], t[1]), fmaxf(t[2], t[3])), fmaxf(fmaxf(t[4], t[5]), fmaxf(t[6], t[7])));
    mx = fmaxf(mx, fmaxf(fmaxf(fmaxf(t[8], t[9]), fmaxf(t[10], t[11])), fmaxf(fmaxf(t[12], t[13]), fmaxf(t[14], t[15]))));
    mx = fmaxf(mx, __shfl_xor(mx, 32));
    if (__builtin_amdgcn_ballot_w64(mx > st.m) != 0ull) { const float mnew = fmaxf(mx, st.m), alpha = fexp2(st.m - mnew); st.l *= alpha; st.o0 *= alpha; st.o1 *= alpha; st.m = mnew; }
    float ls = 0.f;
#pragma unroll
    for (int i = 0; i < 16; ++i) { t[i] = fexp2(t[i] - st.m); ls += t[i]; }
    st.l += ls;
    const bf16x8 pb0 = pk_lo(t), pb1 = pk_hi(t);
    st.o0 = mfma32(v00, pb0, st.o0); st.o0 = mfma32(v01, pb1, st.o0); st.o1 = mfma32(v10, pb0, st.o1); st.o1 = mfma32(v11, pb1, st.o1);
}
__device__ __forceinline__ void soft_init(SoftState& st) { st.m = -1e30f; st.l = 0.f;
#pragma unroll
    for (int i = 0; i < 16; ++i) { st.o0[i] = 0.f; st.o1[i] = 0.f; } }

__device__ __forceinline__ void run_range(SoftState& st, const bf16x8 (&qf)[4], const char* Kl, const char* Vl, int kt_lo, int kt_hi,
                                          int qpos, int qmin, int qmax, int max_dist, unsigned tb_head, const LAS unsigned char* lds, int h) {
    KFrag A, B;
    load_k(A, Kl + (size_t)kt_lo * 4096);
#pragma unroll 1
    for (int kt = kt_lo; kt <= kt_hi; ++kt) {
        if (kt + 1 <= kt_hi) load_k(B, Kl + (size_t)(kt + 1) * 4096);
        const int kbase = 32 * kt, dist0 = qpos - kbase - 4 * h; const unsigned vb = tb_head + (unsigned)(4 * (dist0 - 27));
        const bool masked = !(qmin - kbase - 31 >= 0 && qmax - kbase <= max_dist);
        tile_compute(st, qf, A, Vl + (size_t)kt * 4096, lds, vb, dist0, max_dist, masked);
        A = B;
    }
}

constexpr int ATT_TAB = 1024  , ATT_HS_A = 2056  , ATT_HS_B = 136  , ATT_NEG = LDS_NEG;

__device__ __forceinline__ void phaseA_attn(unsigned char* ws, LAS unsigned char* lds, int gw, int NGW, int lane) {
    const int r = lane & 31, h = lane >> 5, tk = r >> 2, rr = r & 3;
    const LAS unsigned char* lut = lds + LDS_LUT; const LAS float* bias2 = (const LAS float*)(lds + LDS_BIAS);
    { LAS float* tab = (LAS float*)(lds + ATT_TAB);
      for (int i = threadIdx.x; i < 16 * ATT_HS_A; i += 512) { const int hd = i / ATT_HS_A, d = i - hd * ATT_HS_A; tab[i] = d < 2048 ? bias2[(int)lut[d] * 16 + hd] : 0.f; }
      if (threadIdx.x < 256) ((LAS float*)lds)[threadIdx.x] = 0.f;
      if (threadIdx.x < 64) ((LAS float*)(lds + ATT_NEG))[threadIdx.x] = -__builtin_inff();
      __syncthreads(); }
    for (int item = gw; item < 32768; item += NGW) {
        const int bg = item >> 8, ti = ((item & 255) + 16 * (item >> 11)) & 255, b = bg >> 2, g = bg & 3, s0 = ti * 8, s = s0 + tk, head = g * 4 + rr, cur = s0 >> 6;
        const size_t tok = (size_t)b * 2048 + s;
        const LAS float* bias2h = bias2 + head;
        const unsigned tb_head = (unsigned)(ATT_TAB + head * ATT_HS_A * 4);
        bf16x8 qf[4];
        { const char* qp = (const char*)ws + OFF_QA + (tok * 1024 + head * 64 + 8 * h) * 2;
#pragma unroll
          for (int ks = 0; ks < 4; ++ks) qf[ks] = *(const bf16x8*)(qp + 32 * ks); }
        const float* gp = (const float*)(ws + OFF_GATE) + tok * 48 + head * 3; const float g_cmp = gp[0], g_sel = gp[1], g_win = gp[2];
        unsigned tp[16]; unsigned sel;
        {
            const char* Kc = (const char*)ws + OFF_KCMP + (size_t)bg * 128 * 128; const char* Vc = (const char*)ws + OFF_VCMPT + (size_t)bg * 64 * 256;
            f32x16 sc[4];
#pragma unroll
            for (int c = 0; c < 4; ++c) { const char* kp = Kc + (32 * c + r) * 128 + 16 * h; f32x16 a = {0.f, 0.f, 0.f, 0.f, 0.f, 0.f, 0.f, 0.f, 0.f, 0.f, 0.f, 0.f, 0.f, 0.f, 0.f, 0.f};
#pragma unroll
                for (int ks = 0; ks < 4; ++ks) a = mfma32(*(const bf16x8*)(kp + 32 * ks), qf[ks], a); sc[c] = a; }
            __builtin_amdgcn_sched_barrier(0);
            float mx = -1e30f;
#pragma unroll
            for (int c = 0; c < 4; ++c)
#pragma unroll
                for (int i = 0; i < 16; ++i) { const int n = 32 * c + (i & 3) + 8 * (i >> 2) + 4 * h, dist = s - 16 * n - 31; const bool valid = dist >= 0; const int idx = dist < 0 ? 0 : dist;
                    const float t = valid ? sc[c][i] * SC2 + bias2h[(int)lut[idx] * 16] : -1e30f; sc[c][i] = t; mx = fmaxf(mx, t); }
            mx = fmaxf(mx, __shfl_xor(mx, 32)); float l = 0.f;
#pragma unroll
            for (int c = 0; c < 4; ++c)
#pragma unroll
                for (int i = 0; i < 16; ++i) { const float pv = sc[c][i] > -1e29f ? fexp2(sc[c][i] - mx) : 0.f; sc[c][i] = pv; l += pv; }
            l += __shfl_xor(l, 32); const float inv = 1.f / fmaxf(l, 1e-30f);
#pragma unroll
            for (int c = 0; c < 4; ++c) sc[c] *= inv;
            __builtin_amdgcn_sched_barrier(0);
            f32x16 oc0 = {0.f, 0.f, 0.f, 0.f, 0.f, 0.f, 0.f, 0.f, 0.f, 0.f, 0.f, 0.f, 0.f, 0.f, 0.f, 0.f}, oc1 = oc0;
#pragma unroll
            for (int c = 0; c < 4; ++c) { const bf16x8 pb0 = pk_lo(sc[c]), pb1 = pk_hi(sc[c]); const char* vp0 = Vc + r * 256 + (32 * c + 4 * h) * 2; const char* vp1 = vp0 + 32 * 256;
                oc0 = mfma32(ld_v8(vp0), pb0, oc0); oc0 = mfma32(ld_v8(vp0 + 32), pb1, oc0); oc1 = mfma32(ld_v8(vp1), pb0, oc1); oc1 = mfma32(ld_v8(vp1 + 32), pb1, oc1); }
            oc0 *= g_cmp; oc1 *= g_cmp;
#pragma unroll
            for (int q = 0; q < 8; ++q) { tp[q] = cvt_pk_bf16(oc0[2 * q], oc0[2 * q + 1]); tp[8 + q] = cvt_pk_bf16(oc1[2 * q], oc1[2 * q + 1]); }
            __builtin_amdgcn_sched_barrier(0);
            float own[16], oth[16], pl[16];
#pragma unroll
            for (int cgi = 0; cgi < 16; ++cgi) pl[cgi] = __shfl_xor(sc[cgi >> 2][4 * (cgi & 3) + 3], 32);
#pragma unroll
            for (int cgi = 0; cgi < 16; ++cgi) { const int c = cgi >> 2, q4 = 4 * (cgi & 3); float v = (sc[c][q4] + sc[c][q4 + 1]) + (sc[c][q4 + 2] + sc[c][q4 + 3]);
                const float prevh0 = cgi > 0 ? pl[cgi > 0 ? cgi - 1 : 0] : 0.f; v += h ? pl[cgi] : prevh0;
                v += __shfl_xor(v, 1); v += __shfl_xor(v, 2); own[cgi] = v; }
#pragma unroll
            for (int cgi = 0; cgi < 16; ++cgi) oth[cgi] = __shfl_xor(own[cgi], 32);
            __builtin_amdgcn_sched_barrier(0);
            float cand[32];
#pragma unroll
            for (int cgi = 0; cgi < 16; ++cgi) { const float ve = h ? oth[cgi] : own[cgi], vo = h ? own[cgi] : oth[cgi];
                cand[2 * cgi] = (2 * cgi >= 1 && 2 * cgi <= cur - 2) ? ve : -2.f; cand[2 * cgi + 1] = (2 * cgi + 1 <= cur - 2) ? vo : -2.f; }
            float prev = 3.0e38f;
#pragma unroll 1
            for (int round = 0; round < 5; ++round) { float best = -1.f;
#pragma unroll
                for (int j = 0; j < 32; ++j) { const float v = cand[j] < prev ? cand[j] : -2.f; best = fmaxf(best, v); }
                prev = best; }
            const float thr = fmaxf(prev, 0.f);
            sel = 1u | (1u << cur) | (cur > 0 ? (1u << (cur - 1)) : 0u);
#pragma unroll
            for (int j = 1; j < 32; ++j) sel |= (cand[j] >= thr) ? (1u << j) : 0u;
        }
        {
            unsigned um = sel; um |= __shfl_xor(um, 4); um |= __shfl_xor(um, 8); um |= __shfl_xor(um, 16); um = __builtin_amdgcn_readfirstlane(um);
            const char* Kl = (const char*)ws + OFF_BRA + 2 * 32 * MiB + (size_t)bg * 2048 * 128 + lane * 16;
            const char* Vl = (const char*)ws + OFF_BRA + 3 * 32 * MiB + (size_t)bg * 2048 * 128 + lane * 16;
            SoftState st; soft_init(st);
            KFrag A, B; int half = 0, kb = 64 * __builtin_ctz(um), kbn = 0; bool has;
            load_k(A, Kl + (size_t)kb * 128);
#pragma unroll 1
            for (;;) {
                if (half) um &= um - 1; half ^= 1; has = um != 0u; if (has) { kbn = 64 * __builtin_ctz(um) + 32 * half; load_k(B, Kl + (size_t)kbn * 128); }
                { const int jb = kb >> 6, dist0 = s - kb - 4 * h; const unsigned vb = ((sel >> jb) & 1u) ? tb_head + (unsigned)(4 * (dist0 - 27)) : (unsigned)ATT_NEG;
                  tile_compute(st, qf, A, Vl + (size_t)kb * 128, lds, vb, dist0, 1 << 20, jb >= cur); }
                if (!has) break; kb = kbn; A = B;
            }
            const float lt = st.l + __shfl_xor(st.l, 32), sc = g_sel / fmaxf(lt, 1e-30f);
#pragma unroll
            for (int q = 0; q < 8; ++q) { tp[q] = cvt_pk_bf16(__uint_as_float(tp[q] << 16) + st.o0[2 * q] * sc, __uint_as_float(tp[q] & 0xffff0000u) + st.o0[2 * q + 1] * sc);
                tp[8 + q] = cvt_pk_bf16(__uint_as_float(tp[8 + q] << 16) + st.o1[2 * q] * sc, __uint_as_float(tp[8 + q] & 0xffff0000u) + st.o1[2 * q + 1] * sc); }
        }
        {
            const char* Kl = (const char*)ws + OFF_BRA + 4 * 32 * MiB + (size_t)bg * 2048 * 128 + lane * 16;
            const char* Vl = (const char*)ws + OFF_BRA + 5 * 32 * MiB + (size_t)bg * 2048 * 128 + lane * 16;
            SoftState st; soft_init(st);
            const int lo = s0 - 255, kt_lo = lo < 0 ? 0 : (lo >> 5), kt_hi = (s0 + 7) >> 5;
            run_range(st, qf, Kl, Vl, kt_lo, kt_hi, s, s0, s0 + 7, 255, tb_head, lds, h);
            const float lt = st.l + __shfl_xor(st.l, 32), sc = g_win / fmaxf(lt, 1e-30f);
#pragma unroll
            for (int q = 0; q < 8; ++q) { tp[q] = cvt_pk_bf16(__uint_as_float(tp[q] << 16) + st.o0[2 * q] * sc, __uint_as_float(tp[q] & 0xffff0000u) + st.o0[2 * q + 1] * sc);
                tp[8 + q] = cvt_pk_bf16(__uint_as_float(tp[8 + q] << 16) + st.o1[2 * q] * sc, __uint_as_float(tp[8 + q] & 0xffff0000u) + st.o1[2 * q + 1] * sc); }
        }
        { unsigned char* op = ws + OFF_O + (tok * 1024 + head * 64 + 4 * h) * 2;
#pragma unroll
          for (int q = 0; q < 4; ++q) { u32x2 w; w.x = tp[2 * q]; w.y = tp[2 * q + 1]; *(u32x2*)(op + 16 * q) = w; u32x2 w2; w2.x = tp[8 + 2 * q]; w2.y = tp[8 + 2 * q + 1]; *(u32x2*)(op + 64 + 16 * q) = w2; } }
    }
}

__device__ __forceinline__ void phaseB_attn(unsigned char* ws, LAS unsigned char* lds, int gw, int NGW, int lane) {
    const int r = lane & 31, h = lane >> 5, tk = r >> 2, rr = r & 3;
    const LAS unsigned char* lut = lds + LDS_LUT; const LAS float* bias2 = (const LAS float*)(lds + LDS_BIAS);
    { LAS float* tab = (LAS float*)(lds + ATT_TAB);
      for (int i = threadIdx.x; i < 3 * 16 * ATT_HS_B; i += 512) { const int gh = i / ATT_HS_B, d = i - gh * ATT_HS_B, gi = gh >> 4, hd = gh & 15; int td = d << (2 * gi); td = td > 2047 ? 2047 : td;
          tab[i] = bias2[(int)lut[td] * 16 + hd]; }
      if (threadIdx.x < 256) ((LAS float*)lds)[threadIdx.x] = 0.f;
      __syncthreads(); }
    for (int item = gw; item < 32768; item += NGW) {
        const int bg = item >> 8, cc = (item >> 4) & 15, r16 = item & 15, b = bg >> 2, g = bg & 3, s0 = cc * 128 + r16, s = s0 + 16 * tk, head = g * 4 + rr;
        const size_t tok = (size_t)b * 2048 + s;
        SoftState st; soft_init(st);
#pragma unroll 1
        for (int gi = 0; gi < 3; ++gi) {
            const int dsh = 2 * gi, lsh = 11 - dsh, res = s0 & ((1 << dsh) - 1);
            bf16x8 qf[4];
            { const char* qp = (const char*)ws + OFF_QB + (tok * 3072 + gi * 1024 + head * 64 + 8 * h) * 2;
#pragma unroll
              for (int ks = 0; ks < 4; ++ks) qf[ks] = *(const bf16x8*)(qp + 32 * ks); }
            const char* Kl = (const char*)ws + OFF_KVB + (size_t)(gi * 2) * 32 * MiB + ((size_t)bg * 2048 + ((size_t)res << lsh)) * 128 + lane * 16;
            const char* Vl = (const char*)ws + OFF_KVB + (size_t)(gi * 2 + 1) * 32 * MiB + ((size_t)bg * 2048 + ((size_t)res << lsh)) * 128 + lane * 16;
            const int ql = s >> dsh, qmin = s0 >> dsh, qmax = (s0 + 112) >> dsh, ql_lo = qmin - 128, kt_lo = ql_lo < 0 ? 0 : (ql_lo >> 5), kt_hi = qmax >> 5;
            const unsigned tb_head = (unsigned)(ATT_TAB + (gi * 16 + head) * ATT_HS_B * 4);
            run_range(st, qf, Kl, Vl, kt_lo, kt_hi, ql, qmin, qmax, 128, tb_head, lds, h);
        }
        const float lt = st.l + __shfl_xor(st.l, 32), sc = 1.f / fmaxf(lt, 1e-30f);
        const f32x16 tot0 = st.o0 * sc, tot1 = st.o1 * sc;
        { unsigned char* op = ws + OFF_O + (tok * 1024 + head * 64 + 4 * h) * 2;
#pragma unroll
          for (int q = 0; q < 4; ++q) { u32x2 w; w.x = cvt_pk_bf16(tot0[4 * q], tot0[4 * q + 1]); w.y = cvt_pk_bf16(tot0[4 * q + 2], tot0[4 * q + 3]); *(u32x2*)(op + 16 * q) = w;
              u32x2 w2; w2.x = cvt_pk_bf16(tot1[4 * q], tot1[4 * q + 1]); w2.y = cvt_pk_bf16(tot1[4 * q + 2], tot1[4 * q + 3]); *(u32x2*)(op + 64 + 16 * q) = w2; } }
    }
}

__device__ __forceinline__ void phase_cmp2(unsigned char* ws, int gw, int NGW, int lane) {
    const int r = lane & 31, h = lane >> 5;
    for (int item = gw; item < 1024; item += NGW) {
        const int kv = item >> 9, rt = item & 511;
        const char* ap = (const char*)ws + OFF_G1 + (((size_t)kv * 16384 + rt * 32 + r) * 256 + 8 * h) * 2;
        const char* bp = (const char*)ws + OFF_W2 + (size_t)kv * 32768 + ((size_t)r * 256 + 8 * h) * 2;
        f32x16 a0 = {0.f, 0.f, 0.f, 0.f, 0.f, 0.f, 0.f, 0.f, 0.f, 0.f, 0.f, 0.f, 0.f, 0.f, 0.f, 0.f}, a1 = a0;
#pragma unroll
        for (int ks = 0; ks < 16; ++ks) { const bf16x8 a = *(const bf16x8*)(ap + 32 * ks);
            a0 = mfma32(a, *(const bf16x8*)(bp + 32 * ks), a0); a1 = mfma32(a, *(const bf16x8*)(bp + 32 * 256 * 2 + 32 * ks), a1); }
#pragma unroll
        for (int i = 0; i < 16; ++i) { const int row = rt * 32 + (i & 3) + 8 * (i >> 2) + 4 * h, gq = row & 3, n = (row >> 2) & 127, b = row >> 9, bgi = b * 4 + gq;
            if (kv == 0) { bf16_t* o = (bf16_t*)(ws + OFF_KCMP) + ((size_t)bgi * 128 + n) * 64; o[r] = f2bf(a0[i]); o[r + 32] = f2bf(a1[i]); }
            else { bf16_t* o = (bf16_t*)(ws + OFF_VCMPT) + (size_t)bgi * 64 * 128 + n; o[(size_t)r * 128] = f2bf(a0[i]); o[(size_t)(r + 32) * 128] = f2bf(a1[i]); } }
    }
}

__global__ __launch_bounds__(512, 2) void yoco_mega(Params p) {
    extern __shared__ __attribute__((aligned(16))) unsigned char shm[];
    cg::grid_group grid = cg::this_grid();
    LAS unsigned char* lds = (LAS unsigned char*)shm;
    const int tid = threadIdx.x, lane = tid & 63, wave = __builtin_amdgcn_readfirstlane(tid >> 6), gw = blockIdx.x * 8 + wave, NGW = gridDim.x * 8;
    unsigned char* ws = p.ws;
    const float* x_in = p.in[0];
    float* X = p.out;
    { LAS unsigned char* lut = lds + LDS_LUT; LAS float* bias2 = (LAS float*)(lds + LDS_BIAS);
      for (int d = tid; d < 2048; d += 512) { int bk = d; if (d >= 16) bk = 16 + (d >= 22) + (d >= 30) + (d >= 40) + (d >= 54) + (d >= 73) + (d >= 99) + (d >= 134) + (d >= 182) + (d >= 246) + (d >= 332) + (d >= 450) + (d >= 609) + (d >= 825) + (d >= 1117) + (d >= 1513); lut[d] = (unsigned char)bk; }
      bias2[tid] = p.in[1][tid] * LOG2E;
      __syncthreads(); }
    {
        LAS float* scr = (LAS float*)(lds + wave * 8448);
        const float* nm = p.in[2]; const float* nf = p.in[3];
        conv_weight(p.in[4], 1024, 2608, nm, (bf16_t*)(ws + OFF_WIN), 0, 0, scr, gw, NGW, lane);
        conv_weight(p.in[7], 2048, 256, nullptr, (bf16_t*)(ws + OFF_W1), 0, 0, scr, gw, NGW, lane);
        conv_weight(p.in[10], 2048, 256, nullptr, (bf16_t*)(ws + OFF_W1), 256, 0, scr, gw, NGW, lane);
        conv_weight(p.in[8], 256, 64, nullptr, (bf16_t*)(ws + OFF_W2), 0, 0, scr, gw, NGW, lane);
        conv_weight(p.in[11], 256, 64, nullptr, (bf16_t*)(ws + OFF_W2), 64, 0, scr, gw, NGW, lane);
        conv_weight(p.in[12], 1024, 1024, nullptr, (bf16_t*)(ws + OFF_WOUTA), 0, 0, scr, gw, NGW, lane);
        conv_weight(p.in[15], 1024, 3072, nm + 1024, (bf16_t*)(ws + OFF_WQKVB), 0, 0, scr, gw, NGW, lane);
        conv_weight(p.in[14], 1024, 1536, p.in[13], (bf16_t*)(ws + OFF_WQKVB), 3072, 0, scr, gw, NGW, lane);
        conv_weight(p.in[16], 1024, 1024, nullptr, (bf16_t*)(ws + OFF_WOUTB), 0, 0, scr, gw, NGW, lane);
        conv_weight(p.in[17], 1024, 5632, nf, (bf16_t*)(ws + OFF_WUP0), 0, 1, scr, gw, NGW, lane);
        conv_weight(p.in[17] + (size_t)1024 * 5632, 1024, 5632, nf + 1024, (bf16_t*)(ws + OFF_WUP1), 0, 1, scr, gw, NGW, lane);
        conv_weight(p.in[18], 2816, 1024, nullptr, (bf16_t*)(ws + OFF_WDN0), 0, 0, scr, gw, NGW, lane);
        conv_weight(p.in[18] + (size_t)2816 * 1024, 2816, 1024, nullptr, (bf16_t*)(ws + OFF_WDN1), 0, 0, scr, gw, NGW, lane);
        for (int item = gw; item < 64; item += NGW) { const int kv = item >> 5, ksl = (item >> 2) & 7, c = (item & 3) * 64 + lane;
            const float* pe = kv ? p.in[9] : p.in[6]; const float* w1 = kv ? p.in[10] : p.in[7]; float a = 0.f;
#pragma unroll 8
            for (int kk = ksl * 256; kk < ksl * 256 + 256; ++kk) a += pe[kk] * w1[(size_t)kk * 256 + c];
            ((float*)(ws + OFF_BIASP))[(kv * 8 + ksl) * 256 + c] = a; }
        norm_rows(x_in, (bf16_t*)(ws + OFF_H), gw, NGW, lane);
    }
    grid.sync();
    pg8::StaticOrder S;
    { pg8::Gemm g{(const char*)ws + OFF_H, (const char*)ws + OFF_WIN, 1024, 1024, 0, 0}; S.init(256, 11, gridDim.x, blockIdx.x); EpiWin E{ws, p.in[5]}; pg8::gemm_phase(lds, g, S, E); }
    grid.sync();
    { pg8::Gemm g{(const char*)ws + OFF_BRA, (const char*)ws + OFF_W1, 2048, 0, 1, 32 * MiB}; S.init(64, 2, gridDim.x, blockIdx.x); EpiCmp1 E{ws}; pg8::gemm_phase(lds, g, S, E); }
    grid.sync();
    phase_cmp2(ws, gw, NGW, lane);
    grid.sync();
    phaseA_attn(ws, lds, gw, NGW, lane);
    grid.sync();
    { pg8::Gemm g{(const char*)ws + OFF_O, (const char*)ws + OFF_WOUTA, 1024, 1024, 0, 0}; S.init(256, 4, gridDim.x, blockIdx.x); EpiResid E{x_in, X}; pg8::gemm_phase(lds, g, S, E); }
    grid.sync();
#define FFN_BLOCK(WUP, WDN) \
    norm_rows(X, (bf16_t*)(ws + OFF_H), gw, NGW, lane); \
    grid.sync(); \
    { pg8::Gemm g{(const char*)ws + OFF_H, (const char*)ws + (WUP), 1024, 1024, 0, 0}; S.init(256, 22, gridDim.x, blockIdx.x); EpiSwiglu E{ws + OFF_ACT}; pg8::gemm_phase(lds, g, S, E); } \
    grid.sync(); \
    { pg8::Gemm g{(const char*)ws + OFF_ACT, (const char*)ws + (WDN), 2816, 2816, 0, 0}; S.init(256, 4, gridDim.x, blockIdx.x); EpiResid E{X, X}; pg8::gemm_phase(lds, g, S, E); } \
    grid.sync();
    FFN_BLOCK(OFF_WUP0, OFF_WDN0)
    norm_rows(X, (bf16_t*)(ws + OFF_H), gw, NGW, lane);
    grid.sync();
    { pg8::Gemm g{(const char*)ws + OFF_H, (const char*)ws + OFF_WQKVB, 1024, 1024, 0, 0}; S.init(256, 18, gridDim.x, blockIdx.x); EpiQKVB E{ws}; pg8::gemm_phase(lds, g, S, E); }
    grid.sync();
    phaseB_attn(ws, lds, gw, NGW, lane);
    grid.sync();
    { pg8::Gemm g{(const char*)ws + OFF_O, (const char*)ws + OFF_WOUTB, 1024, 1024, 0, 0}; S.init(256, 4, gridDim.x, blockIdx.x); EpiResid E{X, X}; pg8::gemm_phase(lds, g, S, E); }
    grid.sync();
    FFN_BLOCK(OFF_WUP1, OFF_WDN1)
    final_norm_rows(X, p.in[19], gw, NGW, lane);
}

extern "C" void kernel_launch(void* const* d_in, const int* in_sizes, int n_in, void* d_out, int out_size, void* d_ws, size_t ws_size, hipStream_t stream) {
    static int grid_blocks = 0;
    if (grid_blocks == 0) {
        if (n_in != 20 || out_size != T_TOK * DM || ws_size < WS_NEED) { fprintf(stderr, "kernel_launch: unexpected shapes (n_in %d out %d ws %zu)\n", n_in, out_size, ws_size); grid_blocks = -1; return; }
        int dev = 0, cus = 0, per_cu = 0;
        hipGetDevice(&dev); hipDeviceGetAttribute(&cus, hipDeviceAttributeMultiprocessorCount, dev);
        if (hipFuncSetAttribute((const void*)yoco_mega, hipFuncAttributeMaxDynamicSharedMemorySize, LDS_TOTAL) != hipSuccess) { fprintf(stderr, "kernel_launch: hipFuncSetAttribute failed\n"); grid_blocks = -1; return; }
        if (hipOccupancyMaxActiveBlocksPerMultiprocessor(&per_cu, (const void*)yoco_mega, 512, LDS_TOTAL) != hipSuccess || per_cu < 1) { fprintf(stderr, "kernel_launch: occupancy query gave %d\n", per_cu); per_cu = 1; }
        (void)hipGetLastError();
        grid_blocks = cus * 1;
    }
    if (grid_blocks < 0) return;
    Params p{};
    for (int i = 0; i < 20; ++i) p.in[i] = (const float*)d_in[i];
    p.out = (float*)d_out; p.ws = (unsigned char*)d_ws;
    void* args[] = {&p};
    hipError_t e = hipLaunchCooperativeKernel((const void*)yoco_mega, dim3(grid_blocks), dim3(512), args, LDS_TOTAL, stream);
    if (e != hipSuccess) fprintf(stderr, "cooperative launch failed: %s (grid %d)\n", hipGetErrorString(e), grid_blocks);
}
```

```cpp
#include <hip/hip_runtime.h>
#include <hip/hip_cooperative_groups.h>
#include <cstdio>
namespace cg = cooperative_groups;

#define LAS __attribute__((address_space(3)))
typedef unsigned short bf16_t;
typedef short bf16x8 __attribute__((ext_vector_type(8)));
typedef float f32x4 __attribute__((ext_vector_type(4)));
typedef float f32x16 __attribute__((ext_vector_type(16)));
typedef unsigned u32x4 __attribute__((ext_vector_type(4)));
typedef unsigned u32x2 __attribute__((ext_vector_type(2)));
typedef unsigned long long u64;

constexpr int T_TOK = 65536, DM = 1024, SEQ = 2048, FFH = 2816;
constexpr size_t MiB = 1ull << 20;
constexpr size_t OFF_WIN = 0, OFF_WOUTA = 6 * MiB, OFF_WUP0 = 8 * MiB, OFF_WUP1 = 19 * MiB, OFF_WDN0 = 30 * MiB, OFF_WDN1 = 36 * MiB,
                 OFF_WQKVB = 42 * MiB, OFF_WOUTB = 51 * MiB, OFF_W1 = 53 * MiB  , OFF_W2 = 55 * MiB  ,
                 OFF_BIASP = 55 * MiB + 128 * 1024  , OFF_BIAS1 = 55 * MiB + 512 * 1024  , OFF_KCMP = 56 * MiB, OFF_VCMPT = 58 * MiB, OFF_GATE = 60 * MiB,
                 OFF_SSQ = 330 * MiB + 600 * MiB  , OFF_H = 74 * MiB,
                 OFF_O = 202 * MiB, OFF_BIG = 330 * MiB, WS_NEED = 1024 * MiB;
constexpr size_t OFF_QA = OFF_BIG, OFF_BRA = OFF_BIG + 128 * MiB  , OFF_ACT = OFF_BIG,
                 OFF_QB = OFF_BIG, OFF_KVB = OFF_BIG + 384 * MiB  , OFF_G1 = OFF_O;
constexpr int LDS_STAGE = 131072, LDS_NEG = 132608  , LDS_LUT = 133120, LDS_BIAS = LDS_LUT + 2048, LDS_TOTAL = LDS_BIAS + 2048;
constexpr float LOG2E = 1.4426950408889634f;
constexpr float SC2 = 0.125f * LOG2E;

struct Params { const float* in[20]; float* out; unsigned char* ws; };

__device__ __forceinline__ unsigned cvt_pk_bf16(float lo, float hi) { unsigned r; asm volatile("v_cvt_pk_bf16_f32 %0, %1, %2" : "=v"(r) : "v"(lo), "v"(hi)); return r; }
__device__ __forceinline__ bf16_t f2bf(float f) { return (bf16_t)(cvt_pk_bf16(f, 0.f) & 0xffffu); }
__device__ __forceinline__ u32x4 pack8(f32x4 a, f32x4 b) { u32x4 o; o.x = cvt_pk_bf16(a[0], a[1]); o.y = cvt_pk_bf16(a[2], a[3]); o.z = cvt_pk_bf16(b[0], b[1]); o.w = cvt_pk_bf16(b[2], b[3]); return o; }
__device__ __forceinline__ float fexp2(float x) { return __builtin_amdgcn_exp2f(x); }
__device__ __forceinline__ float frcp(float x) { return __builtin_amdgcn_rcpf(x); }
__device__ __forceinline__ float sigmoidf_(float x) { return frcp(1.f + fexp2(-x * LOG2E)); }
__device__ __forceinline__ float wave_sum(float v) {
#pragma unroll
    for (int o = 1; o < 64; o <<= 1) v += __shfl_xor(v, o);
    return v;
}
__device__ __forceinline__ f32x16 mfma32(bf16x8 a, bf16x8 b, f32x16 c) { return __builtin_amdgcn_mfma_f32_32x32x16_bf16(a, b, c, 0, 0, 0); }
#define LDS_WAIT() asm volatile("s_waitcnt lgkmcnt(0)" ::: "memory")

namespace pg8 {
constexpr int BM = 256, BK = 64, HALF = 128, HTB = HALF * BK * 2, NXCD = 8, WGM = 8;
__device__ __forceinline__ int lds_byte(int r, int c) { const int st = (r >> 4) * 2 + (c >> 5), rr = r & 15, cc = c & 31, ob = rr * 64 + cc * 2; return st * 1024 + (ob ^ (((ob >> 9) & 1) << 5)); }
__device__ __forceinline__ void stage_rc(int b, int& R, int& C) { const int st = b / 1024, sb = b % 1024, swz = sb ^ (((sb >> 9) & 1) << 5); R = (st >> 1) * 16 + swz / 64; C = (st & 1) * 32 + (swz % 64) / 2; }
__device__ __forceinline__ int perm32(int rho) { const int n = rho >> 4, i = rho & 15; return 8 * (i >> 2) + 4 * n + (i & 3); }
struct Unit { int pm, pn; };
struct Gemm { const char* A; const char* Bt; int K; int lda; int amode; size_t a_pn_step; };
struct StaticOrder {
    int nM, nN, nwg, G, c, map;
    __device__ void init(int nM_, int nN_, int G_, int c_, int map_ = 0) { nM = nM_; nN = nN_; nwg = nM * nN; G = G_; c = c_; map = map_; }
    __device__ bool next(int i, Unit& u) const {
        const long L = (long)i * G + c; if (L >= nwg) return false;
        int wgid = (int)L; { const int q = nwg / NXCD, r = nwg % NXCD, xcd = wgid % NXCD, off = wgid / NXCD; wgid = (xcd < r ? xcd * (q + 1) : r * (q + 1) + (xcd - r) * q) + off; }
        const int nig = WGM * nN, gid = wgid / nig, fm = gid * WGM, gsz = (nM - fm) < WGM ? (nM - fm) : WGM;
        u.pm = fm + ((wgid % nig) % gsz); int pn = (wgid % nig) / gsz;
        if (map == 1) pn = pn < 7 ? pn : (pn == 7 ? 8 : 10); else if (map == 2) pn = 7 + 2 * pn; else if (map == 3) pn = pn < 12 ? pn : 12 + 2 * (pn - 12); else if (map == 4) pn = 13 + 2 * pn;
        u.pn = pn; return true;
    }
};

template <bool SWAP = false, class Epi>
__device__ __forceinline__ void gemm_phase(LAS unsigned char* lds, const Gemm g, const StaticOrder& S, const Epi& E) {
    int tid = threadIdx.x; asm volatile("" : "+v"(tid));
    const int wid = __builtin_amdgcn_readfirstlane(tid >> 6), lane = tid & 63, wr = wid >> 2, wc = wid & 3, fr = lane & 15, fq = lane >> 4;
    const int K = g.K, nt = K / BK;
    unsigned voffA[2], voffB[2];
#pragma unroll
    for (int i = 0; i < 2; ++i) { int R, C; stage_rc(tid * 16 + i * 8192, R, C); const int Rb = SWAP ? R : (R & ~31) + perm32(R & 31);
        voffA[i] = g.amode ? (unsigned)((R >> 2) * 8192 + (R & 3) * 128 + C * 2) : (unsigned)(R * g.lda + C) * 2u;
        voffB[i] = (unsigned)(Rb * K + C) * 2u; }
    const size_t kstepA = g.amode ? 512 : (size_t)(BK * 2), kstepB = (size_t)(BK * 2);
    const size_t hstepA = g.amode ? (size_t)262144 : (size_t)HALF * g.lda * 2, hstepB = (size_t)HALF * K * 2;
    const size_t tstepA = 2 * hstepA, tstepB = 2 * hstepB;
    const unsigned ldsw = (unsigned)wid * 1024u;
    const int aoff = lds_byte(wr * 64 + fr, fq * 8), boff = lds_byte(wc * 32 + fr, fq * 8);
#define PG8_SA(b, h) (((b) * 2 + (h)) * HTB)
#define PG8_SB(b, h) ((4 + (b) * 2 + (h)) * HTB)
#define PG8_STAGE(bufoff, gbase, voff) do { _Pragma("unroll") for (int _i = 0; _i < 2; ++_i) \
        __builtin_amdgcn_global_load_lds((const unsigned*)((const char*)(gbase) + (voff)[_i]), (LAS unsigned*)(lds + (bufoff) + ldsw + _i * 8192), 16, 0, 0); } while (0)
#define PG8_LDA(dst, b, h) do { _Pragma("unroll") for (int m = 0; m < 4; ++m) _Pragma("unroll") for (int k = 0; k < 2; ++k) dst[m][k] = *(const LAS bf16x8*)(lds + PG8_SA(b, h) + aoff + m * 2048 + k * 1024); } while (0)
#define PG8_LDB(dst, b, h) do { _Pragma("unroll") for (int n = 0; n < 2; ++n) _Pragma("unroll") for (int k = 0; k < 2; ++k) dst[n][k] = *(const LAS bf16x8*)(lds + PG8_SB(b, h) + boff + n * 2048 + k * 1024); } while (0)
#define PG8_MMA(ai, bj, At, Bt) do { __builtin_amdgcn_s_setprio(1); _Pragma("unroll") for (int m = 0; m < 4; ++m) _Pragma("unroll") for (int n = 0; n < 2; ++n) _Pragma("unroll") for (int k = 0; k < 2; ++k) \
        acc[ai][bj][m][n] = SWAP ? __builtin_amdgcn_mfma_f32_16x16x32_bf16(At[m][k], Bt[n][k], acc[ai][bj][m][n], 0, 0, 0) : __builtin_amdgcn_mfma_f32_16x16x32_bf16(Bt[n][k], At[m][k], acc[ai][bj][m][n], 0, 0, 0); __builtin_amdgcn_s_setprio(0); } while (0)
#define PG8_WAIT_V(n) asm volatile("s_waitcnt vmcnt(" #n ")" ::: "memory")
#define PG8_WAIT_L(n) asm volatile("s_waitcnt lgkmcnt(" #n ")" ::: "memory")
#define PG8_BAR __builtin_amdgcn_s_barrier()
#define PG8_SCHED __builtin_amdgcn_sched_barrier(0)
    Unit cur, nxt; int ui = 0;
    if (!S.next(0, cur)) return;
    f32x4 acc[2][2][4][2];
#pragma unroll
    for (int a = 0; a < 2; ++a)
#pragma unroll
        for (int b = 0; b < 2; ++b)
#pragma unroll
            for (int m = 0; m < 4; ++m)
#pragma unroll
                for (int n = 0; n < 2; ++n) acc[a][b][m][n] = (f32x4){0.f, 0.f, 0.f, 0.f};
    bf16x8 At[4][2], B0[2][2], B1[2][2];
    const char* cA = g.A + (size_t)cur.pm * tstepA + (size_t)cur.pn * g.a_pn_step; const char* cB = g.Bt + (size_t)cur.pn * tstepB;
    PG8_STAGE(PG8_SB(0, 0), cB, voffB); PG8_STAGE(PG8_SA(0, 0), cA, voffA); PG8_STAGE(PG8_SB(0, 1), cB + hstepB, voffB); PG8_STAGE(PG8_SA(0, 1), cA + hstepA, voffA);
    if (wr == 1) PG8_BAR;
    PG8_WAIT_V(4); PG8_BAR;
    PG8_STAGE(PG8_SB(1, 0), cB + kstepB, voffB); PG8_STAGE(PG8_SA(1, 0), cA + kstepA, voffA); PG8_STAGE(PG8_SB(1, 1), cB + hstepB + kstepB, voffB);
    PG8_WAIT_V(6); PG8_BAR;
    for (;;) {
        const bool has_next = S.next(ui + 1, nxt);
        const char* nA = has_next ? g.A + (size_t)nxt.pm * tstepA + (size_t)nxt.pn * g.a_pn_step : cA; const char* nB = has_next ? g.Bt + (size_t)nxt.pn * tstepB : cB;
        for (int t = 0; t < nt; t += 2) {
            const bool last = (t == nt - 2);
            const char* a1 = cA + (size_t)(t + 1) * kstepA;
            const char* a2 = last ? nA : cA + (size_t)(t + 2) * kstepA; const char* b2 = last ? nB : cB + (size_t)(t + 2) * kstepB;
            const char* a3 = a2 + kstepA; const char* b3 = b2 + kstepB;
            PG8_LDB(B0, 0, 0); PG8_SCHED; PG8_LDA(At, 0, 0); PG8_STAGE(PG8_SA(1, 1), a1 + hstepA, voffA);
            PG8_WAIT_L(8); PG8_BAR; PG8_WAIT_L(0); PG8_MMA(0, 0, At, B0); PG8_BAR; PG8_SCHED;
            PG8_LDB(B1, 0, 1); PG8_STAGE(PG8_SB(0, 0), b2, voffB);
            PG8_BAR; PG8_WAIT_L(0); PG8_MMA(0, 1, At, B1); PG8_BAR;
            PG8_LDA(At, 0, 1); PG8_STAGE(PG8_SA(0, 0), a2, voffA);
            PG8_BAR; PG8_WAIT_L(0); PG8_MMA(1, 0, At, B0); PG8_BAR; PG8_SCHED;
            PG8_STAGE(PG8_SB(0, 1), b2 + hstepB, voffB);
            PG8_WAIT_V(6); PG8_BAR; PG8_MMA(1, 1, At, B1); PG8_BAR;
            PG8_LDB(B0, 1, 0); PG8_SCHED; PG8_LDA(At, 1, 0); PG8_STAGE(PG8_SA(0, 1), a2 + hstepA, voffA);
            PG8_WAIT_L(8); PG8_BAR; PG8_WAIT_L(0); PG8_MMA(0, 0, At, B0); PG8_BAR; PG8_SCHED;
            PG8_LDB(B1, 1, 1); PG8_STAGE(PG8_SB(1, 0), b3, voffB);
            PG8_BAR; PG8_WAIT_L(0); PG8_MMA(0, 1, At, B1); PG8_BAR;
            PG8_LDA(At, 1, 1); PG8_STAGE(PG8_SA(1, 0), a3, voffA);
            PG8_BAR; PG8_WAIT_L(0); PG8_MMA(1, 0, At, B0); PG8_BAR; PG8_SCHED;
            PG8_STAGE(PG8_SB(1, 1), b3 + hstepB, voffB);
            PG8_WAIT_V(6); PG8_BAR; PG8_MMA(1, 1, At, B1); PG8_BAR;
        }
        E(acc, cur, wr, wc, fr, fq);
        if (!has_next) break;
#pragma unroll
        for (int a = 0; a < 2; ++a)
#pragma unroll
            for (int b = 0; b < 2; ++b)
#pragma unroll
                for (int m = 0; m < 4; ++m)
#pragma unroll
                    for (int n = 0; n < 2; ++n) acc[a][b][m][n] = (f32x4){0.f, 0.f, 0.f, 0.f};
        cur = nxt; cA = nA; cB = nB; ++ui;
    }
    PG8_WAIT_V(0);
    if (wr == 0) PG8_BAR;
    PG8_BAR;
#undef PG8_SA
#undef PG8_SB
#undef PG8_STAGE
#undef PG8_LDA
#undef PG8_LDB
#undef PG8_MMA
#undef PG8_WAIT_V
#undef PG8_WAIT_L
#undef PG8_BAR
#undef PG8_SCHED
}
}
using pg8::Unit;
typedef f32x4 Acc[2][2][4][2];

#define OPAQUE(v) asm volatile("" : "+v"(v))
__device__ __forceinline__ void load_row_rs(float (&rv)[2], const unsigned char* sp, int wr, int fr, int fq);
__device__ __forceinline__ float row_rs(float ssq) { return 1.f / sqrtf(ssq * (1.f / DM) + 1e-6f); }
__device__ __forceinline__ float row_rs16(const unsigned char* p) { const f32x4 a = *(const f32x4*)p, b = *(const f32x4*)(p + 16), c = *(const f32x4*)(p + 32), d = *(const f32x4*)(p + 48);
    return row_rs(((a[0] + a[1]) + (a[2] + a[3])) + ((b[0] + b[1]) + (b[2] + b[3])) + ((c[0] + c[1]) + (c[2] + c[3])) + ((d[0] + d[1]) + (d[2] + d[3]))); }
__device__ __forceinline__ void load_row_rs(float (&rv)[2], const unsigned char* sp, int wr, int fr, int fq) {
    unsigned so = (unsigned)(wr * 64 + fq * 16 + fr) * 64u; OPAQUE(so);
    rv[0] = row_rs16(sp + so); rv[1] = row_rs16(sp + (so + 128u * 64u));
}
struct EpiWin {
    unsigned char* ws; const float* b_gate; const float* ssq;
    __device__ __forceinline__ void operator()(const Acc& acc, const Unit& u, int wr, int wc, int fr, int fq) const {
        const int pn = u.pn; unsigned rl = wr * 64 + fr, cw = wc * 32 + 8 * fq; OPAQUE(rl); OPAQUE(cw); const size_t rowt = (size_t)u.pm * 256;
        float rs[2][4]; { float rv[2]; load_row_rs(rv, (const unsigned char*)(ssq + rowt * 16), wr, fr, fq);
#pragma unroll
            for (int ai = 0; ai < 2; ++ai)
#pragma unroll
                for (int m = 0; m < 4; ++m) rs[ai][m] = __shfl(rv[ai], m * 16 + fr); }
        if (pn < 4) {
            unsigned char* base = ws + OFF_QA + (rowt * 1024 + pn * 256) * 2; unsigned lo = (rl * 1024 + cw) * 2; OPAQUE(lo);
#pragma unroll
            for (int ai = 0; ai < 2; ++ai)
#pragma unroll
                for (int m = 0; m < 4; ++m)
#pragma unroll
                    for (int bj = 0; bj < 2; ++bj) *(u32x4*)(base + (lo + (unsigned)(((ai * 128 + m * 16) * 1024 + bj * 128) * 2))) = pack8(acc[ai][bj][m][0] * rs[ai][m], acc[ai][bj][m][1] * rs[ai][m]);
        } else if (pn < 10) {
            const int br = pn - 4; const int b = u.pm >> 3, tb = (u.pm & 7) * 8;
            if (br == 2 || br == 4) {
                unsigned char* base = ws + OFF_BRA + (size_t)br * 32 * MiB + ((size_t)b * 4 * 2048 * 64 + (size_t)tb * 2048) * 2;
                unsigned lo = ((cw >> 6) * 2048 * 64 + ((wr * 8 + ((cw & 63) >> 4)) * 64 + ((cw >> 3) & 1) * 32 + fr) * 8) * 2; OPAQUE(lo);
#pragma unroll
                for (int ai = 0; ai < 2; ++ai)
#pragma unroll
                    for (int m = 0; m < 4; ++m)
#pragma unroll
                        for (int bj = 0; bj < 2; ++bj) *(u32x4*)(base + (lo + (unsigned)((bj * 2 * 2048 * 64 + ((ai * 4 + (m >> 1)) * 4 * 64 + (m & 1) * 16) * 8) * 2))) = pack8(acc[ai][bj][m][0] * rs[ai][m], acc[ai][bj][m][1] * rs[ai][m]);
            } else {
                unsigned char* base = ws + OFF_BRA + (size_t)br * 32 * MiB + rowt * 256 * 2; unsigned lo = (rl * 256 + cw) * 2; OPAQUE(lo);
#pragma unroll
                for (int ai = 0; ai < 2; ++ai)
#pragma unroll
                    for (int m = 0; m < 4; ++m)
#pragma unroll
                        for (int bj = 0; bj < 2; ++bj) *(u32x4*)(base + (lo + (unsigned)(((ai * 128 + m * 16) * 256 + bj * 128) * 2))) = pack8(acc[ai][bj][m][0] * rs[ai][m], acc[ai][bj][m][1] * rs[ai][m]);
            }
        } else {
            if (cw < 48) {
                unsigned char* base = ws + OFF_GATE + rowt * 48 * 4; unsigned lo = (rl * 48 + cw) * 4; OPAQUE(lo);
                float bg[8];
#pragma unroll
                for (int e = 0; e < 8; ++e) bg[e] = (cw + e < 48) ? b_gate[cw + e] : 0.f;
#pragma unroll
                for (int ai = 0; ai < 2; ++ai)
#pragma unroll
                    for (int m = 0; m < 4; ++m) { const f32x4 v0 = acc[ai][0][m][0] * rs[ai][m], v1 = acc[ai][0][m][1] * rs[ai][m];
#pragma unroll
                        for (int e = 0; e < 4; ++e) { if (cw + e < 48) *(float*)(base + (lo + (unsigned)(((ai * 128 + m * 16) * 48 + e) * 4))) = sigmoidf_(v0[e] + bg[e]);
                            if (cw + 4 + e < 48) *(float*)(base + (lo + (unsigned)(((ai * 128 + m * 16) * 48 + e + 4) * 4))) = sigmoidf_(v1[e] + bg[4 + e]); } }
            }
        }
    }
};
template <int LAYER>
struct EpiV {
    unsigned char* ws; const float* ssq;
    __device__ __forceinline__ void operator()(const Acc& acc, const Unit& u, int wr, int wc, int fr, int fq) const {
        const int pn = u.pn, b = u.pm >> 3; const size_t rowt = (size_t)u.pm * 256;
        const int idx = LAYER ? pn - 12 : 0, dsh = LAYER ? 2 * (idx >> 1) : 0, lsh = 11 - dsh;
        unsigned char* base = ws + (LAYER ? OFF_KVB + (size_t)idx * 32 * MiB : OFF_BRA + (size_t)(pn - 4) * 32 * MiB) + ((size_t)b * 4 * 2048 * 64) * 2;
        unsigned lo = ((wc >> 1) * 2048 * 64 + ((wc & 1) * 128 + fr) * 8) * 2; OPAQUE(lo);
        f32x4 rsv[2][4]; { float rv[2]; load_row_rs(rv, (const unsigned char*)(ssq + rowt * 16), wr, fr, fq);
#pragma unroll
        for (int ai = 0; ai < 2; ++ai)
#pragma unroll
            for (int m = 0; m < 4; ++m)
#pragma unroll
                for (int j = 0; j < 4; ++j) rsv[ai][m][j] = __shfl(rv[ai], m * 16 + 4 * fq + j); }
        if (dsh == 0) {
            const unsigned tb = (u.pm & 7) * 8;
            unsigned lk = (((tb + wr * 2) * 4) * 64 + (fq & 1) * 32) * 16 + (fq >> 1) * 8; OPAQUE(lk);
#pragma unroll
            for (int ai = 0; ai < 2; ++ai)
#pragma unroll
                for (int m = 0; m < 4; ++m) { const f32x4 rs = rsv[ai][m];
#pragma unroll
                    for (int bj = 0; bj < 2; ++bj)
#pragma unroll
                        for (int n = 0; n < 2; ++n) { const f32x4 v = acc[ai][bj][m][n] * rs; u32x2 w; w.x = cvt_pk_bf16(v[0], v[1]); w.y = cvt_pk_bf16(v[2], v[3]);
                            *(u32x2*)(base + (lo + lk + (unsigned)((bj * 2 * 2048 * 64 + ((((ai * 4 + (m >> 1)) * 4 + (m & 1)) * 64) + 16 * n) * 8) * 2))) = w; }
                    __builtin_amdgcn_sched_barrier(0); }
        } else {
            const unsigned sb = ((u.pm & 7) * 256) >> dsh; unsigned slb = wr * 64 + 4 * fq; OPAQUE(slb);
#pragma unroll
            for (int ai = 0; ai < 2; ++ai)
#pragma unroll
                for (int m = 0; m < 4; ++m) {
#pragma unroll
                    for (int j = 0; j < 4; ++j) { const float rs = rsv[ai][m][j]; const unsigned sl = slb + (unsigned)(ai * 128 + m * 16 + j);
                        const unsigned p = ((sl & ((1u << dsh) - 1u)) << lsh) + (sl >> dsh) + sb, kk = p & 31u, k16 = kk & 15u;
                        const unsigned po = (((p >> 5) * 4 + (kk >> 4)) * 64 + ((k16 >> 2) & 1u) * 32) * 16 + (((k16 >> 3) << 2) + (k16 & 3u)) * 2;
#pragma unroll
                        for (int bj = 0; bj < 2; ++bj)
#pragma unroll
                            for (int n = 0; n < 2; ++n) *(bf16_t*)(base + (lo + po + (unsigned)((bj * 2 * 2048 * 64 + 16 * n * 8) * 2))) = f2bf(acc[ai][bj][m][n][j] * rs); }
                    __builtin_amdgcn_sched_barrier(0); }
        }
    }
};
struct EpiQKVB {
    unsigned char* ws; const float* ssq;
    __device__ __forceinline__ void operator()(const Acc& acc, const Unit& u, int wr, int wc, int fr, int fq) const {
        const int pn = u.pn; unsigned rl = wr * 64 + fr, cw = wc * 32 + 8 * fq; OPAQUE(rl); OPAQUE(cw); const size_t rowt = (size_t)u.pm * 256;
        float rs[2][4]; { float rv[2]; load_row_rs(rv, (const unsigned char*)(ssq + rowt * 16), wr, fr, fq);
#pragma unroll
            for (int ai = 0; ai < 2; ++ai)
#pragma unroll
                for (int m = 0; m < 4; ++m) rs[ai][m] = __shfl(rv[ai], m * 16 + fr); }
        if (pn < 12) {
            unsigned char* base = ws + OFF_QB + (rowt * 3072 + pn * 256) * 2; unsigned lo = (rl * 3072 + cw) * 2; OPAQUE(lo);
#pragma unroll
            for (int ai = 0; ai < 2; ++ai)
#pragma unroll
                for (int m = 0; m < 4; ++m)
#pragma unroll
                    for (int bj = 0; bj < 2; ++bj) *(u32x4*)(base + (lo + (unsigned)(((ai * 128 + m * 16) * 3072 + bj * 128) * 2))) = pack8(acc[ai][bj][m][0] * rs[ai][m], acc[ai][bj][m][1] * rs[ai][m]);
        } else {
            const int idx = pn - 12, gi = idx >> 1, dsh = 2 * gi, lsh = 11 - dsh, b = u.pm >> 3, sb = ((u.pm & 7) * 256) >> dsh;
            unsigned posl = ((rl & ((1u << dsh) - 1u)) << lsh) + (rl >> dsh) + sb; OPAQUE(posl);
            unsigned char* base = ws + OFF_KVB + (size_t)idx * 32 * MiB + ((size_t)b * 4 * 2048 * 64) * 2;
            unsigned lo = ((cw >> 6) * 2048 * 64 + (((cw & 63) >> 4) * 64 + ((cw >> 3) & 1) * 32) * 8) * 2; OPAQUE(lo);
#pragma unroll
            for (int ai = 0; ai < 2; ++ai)
#pragma unroll
                for (int m = 0; m < 4; ++m) { const unsigned p = posl + (unsigned)((ai * 128 + m * 16) >> dsh), po = ((p >> 5) * 256 + (p & 31u)) * 16;
#pragma unroll
                    for (int bj = 0; bj < 2; ++bj) *(u32x4*)(base + (lo + po + (unsigned)(bj * 2 * 2048 * 64 * 2))) = pack8(acc[ai][bj][m][0] * rs[ai][m], acc[ai][bj][m][1] * rs[ai][m]); }
        }
    }
};
template <bool NORM_OUT>
struct EpiResid {
    const float* xin; float* xout; unsigned char* hout; float* ssq;
    __device__ __forceinline__ void operator()(const Acc& acc, const Unit& u, int wr, int wc, int fr, int fq) const {
        unsigned rl = wr * 64 + fr, cw = wc * 32 + 8 * fq; OPAQUE(rl); OPAQUE(cw); const size_t t0 = ((size_t)u.pm * 256 * 1024 + u.pn * 256) * 4;
        const unsigned char* bi = (const unsigned char*)xin + t0; unsigned char* bo = (unsigned char*)xout + t0; unsigned char* bh = hout + (t0 >> 1); unsigned lo = (rl * 1024 + cw) * 4; OPAQUE(lo);
        float* sq = ssq + ((size_t)u.pm * 256 + rl) * 16 + u.pn * 4 + wc;
#pragma unroll
        for (int ai = 0; ai < 2; ++ai) {
            f32x4 xa[4][2][2];
#pragma unroll
            for (int m = 0; m < 4; ++m)
#pragma unroll
                for (int bj = 0; bj < 2; ++bj) { const unsigned o = lo + (unsigned)(((ai * 128 + m * 16) * 1024 + bj * 128) * 4); xa[m][bj][0] = *(const f32x4*)(bi + o); xa[m][bj][1] = *(const f32x4*)(bi + o + 16); }
            __builtin_amdgcn_sched_barrier(0);
#pragma unroll
            for (int m = 0; m < 4; ++m) { float q = 0.f;
#pragma unroll
                for (int bj = 0; bj < 2; ++bj) { const unsigned o = lo + (unsigned)(((ai * 128 + m * 16) * 1024 + bj * 128) * 4);
                    const f32x4 a = xa[m][bj][0] + acc[ai][bj][m][0], c = xa[m][bj][1] + acc[ai][bj][m][1];
                    *(f32x4*)(bo + o) = a; *(f32x4*)(bo + o + 16) = c;
                    if (NORM_OUT) { *(u32x4*)(bh + (o >> 1)) = pack8(a, c); q += (a[0] * a[0] + a[1] * a[1]) + (a[2] * a[2] + a[3] * a[3]) + (c[0] * c[0] + c[1] * c[1]) + (c[2] * c[2] + c[3] * c[3]); } }
                if (NORM_OUT) { q += __shfl_xor(q, 16); q += __shfl_xor(q, 32); if (fq == 0) sq[(ai * 128 + m * 16) * 16] = q; } }
        }
    }
};
struct EpiSwiglu {
    unsigned char* act; const float* ssq;
    __device__ __forceinline__ void operator()(const Acc& acc, const Unit& u, int wr, int wc, int fr, int fq) const {
        unsigned rl = wr * 64 + fr, cw = wc * 32 + 8 * fq; OPAQUE(rl); OPAQUE(cw); unsigned char* base = act + ((size_t)u.pm * 256 * FFH + u.pn * 128) * 2; unsigned lo = (rl * FFH + cw) * 2; OPAQUE(lo);
        float rsv[2][4]; { float rv[2]; load_row_rs(rv, (const unsigned char*)(ssq + (size_t)u.pm * 256 * 16), wr, fr, fq);
#pragma unroll
        for (int ai = 0; ai < 2; ++ai)
#pragma unroll
            for (int m = 0; m < 4; ++m) rsv[ai][m] = __shfl(rv[ai], m * 16 + fr); }
#pragma unroll
        for (int ai = 0; ai < 2; ++ai)
#pragma unroll
            for (int m = 0; m < 4; ++m) { f32x4 h0, h1; const float rs = rsv[ai][m];
#pragma unroll
                for (int e = 0; e < 4; ++e) { const float a0 = acc[ai][0][m][0][e] * rs, a1 = acc[ai][0][m][1][e] * rs;
                    h0[e] = a0 * sigmoidf_(a0) * (acc[ai][1][m][0][e] * rs); h1[e] = a1 * sigmoidf_(a1) * (acc[ai][1][m][1][e] * rs); }
                *(u32x4*)(base + (lo + (unsigned)((ai * 128 + m * 16) * FFH * 2))) = pack8(h0, h1); }
    }
};
struct EpiCmp1 {
    unsigned char* ws;
    __device__ __forceinline__ void operator()(const Acc& acc, const Unit& u, int wr, int wc, int fr, int fq) const {
        const int kv = u.pn; unsigned rl = wr * 64 + fr, cw = wc * 32 + 8 * fq; OPAQUE(rl); OPAQUE(cw);
        unsigned char* base = ws + OFF_G1 + (((size_t)kv * 16384 + (size_t)u.pm * 256) * 256) * 2; unsigned lo = (rl * 256 + cw) * 2; OPAQUE(lo);
        const unsigned char* bp = ws + OFF_BIAS1 + (size_t)kv * 256 * 4; unsigned blo = cw * 4; OPAQUE(blo);
#pragma unroll
        for (int bj = 0; bj < 2; ++bj) {
            const f32x4 b0 = *(const f32x4*)(bp + (blo + (unsigned)(bj * 128 * 4))), b1 = *(const f32x4*)(bp + (blo + (unsigned)(bj * 128 * 4 + 16)));
#pragma unroll
            for (int ai = 0; ai < 2; ++ai)
#pragma unroll
                for (int m = 0; m < 4; ++m) { f32x4 h0, h1;
#pragma unroll
                    for (int e = 0; e < 4; ++e) {
                        const float x0 = acc[ai][bj][m][0][e] + b0[e], x1 = acc[ai][bj][m][1][e] + b1[e];
                        const float u0 = 0.7978845608028654f * (x0 + 0.044715f * x0 * x0 * x0), u1 = 0.7978845608028654f * (x1 + 0.044715f * x1 * x1 * x1);
                        h0[e] = x0 * sigmoidf_(2.f * u0); h1[e] = x1 * sigmoidf_(2.f * u1); }
                    *(u32x4*)(base + (lo + (unsigned)(((ai * 128 + m * 16) * 256 + bj * 128) * 2))) = pack8(h0, h1); }
        }
    }
};

__device__ __forceinline__ void conv_weight(const float* W, int K, int N, const float* gain, bf16_t* WT, int row_off, int mode, LAS float* scr, int gw, int NGW, int lane) {
    const int nnb = (N + 31) / 32, nitems = (K / 64) * nnb;
    for (int item = gw; item < nitems; item += NGW) {
        const int kb = item / nnb, nb = item % nnb, k0 = 64 * kb, n0 = 32 * nb;
#pragma unroll 8
        for (int i = 0; i < 32; ++i) { const int kk = 2 * i + (lane >> 5), n = n0 + (lane & 31);
            float v = (n < N) ? W[(size_t)(k0 + kk) * N + n] : 0.f; if (gain) v *= gain[k0 + kk]; scr[kk * 33 + (lane & 31)] = v; }
        LDS_WAIT();
        int dr0 = row_off + n0;
        if (mode == 1) dr0 = (n0 < FFH) ? ((n0 >> 7) * 256 + (n0 & 127)) : ((((n0 - FFH) >> 7) * 256) + 128 + ((n0 - FFH) & 127));
        const int c = lane & 7;
#pragma unroll
        for (int j = 0; j < 4; ++j) { const int nn = (lane >> 3) + 8 * j; const LAS float* s = scr + (8 * c) * 33 + nn;
            u32x4 o; o.x = cvt_pk_bf16(s[0 * 33], s[1 * 33]); o.y = cvt_pk_bf16(s[2 * 33], s[3 * 33]); o.z = cvt_pk_bf16(s[4 * 33], s[5 * 33]); o.w = cvt_pk_bf16(s[6 * 33], s[7 * 33]);
            if (n0 + nn < N) *(u32x4*)(WT + (size_t)(dr0 + nn) * K + k0 + 8 * c) = o; }
        LDS_WAIT();
    }
}
__device__ __forceinline__ void cast_rows(const float* x, bf16_t* h, float* ssq, int gw, int NGW, int lane) {
    for (int row = gw; row < T_TOK; row += NGW) {
        const f32x4* xr = (const f32x4*)(x + (size_t)row * DM) + lane; f32x4 v[4]; float s = 0.f;
#pragma unroll
        for (int j = 0; j < 4; ++j) { v[j] = xr[64 * j]; s += (v[j][0] * v[j][0] + v[j][1] * v[j][1]) + (v[j][2] * v[j][2] + v[j][3] * v[j][3]); }
        s = wave_sum(s);
        u32x2* o = (u32x2*)(h + (size_t)row * DM) + lane;
#pragma unroll
        for (int j = 0; j < 4; ++j) { u32x2 w; w.x = cvt_pk_bf16(v[j][0], v[j][1]); w.y = cvt_pk_bf16(v[j][2], v[j][3]); o[64 * j] = w; }
        if (lane < 16) ssq[(size_t)row * 16 + lane] = lane == 0 ? s : 0.f;
    }
}
__device__ __forceinline__ void final_norm_rows(float* x, const float* gain, int gw, int NGW) {
    const int lane = threadIdx.x & 63;
    f32x4 gv[4];
#pragma unroll
    for (int j = 0; j < 4; ++j) gv[j] = ((const f32x4*)gain)[lane + 64 * j];
    for (int row = gw; row < T_TOK; row += NGW) {
        f32x4* xr = (f32x4*)(x + (size_t)row * DM) + lane; f32x4 v[4]; float s = 0.f;
#pragma unroll
        for (int j = 0; j < 4; ++j) { v[j] = xr[64 * j]; s += (v[j][0] * v[j][0] + v[j][1] * v[j][1]) + (v[j][2] * v[j][2] + v[j][3] * v[j][3]); }
        const float r = 1.f / sqrtf(wave_sum(s) * (1.f / DM) + 1e-6f);
#pragma unroll
        for (int j = 0; j < 4; ++j) xr[64 * j] = v[j] * r * gv[j];
    }
}

struct SoftState { float m, l; f32x16 o0, o1; };
struct KFrag { bf16x8 k0, k1, k2, k3; };
__device__ __forceinline__ bf16x8 ld_v8(const char* p) { const u64 lo = *(const u64*)p, hi = *(const u64*)(p + 16); u32x4 t; t.x = (unsigned)lo; t.y = (unsigned)(lo >> 32); t.z = (unsigned)hi; t.w = (unsigned)(hi >> 32); return __builtin_bit_cast(bf16x8, t); }
__device__ __forceinline__ bf16x8 pk_lo(const f32x16& p) { u32x4 t; t.x = cvt_pk_bf16(p[0], p[1]); t.y = cvt_pk_bf16(p[2], p[3]); t.z = cvt_pk_bf16(p[4], p[5]); t.w = cvt_pk_bf16(p[6], p[7]); return __builtin_bit_cast(bf16x8, t); }
__device__ __forceinline__ bf16x8 pk_hi(const f32x16& p) { u32x4 t; t.x = cvt_pk_bf16(p[8], p[9]); t.y = cvt_pk_bf16(p[10], p[11]); t.z = cvt_pk_bf16(p[12], p[13]); t.w = cvt_pk_bf16(p[14], p[15]); return __builtin_bit_cast(bf16x8, t); }
__device__ __forceinline__ void load_k(KFrag& f, const char* kp) { f.k0 = *(const bf16x8*)kp; f.k1 = *(const bf16x8*)(kp + 1024); f.k2 = *(const bf16x8*)(kp + 2048); f.k3 = *(const bf16x8*)(kp + 3072); }
__device__ __forceinline__ void tile_compute(SoftState& st, const bf16x8 (&qf)[4], const KFrag& f, const char* vp, const LAS unsigned char* lds, unsigned vb, int dist0, int max_dist, bool masked) {
    const bf16x8 v00 = *(const bf16x8*)vp, v01 = *(const bf16x8*)(vp + 1024), v10 = *(const bf16x8*)(vp + 2048), v11 = *(const bf16x8*)(vp + 3072);
    f32x16 s = {0.f, 0.f, 0.f, 0.f, 0.f, 0.f, 0.f, 0.f, 0.f, 0.f, 0.f, 0.f, 0.f, 0.f, 0.f, 0.f};
    s = mfma32(f.k0, qf[0], s); s = mfma32(f.k1, qf[1], s); s = mfma32(f.k2, qf[2], s); s = mfma32(f.k3, qf[3], s);
    f32x16 t;
#pragma unroll
    for (int i = 0; i < 16; ++i) t[i] = s[i] * SC2 + *(const LAS float*)(lds + vb + 4 * (27 - ((i & 3) + 8 * (i >> 2))));
    if (masked) {
#pragma unroll
        for (int i = 0; i < 16; ++i) t[i] = ((unsigned)(dist0 - ((i & 3) + 8 * (i >> 2))) <= (unsigned)max_dist) ? t[i] : -__builtin_inff();
    }
    float mx = fmaxf(fmaxf(fmaxf(t[0], t[1]), fmaxf(t[2], t[3])), fmaxf(fmaxf(t[4], t[5]), fmaxf(t[6], t[7])));
    mx = fmaxf(mx, fmaxf(fmaxf(fmaxf(t[8], t[9]), fmaxf(t[10], t[11])), fmaxf(fmaxf(t[12], t[13]), fmaxf(t[14], t[15]))));
    mx = fmaxf(mx, __shfl_xor(mx, 32));
    if (__builtin_amdgcn_ballot_w64(mx > st.m) != 0ull) { const float mnew = fmaxf(mx, st.m), alpha = fexp2(st.m - mnew); st.l *= alpha; st.o0 *= alpha; st.o1 *= alpha; st.m = mnew; }
    float ls = 0.f;
#pragma unroll
    for (int i = 0; i < 16; ++i) { t[i] = fexp2(t[i] - st.m); ls += t[i]; }
    st.l += ls;
    const bf16x8 pb0 = pk_lo(t), pb1 = pk_hi(t);
    st.o0 = mfma32(v00, pb0, st.o0); st.o0 = mfma32(v01, pb1, st.o0); st.o1 = mfma32(v10, pb0, st.o1); st.o1 = mfma32(v11, pb1, st.o1);
}
__device__ __forceinline__ void soft_init(SoftState& st) { st.m = -1e30f; st.l = 0.f;
#pragma unroll
    for (int i = 0; i < 16; ++i) { st.o0[i] = 0.f; st.o1[i] = 0.f; } }

__device__ __forceinline__ void run_range(SoftState& st, const bf16x8 (&qf)[4], const char* Kl, const char* Vl, int kt_lo, int kt_hi,
                                          int qpos, int qmin, int qmax, int max_dist, unsigned tb_head, const LAS unsigned char* lds, int h) {
    KFrag A, B;
    load_k(A, Kl + (size_t)kt_lo * 4096);
#pragma unroll 1
    for (int kt = kt_lo; kt <= kt_hi; ++kt) {
        if (kt + 1 <= kt_hi) load_k(B, Kl + (size_t)(kt + 1) * 4096);
        const int kbase = 32 * kt, dist0 = qpos - kbase - 4 * h; const unsigned vb = tb_head + (unsigned)(4 * (dist0 - 27));
        const bool masked = !(qmin - kbase - 31 >= 0 && qmax - kbase <= max_dist);
        tile_compute(st, qf, A, Vl + (size_t)kt * 4096, lds, vb, dist0, max_dist, masked);
        A = B;
    }
}

constexpr int ATT_TAB = 1024  , ATT_HS_A = 2056  , ATT_HS_B = 136  , ATT_NEG = LDS_NEG;

__device__ __forceinline__ void phaseA_attn(unsigned char* ws, LAS unsigned char* lds, int gw, int NGW) {
    const int lane = threadIdx.x & 63;
    const int r = lane & 31, h = lane >> 5, tk = r >> 2, rr = r & 3;
    const LAS unsigned char* lut = lds + LDS_LUT; const LAS float* bias2 = (const LAS float*)(lds + LDS_BIAS);
    { LAS float* tab = (LAS float*)(lds + ATT_TAB);
      for (int i = threadIdx.x; i < 16 * ATT_HS_A; i += 512) { const int hd = i / ATT_HS_A, d = i - hd * ATT_HS_A; tab[i] = d < 2048 ? bias2[(int)lut[d] * 16 + hd] : 0.f; }
      if (threadIdx.x < 256) ((LAS float*)lds)[threadIdx.x] = 0.f;
      if (threadIdx.x < 64) ((LAS float*)(lds + ATT_NEG))[threadIdx.x] = -__builtin_inff();
      __syncthreads(); }
    for (int item = gw; item < 32768; item += NGW) {
        const int bg = item >> 8, ti = ((item & 255) + 16 * (item >> 11)) & 255, b = bg >> 2, g = bg & 3, s0 = ti * 8, s = s0 + tk, head = g * 4 + rr, cur = s0 >> 6;
        const size_t tok = (size_t)b * 2048 + s;
        const LAS float* bias2h = bias2 + head;
        const unsigned tb_head = (unsigned)(ATT_TAB + head * ATT_HS_A * 4);
        bf16x8 qf[4];
        { const char* qp = (const char*)ws + OFF_QA + (tok * 1024 + head * 64 + 8 * h) * 2;
#pragma unroll
          for (int ks = 0; ks < 4; ++ks) qf[ks] = *(const bf16x8*)(qp + 32 * ks); }
        const float* gp = (const float*)(ws + OFF_GATE) + tok * 48 + head * 3; const float g_cmp = gp[0], g_sel = gp[1], g_win = gp[2];
        unsigned tp[16]; unsigned sel;
        {
            const char* Kc = (const char*)ws + OFF_KCMP + (size_t)bg * 128 * 128; const char* Vc = (const char*)ws + OFF_VCMPT + (size_t)bg * 64 * 256;
            f32x16 sc[4];
#pragma unroll
            for (int c = 0; c < 4; ++c) { const char* kp = Kc + (32 * c + r) * 128 + 16 * h; f32x16 a = {0.f, 0.f, 0.f, 0.f, 0.f, 0.f, 0.f, 0.f, 0.f, 0.f, 0.f, 0.f, 0.f, 0.f, 0.f, 0.f};
#pragma unroll
                for (int ks = 0; ks < 4; ++ks) a = mfma32(*(const bf16x8*)(kp + 32 * ks), qf[ks], a); sc[c] = a; }
            __builtin_amdgcn_sched_barrier(0);
            float mx = -1e30f;
#pragma unroll
            for (int c = 0; c < 4; ++c)
#pragma unroll
                for (int i = 0; i < 16; ++i) { const int n = 32 * c + (i & 3) + 8 * (i >> 2) + 4 * h, dist = s - 16 * n - 31; const bool valid = dist >= 0; const int idx = dist < 0 ? 0 : dist;
                    const float t = valid ? sc[c][i] * SC2 + bias2h[(int)lut[idx] * 16] : -1e30f; sc[c][i] = t; mx = fmaxf(mx, t); }
            mx = fmaxf(mx, __shfl_xor(mx, 32)); float l = 0.f;
#pragma unroll
            for (int c = 0; c < 4; ++c)
#pragma unroll
                for (int i = 0; i < 16; ++i) { const float pv = sc[c][i] > -1e29f ? fexp2(sc[c][i] - mx) : 0.f; sc[c][i] = pv; l += pv; }
            l += __shfl_xor(l, 32); const float inv = 1.f / fmaxf(l, 1e-30f);
#pragma unroll
            for (int c = 0; c < 4; ++c) sc[c] *= inv;
            __builtin_amdgcn_sched_barrier(0);
            f32x16 oc0 = {0.f, 0.f, 0.f, 0.f, 0.f, 0.f, 0.f, 0.f, 0.f, 0.f, 0.f, 0.f, 0.f, 0.f, 0.f, 0.f}, oc1 = oc0;
#pragma unroll
            for (int c = 0; c < 4; ++c) { const bf16x8 pb0 = pk_lo(sc[c]), pb1 = pk_hi(sc[c]); const char* vp0 = Vc + r * 256 + (32 * c + 4 * h) * 2; const char* vp1 = vp0 + 32 * 256;
                oc0 = mfma32(ld_v8(vp0), pb0, oc0); oc0 = mfma32(ld_v8(vp0 + 32), pb1, oc0); oc1 = mfma32(ld_v8(vp1), pb0, oc1); oc1 = mfma32(ld_v8(vp1 + 32), pb1, oc1); }
            oc0 *= g_cmp; oc1 *= g_cmp;
#pragma unroll
            for (int q = 0; q < 8; ++q) { tp[q] = cvt_pk_bf16(oc0[2 * q], oc0[2 * q + 1]); tp[8 + q] = cvt_pk_bf16(oc1[2 * q], oc1[2 * q + 1]); }
            __builtin_amdgcn_sched_barrier(0);
            float own[16], oth[16], pl[16];
#pragma unroll
            for (int cgi = 0; cgi < 16; ++cgi) pl[cgi] = __shfl_xor(sc[cgi >> 2][4 * (cgi & 3) + 3], 32);
#pragma unroll
            for (int cgi = 0; cgi < 16; ++cgi) { const int c = cgi >> 2, q4 = 4 * (cgi & 3); float v = (sc[c][q4] + sc[c][q4 + 1]) + (sc[c][q4 + 2] + sc[c][q4 + 3]);
                const float prevh0 = cgi > 0 ? pl[cgi > 0 ? cgi - 1 : 0] : 0.f; v += h ? pl[cgi] : prevh0;
                v += __shfl_xor(v, 1); v += __shfl_xor(v, 2); own[cgi] = v; }
#pragma unroll
            for (int cgi = 0; cgi < 16; ++cgi) oth[cgi] = __shfl_xor(own[cgi], 32);
            __builtin_amdgcn_sched_barrier(0);
            float cand[32];
#pragma unroll
            for (int cgi = 0; cgi < 16; ++cgi) { const float ve = h ? oth[cgi] : own[cgi], vo = h ? own[cgi] : oth[cgi];
                cand[2 * cgi] = (2 * cgi >= 1 && 2 * cgi <= cur - 2) ? ve : -2.f; cand[2 * cgi + 1] = (2 * cgi + 1 <= cur - 2) ? vo : -2.f; }
            float prev = 3.0e38f;
#pragma unroll 1
            for (int round = 0; round < 5; ++round) { float best = -1.f;
#pragma unroll
                for (int j = 0; j < 32; ++j) { const float v = cand[j] < prev ? cand[j] : -2.f; best = fmaxf(best, v); }
                prev = best; }
            const float thr = fmaxf(prev, 0.f);
            sel = 1u | (1u << cur) | (cur > 0 ? (1u << (cur - 1)) : 0u);
#pragma unroll
            for (int j = 1; j < 32; ++j) sel |= (cand[j] >= thr) ? (1u << j) : 0u;
        }
        {
            unsigned um = sel; um |= __shfl_xor(um, 4); um |= __shfl_xor(um, 8); um |= __shfl_xor(um, 16); um = __builtin_amdgcn_readfirstlane(um);
            const char* Kl = (const char*)ws + OFF_BRA + 2 * 32 * MiB + (size_t)bg * 2048 * 128 + lane * 16;
            const char* Vl = (const char*)ws + OFF_BRA + 3 * 32 * MiB + (size_t)bg * 2048 * 128 + lane * 16;
            SoftState st; soft_init(st);
            KFrag A, B; int half = 0, kb = 64 * __builtin_ctz(um), kbn = 0; bool has;
            load_k(A, Kl + (size_t)kb * 128);
#pragma unroll 1
            for (;;) {
                if (half) um &= um - 1; half ^= 1; has = um != 0u; if (has) { kbn = 64 * __builtin_ctz(um) + 32 * half; load_k(B, Kl + (size_t)kbn * 128); }
                { const int jb = kb >> 6, dist0 = s - kb - 4 * h; const unsigned vb = ((sel >> jb) & 1u) ? tb_head + (unsigned)(4 * (dist0 - 27)) : (unsigned)ATT_NEG;
                  tile_compute(st, qf, A, Vl + (size_t)kb * 128, lds, vb, dist0, 1 << 20, jb >= cur); }
                if (!has) break; kb = kbn; A = B;
            }
            const float lt = st.l + __shfl_xor(st.l, 32), sc = g_sel / fmaxf(lt, 1e-30f);
#pragma unroll
            for (int q = 0; q < 8; ++q) { tp[q] = cvt_pk_bf16(__uint_as_float(tp[q] << 16) + st.o0[2 * q] * sc, __uint_as_float(tp[q] & 0xffff0000u) + st.o0[2 * q + 1] * sc);
                tp[8 + q] = cvt_pk_bf16(__uint_as_float(tp[8 + q] << 16) + st.o1[2 * q] * sc, __uint_as_float(tp[8 + q] & 0xffff0000u) + st.o1[2 * q + 1] * sc); }
        }
        {
            const char* Kl = (const char*)ws + OFF_BRA + 4 * 32 * MiB + (size_t)bg * 2048 * 128 + lane * 16;
            const char* Vl = (const char*)ws + OFF_BRA + 5 * 32 * MiB + (size_t)bg * 2048 * 128 + lane * 16;
            SoftState st; soft_init(st);
            const int lo = s0 - 255, kt_lo = lo < 0 ? 0 : (lo >> 5), kt_hi = (s0 + 7) >> 5;
            run_range(st, qf, Kl, Vl, kt_lo, kt_hi, s, s0, s0 + 7, 255, tb_head, lds, h);
            const float lt = st.l + __shfl_xor(st.l, 32), sc = g_win / fmaxf(lt, 1e-30f);
#pragma unroll
            for (int q = 0; q < 8; ++q) { tp[q] = cvt_pk_bf16(__uint_as_float(tp[q] << 16) + st.o0[2 * q] * sc, __uint_as_float(tp[q] & 0xffff0000u) + st.o0[2 * q + 1] * sc);
                tp[8 + q] = cvt_pk_bf16(__uint_as_float(tp[8 + q] << 16) + st.o1[2 * q] * sc, __uint_as_float(tp[8 + q] & 0xffff0000u) + st.o1[2 * q + 1] * sc); }
        }
        { unsigned char* op = ws + OFF_O + (tok * 1024 + head * 64 + 4 * h) * 2;
#pragma unroll
          for (int q = 0; q < 4; ++q) { u32x2 w; w.x = tp[2 * q]; w.y = tp[2 * q + 1]; *(u32x2*)(op + 16 * q) = w; u32x2 w2; w2.x = tp[8 + 2 * q]; w2.y = tp[8 + 2 * q + 1]; *(u32x2*)(op + 64 + 16 * q) = w2; } }
    }
}

__device__ __forceinline__ void phaseB_attn(unsigned char* ws, LAS unsigned char* lds, int gw, int NGW) {
    const int lane = threadIdx.x & 63;
    const int r = lane & 31, h = lane >> 5, tk = r >> 2, rr = r & 3;
    const LAS unsigned char* lut = lds + LDS_LUT; const LAS float* bias2 = (const LAS float*)(lds + LDS_BIAS);
    { LAS float* tab = (LAS float*)(lds + ATT_TAB);
      for (int i = threadIdx.x; i < 3 * 16 * ATT_HS_B; i += 512) { const int gh = i / ATT_HS_B, d = i - gh * ATT_HS_B, gi = gh >> 4, hd = gh & 15; int td = d << (2 * gi); td = td > 2047 ? 2047 : td;
          tab[i] = bias2[(int)lut[td] * 16 + hd]; }
      if (threadIdx.x < 256) ((LAS float*)lds)[threadIdx.x] = 0.f;
      __syncthreads(); }
    for (int item = gw; item < 32768; item += NGW) {
        const int bg = item >> 8, cc = (item >> 4) & 15, r16 = item & 15, b = bg >> 2, g = bg & 3, s0 = cc * 128 + r16, s = s0 + 16 * tk, head = g * 4 + rr;
        const size_t tok = (size_t)b * 2048 + s;
        SoftState st; soft_init(st);
#pragma unroll 1
        for (int gi = 0; gi < 3; ++gi) {
            const int dsh = 2 * gi, lsh = 11 - dsh, res = s0 & ((1 << dsh) - 1);
            bf16x8 qf[4];
            { const char* qp = (const char*)ws + OFF_QB + (tok * 3072 + gi * 1024 + head * 64 + 8 * h) * 2;
#pragma unroll
              for (int ks = 0; ks < 4; ++ks) qf[ks] = *(const bf16x8*)(qp + 32 * ks); }
            const char* Kl = (const char*)ws + OFF_KVB + (size_t)(gi * 2) * 32 * MiB + ((size_t)bg * 2048 + ((size_t)res << lsh)) * 128 + lane * 16;
            const char* Vl = (const char*)ws + OFF_KVB + (size_t)(gi * 2 + 1) * 32 * MiB + ((size_t)bg * 2048 + ((size_t)res << lsh)) * 128 + lane * 16;
            const int ql = s >> dsh, qmin = s0 >> dsh, qmax = (s0 + 112) >> dsh, ql_lo = qmin - 128, kt_lo = ql_lo < 0 ? 0 : (ql_lo >> 5), kt_hi = qmax >> 5;
            const unsigned tb_head = (unsigned)(ATT_TAB + (gi * 16 + head) * ATT_HS_B * 4);
            run_range(st, qf, Kl, Vl, kt_lo, kt_hi, ql, qmin, qmax, 128, tb_head, lds, h);
        }
        const float lt = st.l + __shfl_xor(st.l, 32), sc = 1.f / fmaxf(lt, 1e-30f);
        const f32x16 tot0 = st.o0 * sc, tot1 = st.o1 * sc;
        { unsigned char* op = ws + OFF_O + (tok * 1024 + head * 64 + 4 * h) * 2;
#pragma unroll
          for (int q = 0; q < 4; ++q) { u32x2 w; w.x = cvt_pk_bf16(tot0[4 * q], tot0[4 * q + 1]); w.y = cvt_pk_bf16(tot0[4 * q + 2], tot0[4 * q + 3]); *(u32x2*)(op + 16 * q) = w;
              u32x2 w2; w2.x = cvt_pk_bf16(tot1[4 * q], tot1[4 * q + 1]); w2.y = cvt_pk_bf16(tot1[4 * q + 2], tot1[4 * q + 3]); *(u32x2*)(op + 64 + 16 * q) = w2; } }
    }
}

__device__ __forceinline__ void phase_cmp2(unsigned char* ws, int gw, int NGW) {
    const int lane = threadIdx.x & 63;
    const int r = lane & 31, h = lane >> 5;
    for (int item = gw; item < 1024; item += NGW) {
        const int kv = item >> 9, rt = item & 511;
        const char* ap = (const char*)ws + OFF_G1 + (((size_t)kv * 16384 + rt * 32 + r) * 256 + 8 * h) * 2;
        const char* bp = (const char*)ws + OFF_W2 + (size_t)kv * 32768 + ((size_t)r * 256 + 8 * h) * 2;
        f32x16 a0 = {0.f, 0.f, 0.f, 0.f, 0.f, 0.f, 0.f, 0.f, 0.f, 0.f, 0.f, 0.f, 0.f, 0.f, 0.f, 0.f}, a1 = a0;
#pragma unroll
        for (int ks = 0; ks < 16; ++ks) { const bf16x8 a = *(const bf16x8*)(ap + 32 * ks);
            a0 = mfma32(a, *(const bf16x8*)(bp + 32 * ks), a0); a1 = mfma32(a, *(const bf16x8*)(bp + 32 * 256 * 2 + 32 * ks), a1); }
#pragma unroll
        for (int i = 0; i < 16; ++i) { const int row = rt * 32 + (i & 3) + 8 * (i >> 2) + 4 * h, gq = row & 3, n = (row >> 2) & 127, b = row >> 9, bgi = b * 4 + gq;
            if (kv == 0) { bf16_t* o = (bf16_t*)(ws + OFF_KCMP) + ((size_t)bgi * 128 + n) * 64; o[r] = f2bf(a0[i]); o[r + 32] = f2bf(a1[i]); }
            else { bf16_t* o = (bf16_t*)(ws + OFF_VCMPT) + (size_t)bgi * 64 * 128 + n; o[(size_t)r * 128] = f2bf(a0[i]); o[(size_t)(r + 32) * 128] = f2bf(a1[i]); } }
    }
}

__global__ __launch_bounds__(512, 2) void yoco_mega(Params p) {
    extern __shared__ __attribute__((aligned(16))) unsigned char shm[];
    cg::grid_group grid = cg::this_grid();
    LAS unsigned char* lds = (LAS unsigned char*)shm;
    const int tid = threadIdx.x, lane = tid & 63, wave = __builtin_amdgcn_readfirstlane(tid >> 6), gw = blockIdx.x * 8 + wave, NGW = gridDim.x * 8;
    unsigned char* ws = p.ws;
    const float* x_in = p.in[0];
    float* X = p.out;
    { LAS unsigned char* lut = lds + LDS_LUT; LAS float* bias2 = (LAS float*)(lds + LDS_BIAS);
      for (int d = tid; d < 2048; d += 512) { int bk = d; if (d >= 16) bk = 16 + (d >= 22) + (d >= 30) + (d >= 40) + (d >= 54) + (d >= 73) + (d >= 99) + (d >= 134) + (d >= 182) + (d >= 246) + (d >= 332) + (d >= 450) + (d >= 609) + (d >= 825) + (d >= 1117) + (d >= 1513); lut[d] = (unsigned char)bk; }
      bias2[tid] = p.in[1][tid] * LOG2E;
      __syncthreads(); }
    {
        LAS float* scr = (LAS float*)(lds + wave * 8448);
        const float* nm = p.in[2]; const float* nf = p.in[3];
        conv_weight(p.in[4], 1024, 2608, nm, (bf16_t*)(ws + OFF_WIN), 0, 0, scr, gw, NGW, lane);
        conv_weight(p.in[7], 2048, 256, nullptr, (bf16_t*)(ws + OFF_W1), 0, 0, scr, gw, NGW, lane);
        conv_weight(p.in[10], 2048, 256, nullptr, (bf16_t*)(ws + OFF_W1), 256, 0, scr, gw, NGW, lane);
        conv_weight(p.in[8], 256, 64, nullptr, (bf16_t*)(ws + OFF_W2), 0, 0, scr, gw, NGW, lane);
        conv_weight(p.in[11], 256, 64, nullptr, (bf16_t*)(ws + OFF_W2), 64, 0, scr, gw, NGW, lane);
        conv_weight(p.in[12], 1024, 1024, nullptr, (bf16_t*)(ws + OFF_WOUTA), 0, 0, scr, gw, NGW, lane);
        conv_weight(p.in[15], 1024, 3072, nm + 1024, (bf16_t*)(ws + OFF_WQKVB), 0, 0, scr, gw, NGW, lane);
        conv_weight(p.in[14], 1024, 1536, p.in[13], (bf16_t*)(ws + OFF_WQKVB), 3072, 0, scr, gw, NGW, lane);
        conv_weight(p.in[16], 1024, 1024, nullptr, (bf16_t*)(ws + OFF_WOUTB), 0, 0, scr, gw, NGW, lane);
        conv_weight(p.in[17], 1024, 5632, nf, (bf16_t*)(ws + OFF_WUP0), 0, 1, scr, gw, NGW, lane);
        conv_weight(p.in[17] + (size_t)1024 * 5632, 1024, 5632, nf + 1024, (bf16_t*)(ws + OFF_WUP1), 0, 1, scr, gw, NGW, lane);
        conv_weight(p.in[18], 2816, 1024, nullptr, (bf16_t*)(ws + OFF_WDN0), 0, 0, scr, gw, NGW, lane);
        conv_weight(p.in[18] + (size_t)2816 * 1024, 2816, 1024, nullptr, (bf16_t*)(ws + OFF_WDN1), 0, 0, scr, gw, NGW, lane);
        for (int item = gw; item < 512; item += NGW) { const int kv = item >> 8, ksl = (item >> 2) & 63, c = (item & 3) * 64 + lane;
            const float* pe = kv ? p.in[9] : p.in[6]; const float* w1 = kv ? p.in[10] : p.in[7]; float a = 0.f;
#pragma unroll 8
            for (int kk = ksl * 32; kk < ksl * 32 + 32; ++kk) a += pe[kk] * w1[(size_t)kk * 256 + c];
            ((float*)(ws + OFF_BIASP))[(kv * 64 + ksl) * 256 + c] = a; }
        cast_rows(x_in, (bf16_t*)(ws + OFF_H), (float*)(ws + OFF_SSQ), gw, NGW, lane);
    }
    grid.sync();
    pg8::StaticOrder S;
    float* const SSQ = (float*)(ws + OFF_SSQ);
    { pg8::Gemm g{(const char*)ws + OFF_H, (const char*)ws + OFF_WIN, 1024, 1024, 0, 0};
      { S.init(256, 9, gridDim.x, blockIdx.x, 1); EpiWin E{ws, p.in[5], SSQ}; pg8::gemm_phase<false>(lds, g, S, E); }
      { S.init(256, 2, gridDim.x, blockIdx.x, 2); EpiV<0> E{ws, SSQ}; pg8::gemm_phase<true>(lds, g, S, E); }
      if (gw < 8) { const int o = gw * 64 + lane; const float* pp = (const float*)(ws + OFF_BIASP) + (o >> 8) * 64 * 256 + (o & 255); float a = 0.f;
#pragma unroll 8
          for (int q = 0; q < 64; ++q) a += pp[q * 256];
          ((float*)(ws + OFF_BIAS1))[o] = a; } }
    grid.sync();
    { pg8::Gemm g{(const char*)ws + OFF_BRA, (const char*)ws + OFF_W1, 2048, 0, 1, 32 * MiB}; S.init(64, 2, gridDim.x, blockIdx.x); EpiCmp1 E{ws}; pg8::gemm_phase<false>(lds, g, S, E); }
    grid.sync();
    phase_cmp2(ws, gw, NGW);
    grid.sync();
    phaseA_attn(ws, lds, gw, NGW);
    grid.sync();
    { pg8::Gemm g{(const char*)ws + OFF_O, (const char*)ws + OFF_WOUTA, 1024, 1024, 0, 0}; S.init(256, 4, gridDim.x, blockIdx.x); EpiResid<true> E{x_in, X, ws + OFF_H, SSQ + 16 * T_TOK}; pg8::gemm_phase<false>(lds, g, S, E); }
    grid.sync();
    { pg8::Gemm g{(const char*)ws + OFF_H, (const char*)ws + OFF_WUP0, 1024, 1024, 0, 0}; S.init(256, 22, gridDim.x, blockIdx.x); EpiSwiglu E{ws + OFF_ACT, SSQ + 16 * T_TOK}; pg8::gemm_phase<false>(lds, g, S, E); }
    grid.sync();
    { pg8::Gemm g{(const char*)ws + OFF_ACT, (const char*)ws + OFF_WDN0, 2816, 2816, 0, 0}; S.init(256, 4, gridDim.x, blockIdx.x); EpiResid<true> E{X, X, ws + OFF_H, SSQ + 32 * T_TOK}; pg8::gemm_phase<false>(lds, g, S, E); }
    grid.sync();
    { pg8::Gemm g{(const char*)ws + OFF_H, (const char*)ws + OFF_WQKVB, 1024, 1024, 0, 0};
      { S.init(256, 15, gridDim.x, blockIdx.x, 3); EpiQKVB E{ws, SSQ + 32 * T_TOK}; pg8::gemm_phase<false>(lds, g, S, E); }
      { S.init(256, 3, gridDim.x, blockIdx.x, 4); EpiV<1> E{ws, SSQ + 32 * T_TOK}; pg8::gemm_phase<true>(lds, g, S, E); } }
    grid.sync();
    phaseB_attn(ws, lds, gw, NGW);
    grid.sync();
    { pg8::Gemm g{(const char*)ws + OFF_O, (const char*)ws + OFF_WOUTB, 1024, 1024, 0, 0}; S.init(256, 4, gridDim.x, blockIdx.x); EpiResid<true> E{X, X, ws + OFF_H, SSQ + 48 * T_TOK}; pg8::gemm_phase<false>(lds, g, S, E); }
    grid.sync();
    { pg8::Gemm g{(const char*)ws + OFF_H, (const char*)ws + OFF_WUP1, 1024, 1024, 0, 0}; S.init(256, 22, gridDim.x, blockIdx.x); EpiSwiglu E{ws + OFF_ACT, SSQ + 48 * T_TOK}; pg8::gemm_phase<false>(lds, g, S, E); }
    grid.sync();
    { pg8::Gemm g{(const char*)ws + OFF_ACT, (const char*)ws + OFF_WDN1, 2816, 2816, 0, 0}; S.init(256, 4, gridDim.x, blockIdx.x); EpiResid<false> E{X, X, ws + OFF_H, SSQ}; pg8::gemm_phase<false>(lds, g, S, E); }
    grid.sync();
    final_norm_rows(X, p.in[19], gw, NGW);
}

extern "C" void kernel_launch(void* const* d_in, const int* in_sizes, int n_in, void* d_out, int out_size, void* d_ws, size_t ws_size, hipStream_t stream) {
    static int grid_blocks = 0;
    if (grid_blocks == 0) {
        if (n_in != 20 || out_size != T_TOK * DM || ws_size < WS_NEED) { fprintf(stderr, "kernel_launch: unexpected shapes (n_in %d out %d ws %zu)\n", n_in, out_size, ws_size); grid_blocks = -1; return; }
        int dev = 0, cus = 0, per_cu = 0;
        hipGetDevice(&dev); hipDeviceGetAttribute(&cus, hipDeviceAttributeMultiprocessorCount, dev);
        if (hipFuncSetAttribute((const void*)yoco_mega, hipFuncAttributeMaxDynamicSharedMemorySize, LDS_TOTAL) != hipSuccess) { fprintf(stderr, "kernel_launch: hipFuncSetAttribute failed\n"); grid_blocks = -1; return; }
        if (hipOccupancyMaxActiveBlocksPerMultiprocessor(&per_cu, (const void*)yoco_mega, 512, LDS_TOTAL) != hipSuccess || per_cu < 1) { fprintf(stderr, "kernel_launch: occupancy query gave %d\n", per_cu); per_cu = 1; }
        (void)hipGetLastError();
        grid_blocks = cus * 1;
    }
    if (grid_blocks < 0) return;
    Params p{};
    for (int i = 0; i < 20; ++i) p.in[i] = (const float*)d_in[i];
    p.out = (float*)d_out; p.ws = (unsigned char*)d_ws;
    void* args[] = {&p};
    hipError_t e = hipLaunchCooperativeKernel((const void*)yoco_mega, dim3(grid_blocks), dim3(512), args, LDS_TOTAL, stream);
    if (e != hipSuccess) fprintf(stderr, "cooperative launch failed: %s (grid %d)\n", hipGetErrorString(e), grid_blocks);
}
```

```cpp
#include <hip/hip_runtime.h>
#include <hip/hip_cooperative_groups.h>
#include <cstdio>
namespace cg = cooperative_groups;

#define LAS __attribute__((address_space(3)))
typedef unsigned short bf16_t;
typedef short bf16x8 __attribute__((ext_vector_type(8)));
typedef float f32x4 __attribute__((ext_vector_type(4)));
typedef float f32x16 __attribute__((ext_vector_type(16)));
typedef unsigned u32x4 __attribute__((ext_vector_type(4)));
typedef unsigned u32x2 __attribute__((ext_vector_type(2)));
typedef unsigned long long u64;

constexpr int T_TOK = 65536, DM = 1024, SEQ = 2048, FFH = 2816;
constexpr size_t MiB = 1ull << 20;
constexpr size_t OFF_WIN = 0, OFF_WOUTA = 6 * MiB, OFF_WUP0 = 8 * MiB, OFF_WUP1 = 19 * MiB, OFF_WDN0 = 30 * MiB, OFF_WDN1 = 36 * MiB,
                 OFF_WQKVB = 42 * MiB, OFF_WOUTB = 51 * MiB, OFF_W1 = 53 * MiB  , OFF_W2 = 55 * MiB  ,
                 OFF_BIASP = 55 * MiB + 128 * 1024  , OFF_BIAS1 = 55 * MiB + 512 * 1024  , OFF_KCMP = 56 * MiB, OFF_VCMPT = 58 * MiB, OFF_GATE = 60 * MiB,
                 OFF_SSQ = 330 * MiB + 600 * MiB  , OFF_H = 74 * MiB,
                 OFF_O = 202 * MiB, OFF_BIG = 330 * MiB, WS_NEED = 1024 * MiB;
constexpr size_t OFF_QA = OFF_BIG, OFF_BRA = OFF_BIG + 128 * MiB  , OFF_ACT = OFF_BIG,
                 OFF_QB = OFF_BIG, OFF_KVB = OFF_BIG + 384 * MiB  , OFF_G1 = OFF_O;
constexpr int LDS_STAGE = 131072, LDS_NEG = 132608  , LDS_LUT = 133120, LDS_BIAS = LDS_LUT + 2048, LDS_TOTAL = LDS_BIAS + 2048;
constexpr float LOG2E = 1.4426950408889634f;
constexpr float SC2 = 0.125f * LOG2E;

struct Params { const float* in[20]; float* out; unsigned char* ws; };

__device__ __forceinline__ unsigned cvt_pk_bf16(float lo, float hi) { unsigned r; asm volatile("v_cvt_pk_bf16_f32 %0, %1, %2" : "=v"(r) : "v"(lo), "v"(hi)); return r; }
__device__ __forceinline__ bf16_t f2bf(float f) { return (bf16_t)(cvt_pk_bf16(f, 0.f) & 0xffffu); }
__device__ __forceinline__ u32x4 pack8(f32x4 a, f32x4 b) { u32x4 o; o.x = cvt_pk_bf16(a[0], a[1]); o.y = cvt_pk_bf16(a[2], a[3]); o.z = cvt_pk_bf16(b[0], b[1]); o.w = cvt_pk_bf16(b[2], b[3]); return o; }
__device__ __forceinline__ float fexp2(float x) { return __builtin_amdgcn_exp2f(x); }
__device__ __forceinline__ float frcp(float x) { return __builtin_amdgcn_rcpf(x); }
__device__ __forceinline__ float sigmoidf_(float x) { return frcp(1.f + fexp2(-x * LOG2E)); }
__device__ __forceinline__ float wave_sum(float v) {
#pragma unroll
    for (int o = 1; o < 64; o <<= 1) v += __shfl_xor(v, o);
    return v;
}
__device__ __forceinline__ f32x16 mfma32(bf16x8 a, bf16x8 b, f32x16 c) { return __builtin_amdgcn_mfma_f32_32x32x16_bf16(a, b, c, 0, 0, 0); }
#define LDS_WAIT() asm volatile("s_waitcnt lgkmcnt(0)" ::: "memory")

namespace pg8 {
constexpr int BM = 256, BK = 64, HALF = 128, HTB = HALF * BK * 2, NXCD = 8, WGM = 8;
__device__ __forceinline__ int lds_byte(int r, int c) { const int st = (r >> 4) * 2 + (c >> 5), rr = r & 15, cc = c & 31, ob = rr * 64 + cc * 2; return st * 1024 + (ob ^ (((ob >> 9) & 1) << 5)); }
__device__ __forceinline__ void stage_rc(int b, int& R, int& C) { const int st = b / 1024, sb = b % 1024, swz = sb ^ (((sb >> 9) & 1) << 5); R = (st >> 1) * 16 + swz / 64; C = (st & 1) * 32 + (swz % 64) / 2; }
__device__ __forceinline__ int perm32(int rho) { const int n = rho >> 4, i = rho & 15; return 8 * (i >> 2) + 4 * n + (i & 3); }
struct Unit { int pm, pn; };
struct Gemm { const char* A; const char* Bt; int K; int lda; int amode; size_t a_pn_step; };
struct StaticOrder {
    int nM, nN, nwg, G, c, map;
    __device__ void init(int nM_, int nN_, int G_, int c_, int map_ = 0) { nM = nM_; nN = nN_; nwg = nM * nN; G = G_; c = c_; map = map_; }
    __device__ bool next(int i, Unit& u) const {
        const long L = (long)i * G + c; if (L >= nwg) return false;
        int wgid = (int)L; { const int q = nwg / NXCD, r = nwg % NXCD, xcd = wgid % NXCD, off = wgid / NXCD; wgid = (xcd < r ? xcd * (q + 1) : r * (q + 1) + (xcd - r) * q) + off; }
        const int nig = WGM * nN, gid = wgid / nig, fm = gid * WGM, gsz = (nM - fm) < WGM ? (nM - fm) : WGM;
        u.pm = fm + ((wgid % nig) % gsz); int pn = (wgid % nig) / gsz;
        if (map == 1) pn = pn < 7 ? pn : (pn == 7 ? 8 : 10); else if (map == 2) pn = 7 + 2 * pn; else if (map == 3) pn = pn < 12 ? pn : 12 + 2 * (pn - 12); else if (map == 4) pn = 13 + 2 * pn;
        u.pn = pn; return true;
    }
};

template <bool SWAP = false, class Epi>
__device__ __forceinline__ void gemm_phase(LAS unsigned char* lds, const Gemm g, const StaticOrder& S, const Epi& E) {
    int tid = threadIdx.x; asm volatile("" : "+v"(tid));
    const int wid = __builtin_amdgcn_readfirstlane(tid >> 6), lane = tid & 63, wr = wid >> 2, wc = wid & 3, fr = lane & 15, fq = lane >> 4;
    const int K = g.K, nt = K / BK;
    unsigned voffA[2], voffB[2];
#pragma unroll
    for (int i = 0; i < 2; ++i) { int R, C; stage_rc(tid * 16 + i * 8192, R, C); const int Rb = SWAP ? R : (R & ~31) + perm32(R & 31);
        voffA[i] = g.amode ? (unsigned)((R >> 2) * 8192 + (R & 3) * 128 + C * 2) : (unsigned)(R * g.lda + C) * 2u;
        voffB[i] = (unsigned)(Rb * K + C) * 2u; }
    const size_t kstepA = g.amode ? 512 : (size_t)(BK * 2), kstepB = (size_t)(BK * 2);
    const size_t hstepA = g.amode ? (size_t)262144 : (size_t)HALF * g.lda * 2, hstepB = (size_t)HALF * K * 2;
    const size_t tstepA = 2 * hstepA, tstepB = 2 * hstepB;
    const unsigned ldsw = (unsigned)wid * 1024u;
    const int aoff = lds_byte(wr * 64 + fr, fq * 8), boff = lds_byte(wc * 32 + fr, fq * 8);
#define PG8_SA(b, h) (((b) * 2 + (h)) * HTB)
#define PG8_SB(b, h) ((4 + (b) * 2 + (h)) * HTB)
#define PG8_STAGE(bufoff, gbase, voff) do { _Pragma("unroll") for (int _i = 0; _i < 2; ++_i) \
        __builtin_amdgcn_global_load_lds((const unsigned*)((const char*)(gbase) + (voff)[_i]), (LAS unsigned*)(lds + (bufoff) + ldsw + _i * 8192), 16, 0, 0); } while (0)
#define PG8_LDA(dst, b, h) do { _Pragma("unroll") for (int m = 0; m < 4; ++m) _Pragma("unroll") for (int k = 0; k < 2; ++k) dst[m][k] = *(const LAS bf16x8*)(lds + PG8_SA(b, h) + aoff + m * 2048 + k * 1024); } while (0)
#define PG8_LDB(dst, b, h) do { _Pragma("unroll") for (int n = 0; n < 2; ++n) _Pragma("unroll") for (int k = 0; k < 2; ++k) dst[n][k] = *(const LAS bf16x8*)(lds + PG8_SB(b, h) + boff + n * 2048 + k * 1024); } while (0)
#define PG8_MMA(ai, bj, At, Bt) do { __builtin_amdgcn_s_setprio(1); _Pragma("unroll") for (int m = 0; m < 4; ++m) _Pragma("unroll") for (int n = 0; n < 2; ++n) _Pragma("unroll") for (int k = 0; k < 2; ++k) \
        acc[ai][bj][m][n] = SWAP ? __builtin_amdgcn_mfma_f32_16x16x32_bf16(At[m][k], Bt[n][k], acc[ai][bj][m][n], 0, 0, 0) : __builtin_amdgcn_mfma_f32_16x16x32_bf16(Bt[n][k], At[m][k], acc[ai][bj][m][n], 0, 0, 0); __builtin_amdgcn_s_setprio(0); } while (0)
#define PG8_WAIT_V(n) asm volatile("s_waitcnt vmcnt(" #n ")" ::: "memory")
#define PG8_WAIT_L(n) asm volatile("s_waitcnt lgkmcnt(" #n ")" ::: "memory")
#define PG8_BAR __builtin_amdgcn_s_barrier()
#define PG8_SCHED __builtin_amdgcn_sched_barrier(0)
    Unit cur, nxt; int ui = 0;
    if (!S.next(0, cur)) return;
    f32x4 acc[2][2][4][2];
#pragma unroll
    for (int a = 0; a < 2; ++a)
#pragma unroll
        for (int b = 0; b < 2; ++b)
#pragma unroll
            for (int m = 0; m < 4; ++m)
#pragma unroll
                for (int n = 0; n < 2; ++n) acc[a][b][m][n] = (f32x4){0.f, 0.f, 0.f, 0.f};
    bf16x8 At[4][2], B0[2][2], B1[2][2];
    const char* cA = g.A + (size_t)cur.pm * tstepA + (size_t)cur.pn * g.a_pn_step; const char* cB = g.Bt + (size_t)cur.pn * tstepB;
    PG8_STAGE(PG8_SB(0, 0), cB, voffB); PG8_STAGE(PG8_SA(0, 0), cA, voffA); PG8_STAGE(PG8_SB(0, 1), cB + hstepB, voffB); PG8_STAGE(PG8_SA(0, 1), cA + hstepA, voffA);
    if (wr == 1) PG8_BAR;
    PG8_WAIT_V(4); PG8_BAR;
    PG8_STAGE(PG8_SB(1, 0), cB + kstepB, voffB); PG8_STAGE(PG8_SA(1, 0), cA + kstepA, voffA); PG8_STAGE(PG8_SB(1, 1), cB + hstepB + kstepB, voffB);
    PG8_WAIT_V(6); PG8_BAR;
    for (;;) {
        const bool has_next = S.next(ui + 1, nxt);
        const char* nA = has_next ? g.A + (size_t)nxt.pm * tstepA + (size_t)nxt.pn * g.a_pn_step : cA; const char* nB = has_next ? g.Bt + (size_t)nxt.pn * tstepB : cB;
        for (int t = 0; t < nt; t += 2) {
            const bool last = (t == nt - 2);
            const char* a1 = cA + (size_t)(t + 1) * kstepA;
            const char* a2 = last ? nA : cA + (size_t)(t + 2) * kstepA; const char* b2 = last ? nB : cB + (size_t)(t + 2) * kstepB;
            const char* a3 = a2 + kstepA; const char* b3 = b2 + kstepB;
            PG8_LDB(B0, 0, 0); PG8_SCHED; PG8_LDA(At, 0, 0); PG8_STAGE(PG8_SA(1, 1), a1 + hstepA, voffA);
            PG8_WAIT_L(8); PG8_BAR; PG8_WAIT_L(0); PG8_MMA(0, 0, At, B0); PG8_BAR; PG8_SCHED;
            PG8_LDB(B1, 0, 1); PG8_STAGE(PG8_SB(0, 0), b2, voffB);
            PG8_BAR; PG8_WAIT_L(0); PG8_MMA(0, 1, At, B1); PG8_BAR;
            PG8_LDA(At, 0, 1); PG8_STAGE(PG8_SA(0, 0), a2, voffA);
            PG8_BAR; PG8_WAIT_L(0); PG8_MMA(1, 0, At, B0); PG8_BAR; PG8_SCHED;
            PG8_STAGE(PG8_SB(0, 1), b2 + hstepB, voffB);
            PG8_WAIT_V(6); PG8_BAR; PG8_MMA(1, 1, At, B1); PG8_BAR;
            PG8_LDB(B0, 1, 0); PG8_SCHED; PG8_LDA(At, 1, 0); PG8_STAGE(PG8_SA(0, 1), a2 + hstepA, voffA);
            PG8_WAIT_L(8); PG8_BAR; PG8_WAIT_L(0); PG8_MMA(0, 0, At, B0); PG8_BAR; PG8_SCHED;
            PG8_LDB(B1, 1, 1); PG8_STAGE(PG8_SB(1, 0), b3, voffB);
            PG8_BAR; PG8_WAIT_L(0); PG8_MMA(0, 1, At, B1); PG8_BAR;
            PG8_LDA(At, 1, 1); PG8_STAGE(PG8_SA(1, 0), a3, voffA);
            PG8_BAR; PG8_WAIT_L(0); PG8_MMA(1, 0, At, B0); PG8_BAR; PG8_SCHED;
            PG8_STAGE(PG8_SB(1, 1), b3 + hstepB, voffB);
            PG8_WAIT_V(6); PG8_BAR; PG8_MMA(1, 1, At, B1); PG8_BAR;
        }
        E(acc, cur, wr, wc, fr, fq);
        if (!has_next) break;
#pragma unroll
        for (int a = 0; a < 2; ++a)
#pragma unroll
            for (int b = 0; b < 2; ++b)
#pragma unroll
                for (int m = 0; m < 4; ++m)
#pragma unroll
                    for (int n = 0; n < 2; ++n) acc[a][b][m][n] = (f32x4){0.f, 0.f, 0.f, 0.f};
        cur = nxt; cA = nA; cB = nB; ++ui;
    }
    PG8_WAIT_V(0);
    if (wr == 0) PG8_BAR;
    PG8_BAR;
#undef PG8_SA
#undef PG8_SB
#undef PG8_STAGE
#undef PG8_LDA
#undef PG8_LDB
#undef PG8_MMA
#undef PG8_WAIT_V
#undef PG8_WAIT_L
#undef PG8_BAR
#undef PG8_SCHED
}
}
using pg8::Unit;
typedef f32x4 Acc[2][2][4][2];

#define OPAQUE(v) asm volatile("" : "+v"(v))
__device__ __forceinline__ void load_row_rs(float (&rv)[2], const unsigned char* sp, int wr, int fr, int fq);
__device__ __forceinline__ float row_rs(float ssq) { return 1.f / sqrtf(ssq * (1.f / DM) + 1e-6f); }
__device__ __forceinline__ float row_rs16(const unsigned char* p) { const f32x4 a = *(const f32x4*)p, b = *(const f32x4*)(p + 16), c = *(const f32x4*)(p + 32), d = *(const f32x4*)(p + 48);
    return row_rs(((a[0] + a[1]) + (a[2] + a[3])) + ((b[0] + b[1]) + (b[2] + b[3])) + ((c[0] + c[1]) + (c[2] + c[3])) + ((d[0] + d[1]) + (d[2] + d[3]))); }
__device__ __forceinline__ void load_row_rs(float (&rv)[2], const unsigned char* sp, int wr, int fr, int fq) {
    unsigned so = (unsigned)(wr * 64 + fq * 16 + fr) * 64u; OPAQUE(so);
    rv[0] = row_rs16(sp + so); rv[1] = row_rs16(sp + (so + 128u * 64u));
}
struct EpiWin {
    unsigned char* ws; const float* b_gate; const float* ssq;
    __device__ __forceinline__ void operator()(const Acc& acc, const Unit& u, int wr, int wc, int fr, int fq) const {
        const int pn = u.pn; unsigned rl = wr * 64 + fr, cw = wc * 32 + 8 * fq; OPAQUE(rl); OPAQUE(cw); const size_t rowt = (size_t)u.pm * 256;
        float rs[2][4]; { float rv[2]; load_row_rs(rv, (const unsigned char*)(ssq + rowt * 16), wr, fr, fq);
#pragma unroll
            for (int ai = 0; ai < 2; ++ai)
#pragma unroll
                for (int m = 0; m < 4; ++m) rs[ai][m] = __shfl(rv[ai], m * 16 + fr); }
        if (pn < 4) {
            unsigned char* base = ws + OFF_QA + (rowt * 1024 + pn * 256) * 2; unsigned lo = (rl * 1024 + cw) * 2; OPAQUE(lo);
#pragma unroll
            for (int ai = 0; ai < 2; ++ai)
#pragma unroll
                for (int m = 0; m < 4; ++m)
#pragma unroll
                    for (int bj = 0; bj < 2; ++bj) *(u32x4*)(base + (lo + (unsigned)(((ai * 128 + m * 16) * 1024 + bj * 128) * 2))) = pack8(acc[ai][bj][m][0] * rs[ai][m], acc[ai][bj][m][1] * rs[ai][m]);
        } else if (pn < 10) {
            const int br = pn - 4; const int b = u.pm >> 3, tb = (u.pm & 7) * 8;
            if (br == 2 || br == 4) {
                unsigned char* base = ws + OFF_BRA + (size_t)br * 32 * MiB + ((size_t)b * 4 * 2048 * 64 + (size_t)tb * 2048) * 2;
                unsigned lo = ((cw >> 6) * 2048 * 64 + ((wr * 8 + ((cw & 63) >> 4)) * 64 + ((cw >> 3) & 1) * 32 + fr) * 8) * 2; OPAQUE(lo);
#pragma unroll
                for (int ai = 0; ai < 2; ++ai)
#pragma unroll
                    for (int m = 0; m < 4; ++m)
#pragma unroll
                        for (int bj = 0; bj < 2; ++bj) *(u32x4*)(base + (lo + (unsigned)((bj * 2 * 2048 * 64 + ((ai * 4 + (m >> 1)) * 4 * 64 + (m & 1) * 16) * 8) * 2))) = pack8(acc[ai][bj][m][0] * rs[ai][m], acc[ai][bj][m][1] * rs[ai][m]);
            } else {
                unsigned char* base = ws + OFF_BRA + (size_t)br * 32 * MiB + rowt * 256 * 2; unsigned lo = (rl * 256 + cw) * 2; OPAQUE(lo);
#pragma unroll
                for (int ai = 0; ai < 2; ++ai)
#pragma unroll
                    for (int m = 0; m < 4; ++m)
#pragma unroll
                        for (int bj = 0; bj < 2; ++bj) *(u32x4*)(base + (lo + (unsigned)(((ai * 128 + m * 16) * 256 + bj * 128) * 2))) = pack8(acc[ai][bj][m][0] * rs[ai][m], acc[ai][bj][m][1] * rs[ai][m]);
            }
        } else {
            if (cw < 48) {
                unsigned char* base = ws + OFF_GATE + rowt * 48 * 4; unsigned lo = (rl * 48 + cw) * 4; OPAQUE(lo);
                float bg[8];
#pragma unroll
                for (int e = 0; e < 8; ++e) bg[e] = (cw + e < 48) ? b_gate[cw + e] : 0.f;
#pragma unroll
                for (int ai = 0; ai < 2; ++ai)
#pragma unroll
                    for (int m = 0; m < 4; ++m) { const f32x4 v0 = acc[ai][0][m][0] * rs[ai][m], v1 = acc[ai][0][m][1] * rs[ai][m];
#pragma unroll
                        for (int e = 0; e < 4; ++e) { if (cw + e < 48) *(float*)(base + (lo + (unsigned)(((ai * 128 + m * 16) * 48 + e) * 4))) = sigmoidf_(v0[e] + bg[e]);
                            if (cw + 4 + e < 48) *(float*)(base + (lo + (unsigned)(((ai * 128 + m * 16) * 48 + e + 4) * 4))) = sigmoidf_(v1[e] + bg[4 + e]); } }
            }
        }
    }
};
template <int LAYER>
struct EpiV {
    unsigned char* ws; const float* ssq;
    __device__ __forceinline__ void operator()(const Acc& acc, const Unit& u, int wr, int wc, int fr, int fq) const {
        const int pn = u.pn, b = u.pm >> 3; const size_t rowt = (size_t)u.pm * 256;
        const int idx = LAYER ? pn - 12 : 0, dsh = LAYER ? 2 * (idx >> 1) : 0, lsh = 11 - dsh;
        unsigned char* base = ws + (LAYER ? OFF_KVB + (size_t)idx * 32 * MiB : OFF_BRA + (size_t)(pn - 4) * 32 * MiB) + ((size_t)b * 4 * 2048 * 64) * 2;
        unsigned lo = ((wc >> 1) * 2048 * 64 + ((wc & 1) * 128 + fr) * 8) * 2; OPAQUE(lo);
        f32x4 rsv[2][4]; { float rv[2]; load_row_rs(rv, (const unsigned char*)(ssq + rowt * 16), wr, fr, fq);
#pragma unroll
        for (int ai = 0; ai < 2; ++ai)
#pragma unroll
            for (int m = 0; m < 4; ++m)
#pragma unroll
                for (int j = 0; j < 4; ++j) rsv[ai][m][j] = __shfl(rv[ai], m * 16 + 4 * fq + j); }
        if (dsh == 0) {
            const unsigned tb = (u.pm & 7) * 8;
            unsigned lk = (((tb + wr * 2) * 4) * 64 + (fq & 1) * 32) * 16 + (fq >> 1) * 8; OPAQUE(lk);
#pragma unroll
            for (int ai = 0; ai < 2; ++ai)
#pragma unroll
                for (int m = 0; m < 4; ++m) { const f32x4 rs = rsv[ai][m];
#pragma unroll
                    for (int bj = 0; bj < 2; ++bj)
#pragma unroll
                        for (int n = 0; n < 2; ++n) { const f32x4 v = acc[ai][bj][m][n] * rs; u32x2 w; w.x = cvt_pk_bf16(v[0], v[1]); w.y = cvt_pk_bf16(v[2], v[3]);
                            *(u32x2*)(base + (lo + lk + (unsigned)((bj * 2 * 2048 * 64 + ((((ai * 4 + (m >> 1)) * 4 + (m & 1)) * 64) + 16 * n) * 8) * 2))) = w; }
                    __builtin_amdgcn_sched_barrier(0); }
        } else {
            const unsigned sb = ((u.pm & 7) * 256) >> dsh; unsigned slb = wr * 64 + 4 * fq; OPAQUE(slb);
#pragma unroll
            for (int ai = 0; ai < 2; ++ai)
#pragma unroll
                for (int m = 0; m < 4; ++m) {
#pragma unroll
                    for (int j = 0; j < 4; ++j) { const float rs = rsv[ai][m][j]; const unsigned sl = slb + (unsigned)(ai * 128 + m * 16 + j);
                        const unsigned p = ((sl & ((1u << dsh) - 1u)) << lsh) + (sl >> dsh) + sb, kk = p & 31u, k16 = kk & 15u;
                        const unsigned po = (((p >> 5) * 4 + (kk >> 4)) * 64 + ((k16 >> 2) & 1u) * 32) * 16 + (((k16 >> 3) << 2) + (k16 & 3u)) * 2;
#pragma unroll
                        for (int bj = 0; bj < 2; ++bj)
#pragma unroll
                            for (int n = 0; n < 2; ++n) *(bf16_t*)(base + (lo + po + (unsigned)((bj * 2 * 2048 * 64 + 16 * n * 8) * 2))) = f2bf(acc[ai][bj][m][n][j] * rs); }
                    __builtin_amdgcn_sched_barrier(0); }
        }
    }
};
struct EpiQKVB {
    unsigned char* ws; const float* ssq;
    __device__ __forceinline__ void operator()(const Acc& acc, const Unit& u, int wr, int wc, int fr, int fq) const {
        const int pn = u.pn; unsigned rl = wr * 64 + fr, cw = wc * 32 + 8 * fq; OPAQUE(rl); OPAQUE(cw); const size_t rowt = (size_t)u.pm * 256;
        float rs[2][4]; { float rv[2]; load_row_rs(rv, (const unsigned char*)(ssq + rowt * 16), wr, fr, fq);
#pragma unroll
            for (int ai = 0; ai < 2; ++ai)
#pragma unroll
                for (int m = 0; m < 4; ++m) rs[ai][m] = __shfl(rv[ai], m * 16 + fr); }
        if (pn < 12) {
            unsigned char* base = ws + OFF_QB + (rowt * 3072 + pn * 256) * 2; unsigned lo = (rl * 3072 + cw) * 2; OPAQUE(lo);
#pragma unroll
            for (int ai = 0; ai < 2; ++ai)
#pragma unroll
                for (int m = 0; m < 4; ++m)
#pragma unroll
                    for (int bj = 0; bj < 2; ++bj) *(u32x4*)(base + (lo + (unsigned)(((ai * 128 + m * 16) * 3072 + bj * 128) * 2))) = pack8(acc[ai][bj][m][0] * rs[ai][m], acc[ai][bj][m][1] * rs[ai][m]);
        } else {
            const int idx = pn - 12, gi = idx >> 1, dsh = 2 * gi, lsh = 11 - dsh, b = u.pm >> 3, sb = ((u.pm & 7) * 256) >> dsh;
            unsigned posl = ((rl & ((1u << dsh) - 1u)) << lsh) + (rl >> dsh) + sb; OPAQUE(posl);
            unsigned char* base = ws + OFF_KVB + (size_t)idx * 32 * MiB + ((size_t)b * 4 * 2048 * 64) * 2;
            unsigned lo = ((cw >> 6) * 2048 * 64 + (((cw & 63) >> 4) * 64 + ((cw >> 3) & 1) * 32) * 8) * 2; OPAQUE(lo);
#pragma unroll
            for (int ai = 0; ai < 2; ++ai)
#pragma unroll
                for (int m = 0; m < 4; ++m) { const unsigned p = posl + (unsigned)((ai * 128 + m * 16) >> dsh), po = ((p >> 5) * 256 + (p & 31u)) * 16;
#pragma unroll
                    for (int bj = 0; bj < 2; ++bj) *(u32x4*)(base + (lo + po + (unsigned)(bj * 2 * 2048 * 64 * 2))) = pack8(acc[ai][bj][m][0] * rs[ai][m], acc[ai][bj][m][1] * rs[ai][m]); }
        }
    }
};
__device__ __forceinline__ f32x4 bf_lo4(u32x4 w) { f32x4 r; r[0] = __uint_as_float(w.x << 16); r[1] = __uint_as_float(w.x & 0xffff0000u); r[2] = __uint_as_float(w.y << 16); r[3] = __uint_as_float(w.y & 0xffff0000u); return r; }
__device__ __forceinline__ f32x4 bf_hi4(u32x4 w) { f32x4 r; r[0] = __uint_as_float(w.z << 16); r[1] = __uint_as_float(w.z & 0xffff0000u); r[2] = __uint_as_float(w.w << 16); r[3] = __uint_as_float(w.w & 0xffff0000u); return r; }
template <int MODE>
struct EpiResid {
    const float* xin; unsigned char* hout; float* ssq;
    __device__ __forceinline__ void operator()(const Acc& acc, const Unit& u, int wr, int wc, int fr, int fq) const {
        unsigned rl = wr * 64 + fr, cw = wc * 32 + 8 * fq; OPAQUE(rl); OPAQUE(cw); const size_t t0 = ((size_t)u.pm * 256 * 1024 + u.pn * 256) * 2;
        const unsigned char* bi = (const unsigned char*)xin + 2 * t0; unsigned char* bh = hout + t0; unsigned lo = (rl * 1024 + cw) * 2; OPAQUE(lo);
        float* sq = ssq + ((size_t)u.pm * 256 + rl) * 16 + u.pn * 4 + wc;
#pragma unroll
        for (int ai = 0; ai < 2; ++ai) {
            f32x4 xa[4][2][2];
#pragma unroll
            for (int m = 0; m < 4; ++m)
#pragma unroll
                for (int bj = 0; bj < 2; ++bj) { const unsigned o = lo + (unsigned)(((ai * 128 + m * 16) * 1024 + bj * 128) * 2);
                    if (MODE == 0) { xa[m][bj][0] = *(const f32x4*)(bi + 2 * o); xa[m][bj][1] = *(const f32x4*)(bi + 2 * o + 16); }
                    else { const u32x4 w = *(const u32x4*)(bh + o); xa[m][bj][0] = bf_lo4(w); xa[m][bj][1] = bf_hi4(w); } }
            __builtin_amdgcn_sched_barrier(0);
#pragma unroll
            for (int m = 0; m < 4; ++m) { float q = 0.f;
#pragma unroll
                for (int bj = 0; bj < 2; ++bj) { const unsigned o = lo + (unsigned)(((ai * 128 + m * 16) * 1024 + bj * 128) * 2);
                    const u32x4 w = pack8(xa[m][bj][0] + acc[ai][bj][m][0], xa[m][bj][1] + acc[ai][bj][m][1]);
                    *(u32x4*)(bh + o) = w;
                    if (MODE != 2) { const f32x4 a = bf_lo4(w), c = bf_hi4(w); q += (a[0] * a[0] + a[1] * a[1]) + (a[2] * a[2] + a[3] * a[3]) + (c[0] * c[0] + c[1] * c[1]) + (c[2] * c[2] + c[3] * c[3]); } }
                if (MODE != 2) { q += __shfl_xor(q, 16); q += __shfl_xor(q, 32); if (fq == 0) sq[(ai * 128 + m * 16) * 16] = q; } }
        }
    }
};
struct EpiSwiglu {
    unsigned char* act; const float* ssq;
    __device__ __forceinline__ void operator()(const Acc& acc, const Unit& u, int wr, int wc, int fr, int fq) const {
        unsigned rl = wr * 64 + fr, cw = wc * 32 + 8 * fq; OPAQUE(rl); OPAQUE(cw); unsigned char* base = act + ((size_t)u.pm * 256 * FFH + u.pn * 128) * 2; unsigned lo = (rl * FFH + cw) * 2; OPAQUE(lo);
        float rsv[2][4]; { float rv[2]; load_row_rs(rv, (const unsigned char*)(ssq + (size_t)u.pm * 256 * 16), wr, fr, fq);
#pragma unroll
        for (int ai = 0; ai < 2; ++ai)
#pragma unroll
            for (int m = 0; m < 4; ++m) rsv[ai][m] = __shfl(rv[ai], m * 16 + fr); }
#pragma unroll
        for (int ai = 0; ai < 2; ++ai)
#pragma unroll
            for (int m = 0; m < 4; ++m) { f32x4 h0, h1; const float rs = rsv[ai][m];
#pragma unroll
                for (int e = 0; e < 4; ++e) { const float a0 = acc[ai][0][m][0][e] * rs, a1 = acc[ai][0][m][1][e] * rs;
                    h0[e] = a0 * sigmoidf_(a0) * (acc[ai][1][m][0][e] * rs); h1[e] = a1 * sigmoidf_(a1) * (acc[ai][1][m][1][e] * rs); }
                *(u32x4*)(base + (lo + (unsigned)((ai * 128 + m * 16) * FFH * 2))) = pack8(h0, h1); }
    }
};
struct EpiCmp1 {
    unsigned char* ws;
    __device__ __forceinline__ void operator()(const Acc& acc, const Unit& u, int wr, int wc, int fr, int fq) const {
        const int kv = u.pn; unsigned rl = wr * 64 + fr, cw = wc * 32 + 8 * fq; OPAQUE(rl); OPAQUE(cw);
        unsigned char* base = ws + OFF_G1 + (((size_t)kv * 16384 + (size_t)u.pm * 256) * 256) * 2; unsigned lo = (rl * 256 + cw) * 2; OPAQUE(lo);
        const unsigned char* bp = ws + OFF_BIAS1 + (size_t)kv * 256 * 4; unsigned blo = cw * 4; OPAQUE(blo);
#pragma unroll
        for (int bj = 0; bj < 2; ++bj) {
            const f32x4 b0 = *(const f32x4*)(bp + (blo + (unsigned)(bj * 128 * 4))), b1 = *(const f32x4*)(bp + (blo + (unsigned)(bj * 128 * 4 + 16)));
#pragma unroll
            for (int ai = 0; ai < 2; ++ai)
#pragma unroll
                for (int m = 0; m < 4; ++m) { f32x4 h0, h1;
#pragma unroll
                    for (int e = 0; e < 4; ++e) {
                        const float x0 = acc[ai][bj][m][0][e] + b0[e], x1 = acc[ai][bj][m][1][e] + b1[e];
                        const float u0 = 0.7978845608028654f * (x0 + 0.044715f * x0 * x0 * x0), u1 = 0.7978845608028654f * (x1 + 0.044715f * x1 * x1 * x1);
                        h0[e] = x0 * sigmoidf_(2.f * u0); h1[e] = x1 * sigmoidf_(2.f * u1); }
                    *(u32x4*)(base + (lo + (unsigned)(((ai * 128 + m * 16) * 256 + bj * 128) * 2))) = pack8(h0, h1); }
        }
    }
};

__device__ __forceinline__ void conv_weight(const float* W, int K, int N, const float* gain, bf16_t* WT, int row_off, int mode, LAS float* scr, int gw, int NGW, int lane) {
    const int nnb = (N + 31) / 32, nitems = (K / 64) * nnb;
    for (int item = gw; item < nitems; item += NGW) {
        const int kb = item / nnb, nb = item % nnb, k0 = 64 * kb, n0 = 32 * nb;
#pragma unroll 8
        for (int i = 0; i < 32; ++i) { const int kk = 2 * i + (lane >> 5), n = n0 + (lane & 31);
            float v = (n < N) ? W[(size_t)(k0 + kk) * N + n] : 0.f; if (gain) v *= gain[k0 + kk]; scr[kk * 33 + (lane & 31)] = v; }
        LDS_WAIT();
        int dr0 = row_off + n0;
        if (mode == 1) dr0 = (n0 < FFH) ? ((n0 >> 7) * 256 + (n0 & 127)) : ((((n0 - FFH) >> 7) * 256) + 128 + ((n0 - FFH) & 127));
        const int c = lane & 7;
#pragma unroll
        for (int j = 0; j < 4; ++j) { const int nn = (lane >> 3) + 8 * j; const LAS float* s = scr + (8 * c) * 33 + nn;
            u32x4 o; o.x = cvt_pk_bf16(s[0 * 33], s[1 * 33]); o.y = cvt_pk_bf16(s[2 * 33], s[3 * 33]); o.z = cvt_pk_bf16(s[4 * 33], s[5 * 33]); o.w = cvt_pk_bf16(s[6 * 33], s[7 * 33]);
            if (n0 + nn < N) *(u32x4*)(WT + (size_t)(dr0 + nn) * K + k0 + 8 * c) = o; }
        LDS_WAIT();
    }
}
__device__ __forceinline__ void cast_rows(const float* x, bf16_t* h, float* ssq, int gw, int NGW, int lane) {
    for (int row = gw; row < T_TOK; row += NGW) {
        const f32x4* xr = (const f32x4*)(x + (size_t)row * DM) + lane; f32x4 v[4]; float s = 0.f;
#pragma unroll
        for (int j = 0; j < 4; ++j) { v[j] = xr[64 * j]; s += (v[j][0] * v[j][0] + v[j][1] * v[j][1]) + (v[j][2] * v[j][2] + v[j][3] * v[j][3]); }
        s = wave_sum(s);
        u32x2* o = (u32x2*)(h + (size_t)row * DM) + lane;
#pragma unroll
        for (int j = 0; j < 4; ++j) { u32x2 w; w.x = cvt_pk_bf16(v[j][0], v[j][1]); w.y = cvt_pk_bf16(v[j][2], v[j][3]); o[64 * j] = w; }
        if (lane < 16) ssq[(size_t)row * 16 + lane] = lane == 0 ? s : 0.f;
    }
}
__device__ __forceinline__ void final_norm_rows(const bf16_t* hsrc, float* out, const float* gain, int gw, int NGW) {
    const int lane = threadIdx.x & 63;
    f32x4 gv[4];
#pragma unroll
    for (int j = 0; j < 4; ++j) gv[j] = ((const f32x4*)gain)[lane + 64 * j];
    for (int row = gw; row < T_TOK; row += NGW) {
        const u32x2* hr = (const u32x2*)(hsrc + (size_t)row * DM) + lane; f32x4* xr = (f32x4*)(out + (size_t)row * DM) + lane; f32x4 v[4]; float s = 0.f;
#pragma unroll
        for (int j = 0; j < 4; ++j) { const u32x2 w = hr[64 * j]; v[j][0] = __uint_as_float(w.x << 16); v[j][1] = __uint_as_float(w.x & 0xffff0000u); v[j][2] = __uint_as_float(w.y << 16); v[j][3] = __uint_as_float(w.y & 0xffff0000u);
            s += (v[j][0] * v[j][0] + v[j][1] * v[j][1]) + (v[j][2] * v[j][2] + v[j][3] * v[j][3]); }
        const float r = 1.f / sqrtf(wave_sum(s) * (1.f / DM) + 1e-6f);
#pragma unroll
        for (int j = 0; j < 4; ++j) xr[64 * j] = v[j] * r * gv[j];
    }
}

struct SoftState { float m, l; f32x16 o0, o1; };
struct KFrag { bf16x8 k0, k1, k2, k3; };
__device__ __forceinline__ bf16x8 ld_v8(const char* p) { const u64 lo = *(const u64*)p, hi = *(const u64*)(p + 16); u32x4 t; t.x = (unsigned)lo; t.y = (unsigned)(lo >> 32); t.z = (unsigned)hi; t.w = (unsigned)(hi >> 32); return __builtin_bit_cast(bf16x8, t); }
__device__ __forceinline__ bf16x8 pk_lo(const f32x16& p) { u32x4 t; t.x = cvt_pk_bf16(p[0], p[1]); t.y = cvt_pk_bf16(p[2], p[3]); t.z = cvt_pk_bf16(p[4], p[5]); t.w = cvt_pk_bf16(p[6], p[7]); return __builtin_bit_cast(bf16x8, t); }
__device__ __forceinline__ bf16x8 pk_hi(const f32x16& p) { u32x4 t; t.x = cvt_pk_bf16(p[8], p[9]); t.y = cvt_pk_bf16(p[10], p[11]); t.z = cvt_pk_bf16(p[12], p[13]); t.w = cvt_pk_bf16(p[14], p[15]); return __builtin_bit_cast(bf16x8, t); }
__device__ __forceinline__ void load_k(KFrag& f, const char* kp) { f.k0 = *(const bf16x8*)kp; f.k1 = *(const bf16x8*)(kp + 1024); f.k2 = *(const bf16x8*)(kp + 2048); f.k3 = *(const bf16x8*)(kp + 3072); }
__device__ __forceinline__ void tile_compute(SoftState& st, const bf16x8 (&qf)[4], const KFrag& f, const char* vp, const LAS unsigned char* lds, unsigned vb, int dist0, int max_dist, bool masked) {
    const bf16x8 v00 = *(const bf16x8*)vp, v01 = *(const bf16x8*)(vp + 1024), v10 = *(const bf16x8*)(vp + 2048), v11 = *(const bf16x8*)(vp + 3072);
    f32x16 s = {0.f, 0.f, 0.f, 0.f, 0.f, 0.f, 0.f, 0.f, 0.f, 0.f, 0.f, 0.f, 0.f, 0.f, 0.f, 0.f};
    s = mfma32(f.k0, qf[0], s); s = mfma32(f.k1, qf[1], s); s = mfma32(f.k2, qf[2], s); s = mfma32(f.k3, qf[3], s);
    f32x16 t;
#pragma unroll
    for (int i = 0; i < 16; ++i) t[i] = s[i] * SC2 + *(const LAS float*)(lds + vb + 4 * (27 - ((i & 3) + 8 * (i >> 2))));
    if (masked) {
#pragma unroll
        for (int i = 0; i < 16; ++i) t[i] = ((unsigned)(dist0 - ((i & 3) + 8 * (i >> 2))) <= (unsigned)max_dist) ? t[i] : -__builtin_inff();
    }
    float mx = fmaxf(fmaxf(fmaxf(t[0], t[1]), fmaxf(t[2], t[3])), fmaxf(fmaxf(t[4], t[5]), fmaxf(t[6], t[7])));
    mx = fmaxf(mx, fmaxf(fmaxf(fmaxf(t[8], t[9]), fmaxf(t[10], t[11])), fmaxf(fmaxf(t[12], t[13]), fmaxf(t[14], t[15]))));
    mx = fmaxf(mx, __shfl_xor(mx, 32));
    if (__builtin_amdgcn_ballot_w64(mx > st.m) != 0ull) { const float mnew = fmaxf(mx, st.m), alpha = fexp2(st.m - mnew); st.l *= alpha; st.o0 *= alpha; st.o1 *= alpha; st.m = mnew; }
    float ls = 0.f;
#pragma unroll
    for (int i = 0; i < 16; ++i) { t[i] = fexp2(t[i] - st.m); ls += t[i]; }
    st.l += ls;
    const bf16x8 pb0 = pk_lo(t), pb1 = pk_hi(t);
    st.o0 = mfma32(v00, pb0, st.o0); st.o0 = mfma32(v01, pb1, st.o0); st.o1 = mfma32(v10, pb0, st.o1); st.o1 = mfma32(v11, pb1, st.o1);
}
__device__ __forceinline__ void soft_init(SoftState& st) { st.m = -1e30f; st.l = 0.f;
#pragma unroll
    for (int i = 0; i < 16; ++i) { st.o0[i] = 0.f; st.o1[i] = 0.f; } }

__device__ __forceinline__ void run_range(SoftState& st, const bf16x8 (&qf)[4], const char* Kl, const char* Vl, int kt_lo, int kt_hi,
                                          int qpos, int qmin, int qmax, int max_dist, unsigned tb_head, const LAS unsigned char* lds, int h) {
    KFrag A, B;
    load_k(A, Kl + (size_t)kt_lo * 4096);
#pragma unroll 1
    for (int kt = kt_lo; kt <= kt_hi; ++kt) {
        if (kt + 1 <= kt_hi) load_k(B, Kl + (size_t)(kt + 1) * 4096);
        const int kbase = 32 * kt, dist0 = qpos - kbase - 4 * h; const unsigned vb = tb_head + (unsigned)(4 * (dist0 - 27));
        const bool masked = !(qmin - kbase - 31 >= 0 && qmax - kbase <= max_dist);
        tile_compute(st, qf, A, Vl + (size_t)kt * 4096, lds, vb, dist0, max_dist, masked);
        A = B;
    }
}

constexpr int ATT_TAB = 1024  , ATT_HS_A = 2056  , ATT_HS_B = 136  , ATT_NEG = LDS_NEG;

__device__ __forceinline__ void phaseA_attn(unsigned char* ws, LAS unsigned char* lds, int gw, int NGW) {
    const int lane = threadIdx.x & 63;
    const int r = lane & 31, h = lane >> 5, tk = r >> 2, rr = r & 3;
    const LAS unsigned char* lut = lds + LDS_LUT; const LAS float* bias2 = (const LAS float*)(lds + LDS_BIAS);
    { LAS float* tab = (LAS float*)(lds + ATT_TAB);
      for (int i = threadIdx.x; i < 16 * ATT_HS_A; i += 512) { const int hd = i / ATT_HS_A, d = i - hd * ATT_HS_A; tab[i] = d < 2048 ? bias2[(int)lut[d] * 16 + hd] : 0.f; }
      if (threadIdx.x < 256) ((LAS float*)lds)[threadIdx.x] = 0.f;
      if (threadIdx.x < 64) ((LAS float*)(lds + ATT_NEG))[threadIdx.x] = -__builtin_inff();
      __syncthreads(); }
    for (int item = gw; item < 32768; item += NGW) {
        const int bg = item >> 8, ti = ((item & 255) + 16 * (item >> 11)) & 255, b = bg >> 2, g = bg & 3, s0 = ti * 8, s = s0 + tk, head = g * 4 + rr, cur = s0 >> 6;
        const size_t tok = (size_t)b * 2048 + s;
        const LAS float* bias2h = bias2 + head;
        const unsigned tb_head = (unsigned)(ATT_TAB + head * ATT_HS_A * 4);
        bf16x8 qf[4];
        { const char* qp = (const char*)ws + OFF_QA + (tok * 1024 + head * 64 + 8 * h) * 2;
#pragma unroll
          for (int ks = 0; ks < 4; ++ks) qf[ks] = *(const bf16x8*)(qp + 32 * ks); }
        const float* gp = (const float*)(ws + OFF_GATE) + tok * 48 + head * 3; const float g_cmp = gp[0], g_sel = gp[1], g_win = gp[2];
        unsigned tp[16]; unsigned sel;
        {
            const char* Kc = (const char*)ws + OFF_KCMP + (size_t)bg * 128 * 128; const char* Vc = (const char*)ws + OFF_VCMPT + (size_t)bg * 64 * 256;
            f32x16 sc[4];
#pragma unroll
            for (int c = 0; c < 4; ++c) { const char* kp = Kc + (32 * c + r) * 128 + 16 * h; f32x16 a = {0.f, 0.f, 0.f, 0.f, 0.f, 0.f, 0.f, 0.f, 0.f, 0.f, 0.f, 0.f, 0.f, 0.f, 0.f, 0.f};
#pragma unroll
                for (int ks = 0; ks < 4; ++ks) a = mfma32(*(const bf16x8*)(kp + 32 * ks), qf[ks], a); sc[c] = a; }
            __builtin_amdgcn_sched_barrier(0);
            float mx = -1e30f;
#pragma unroll
            for (int c = 0; c < 4; ++c)
#pragma unroll
                for (int i = 0; i < 16; ++i) { const int n = 32 * c + (i & 3) + 8 * (i >> 2) + 4 * h, dist = s - 16 * n - 31; const bool valid = dist >= 0; const int idx = dist < 0 ? 0 : dist;
                    const float t = valid ? sc[c][i] * SC2 + bias2h[(int)lut[idx] * 16] : -1e30f; sc[c][i] = t; mx = fmaxf(mx, t); }
            mx = fmaxf(mx, __shfl_xor(mx, 32)); float l = 0.f;
#pragma unroll
            for (int c = 0; c < 4; ++c)
#pragma unroll
                for (int i = 0; i < 16; ++i) { const float pv = sc[c][i] > -1e29f ? fexp2(sc[c][i] - mx) : 0.f; sc[c][i] = pv; l += pv; }
            l += __shfl_xor(l, 32); const float inv = 1.f / fmaxf(l, 1e-30f);
#pragma unroll
            for (int c = 0; c < 4; ++c) sc[c] *= inv;
            __builtin_amdgcn_sched_barrier(0);
            f32x16 oc0 = {0.f, 0.f, 0.f, 0.f, 0.f, 0.f, 0.f, 0.f, 0.f, 0.f, 0.f, 0.f, 0.f, 0.f, 0.f, 0.f}, oc1 = oc0;
#pragma unroll
            for (int c = 0; c < 4; ++c) { const bf16x8 pb0 = pk_lo(sc[c]), pb1 = pk_hi(sc[c]); const char* vp0 = Vc + r * 256 + (32 * c + 4 * h) * 2; const char* vp1 = vp0 + 32 * 256;
                oc0 = mfma32(ld_v8(vp0), pb0, oc0); oc0 = mfma32(ld_v8(vp0 + 32), pb1, oc0); oc1 = mfma32(ld_v8(vp1), pb0, oc1); oc1 = mfma32(ld_v8(vp1 + 32), pb1, oc1); }
            oc0 *= g_cmp; oc1 *= g_cmp;
#pragma unroll
            for (int q = 0; q < 8; ++q) { tp[q] = cvt_pk_bf16(oc0[2 * q], oc0[2 * q + 1]); tp[8 + q] = cvt_pk_bf16(oc1[2 * q], oc1[2 * q + 1]); }
            __builtin_amdgcn_sched_barrier(0);
            float own[16], oth[16], pl[16];
#pragma unroll
            for (int cgi = 0; cgi < 16; ++cgi) pl[cgi] = __shfl_xor(sc[cgi >> 2][4 * (cgi & 3) + 3], 32);
#pragma unroll
            for (int cgi = 0; cgi < 16; ++cgi) { const int c = cgi >> 2, q4 = 4 * (cgi & 3); float v = (sc[c][q4] + sc[c][q4 + 1]) + (sc[c][q4 + 2] + sc[c][q4 + 3]);
                const float prevh0 = cgi > 0 ? pl[cgi > 0 ? cgi - 1 : 0] : 0.f; v += h ? pl[cgi] : prevh0;
                v += __shfl_xor(v, 1); v += __shfl_xor(v, 2); own[cgi] = v; }
#pragma unroll
            for (int cgi = 0; cgi < 16; ++cgi) oth[cgi] = __shfl_xor(own[cgi], 32);
            __builtin_amdgcn_sched_barrier(0);
            float cand[32];
#pragma unroll
            for (int cgi = 0; cgi < 16; ++cgi) { const float ve = h ? oth[cgi] : own[cgi], vo = h ? own[cgi] : oth[cgi];
                cand[2 * cgi] = (2 * cgi >= 1 && 2 * cgi <= cur - 2) ? ve : -2.f; cand[2 * cgi + 1] = (2 * cgi + 1 <= cur - 2) ? vo : -2.f; }
            float prev = 3.0e38f;
#pragma unroll 1
            for (int round = 0; round < 5; ++round) { float best = -1.f;
#pragma unroll
                for (int j = 0; j < 32; ++j) { const float v = cand[j] < prev ? cand[j] : -2.f; best = fmaxf(best, v); }
                prev = best; }
            const float thr = fmaxf(prev, 0.f);
            sel = 1u | (1u << cur) | (cur > 0 ? (1u << (cur - 1)) : 0u);
#pragma unroll
            for (int j = 1; j < 32; ++j) sel |= (cand[j] >= thr) ? (1u << j) : 0u;
        }
        {
            unsigned um = sel; um |= __shfl_xor(um, 4); um |= __shfl_xor(um, 8); um |= __shfl_xor(um, 16); um = __builtin_amdgcn_readfirstlane(um);
            const char* Kl = (const char*)ws + OFF_BRA + 2 * 32 * MiB + (size_t)bg * 2048 * 128 + lane * 16;
            const char* Vl = (const char*)ws + OFF_BRA + 3 * 32 * MiB + (size_t)bg * 2048 * 128 + lane * 16;
            SoftState st; soft_init(st);
            KFrag A, B; int half = 0, kb = 64 * __builtin_ctz(um), kbn = 0; bool has;
            load_k(A, Kl + (size_t)kb * 128);
#pragma unroll 1
            for (;;) {
                if (half) um &= um - 1; half ^= 1; has = um != 0u; if (has) { kbn = 64 * __builtin_ctz(um) + 32 * half; load_k(B, Kl + (size_t)kbn * 128); }
                { const int jb = kb >> 6, dist0 = s - kb - 4 * h; const unsigned vb = ((sel >> jb) & 1u) ? tb_head + (unsigned)(4 * (dist0 - 27)) : (unsigned)ATT_NEG;
                  tile_compute(st, qf, A, Vl + (size_t)kb * 128, lds, vb, dist0, 1 << 20, jb >= cur); }
                if (!has) break; kb = kbn; A = B;
            }
            const float lt = st.l + __shfl_xor(st.l, 32), sc = g_sel / fmaxf(lt, 1e-30f);
#pragma unroll
            for (int q = 0; q < 8; ++q) { tp[q] = cvt_pk_bf16(__uint_as_float(tp[q] << 16) + st.o0[2 * q] * sc, __uint_as_float(tp[q] & 0xffff0000u) + st.o0[2 * q + 1] * sc);
                tp[8 + q] = cvt_pk_bf16(__uint_as_float(tp[8 + q] << 16) + st.o1[2 * q] * sc, __uint_as_float(tp[8 + q] & 0xffff0000u) + st.o1[2 * q + 1] * sc); }
        }
        {
            const char* Kl = (const char*)ws + OFF_BRA + 4 * 32 * MiB + (size_t)bg * 2048 * 128 + lane * 16;
            const char* Vl = (const char*)ws + OFF_BRA + 5 * 32 * MiB + (size_t)bg * 2048 * 128 + lane * 16;
            SoftState st; soft_init(st);
            const int lo = s0 - 255, kt_lo = lo < 0 ? 0 : (lo >> 5), kt_hi = (s0 + 7) >> 5;
            run_range(st, qf, Kl, Vl, kt_lo, kt_hi, s, s0, s0 + 7, 255, tb_head, lds, h);
            const float lt = st.l + __shfl_xor(st.l, 32), sc = g_win / fmaxf(lt, 1e-30f);
#pragma unroll
            for (int q = 0; q < 8; ++q) { tp[q] = cvt_pk_bf16(__uint_as_float(tp[q] << 16) + st.o0[2 * q] * sc, __uint_as_float(tp[q] & 0xffff0000u) + st.o0[2 * q + 1] * sc);
                tp[8 + q] = cvt_pk_bf16(__uint_as_float(tp[8 + q] << 16) + st.o1[2 * q] * sc, __uint_as_float(tp[8 + q] & 0xffff0000u) + st.o1[2 * q + 1] * sc); }
        }
        { unsigned char* op = ws + OFF_O + (tok * 1024 + head * 64 + 4 * h) * 2;
#pragma unroll
          for (int q = 0; q < 4; ++q) { u32x2 w; w.x = tp[2 * q]; w.y = tp[2 * q + 1]; *(u32x2*)(op + 16 * q) = w; u32x2 w2; w2.x = tp[8 + 2 * q]; w2.y = tp[8 + 2 * q + 1]; *(u32x2*)(op + 64 + 16 * q) = w2; } }
    }
}

__device__ __forceinline__ void phaseB_attn(unsigned char* ws, LAS unsigned char* lds, int gw, int NGW) {
    const int lane = threadIdx.x & 63;
    const int r = lane & 31, h = lane >> 5, tk = r >> 2, rr = r & 3;
    const LAS unsigned char* lut = lds + LDS_LUT; const LAS float* bias2 = (const LAS float*)(lds + LDS_BIAS);
    { LAS float* tab = (LAS float*)(lds + ATT_TAB);
      for (int i = threadIdx.x; i < 3 * 16 * ATT_HS_B; i += 512) { const int gh = i / ATT_HS_B, d = i - gh * ATT_HS_B, gi = gh >> 4, hd = gh & 15; int td = d << (2 * gi); td = td > 2047 ? 2047 : td;
          tab[i] = bias2[(int)lut[td] * 16 + hd]; }
      if (threadIdx.x < 256) ((LAS float*)lds)[threadIdx.x] = 0.f;
      __syncthreads(); }
    for (int item = gw; item < 32768; item += NGW) {
        const int bg = item >> 8, cc = (item >> 4) & 15, r16 = item & 15, b = bg >> 2, g = bg & 3, s0 = cc * 128 + r16, s = s0 + 16 * tk, head = g * 4 + rr;
        const size_t tok = (size_t)b * 2048 + s;
        SoftState st; soft_init(st);
#pragma unroll 1
        for (int gi = 0; gi < 3; ++gi) {
            const int dsh = 2 * gi, lsh = 11 - dsh, res = s0 & ((1 << dsh) - 1);
            bf16x8 qf[4];
            { const char* qp = (const char*)ws + OFF_QB + (tok * 3072 + gi * 1024 + head * 64 + 8 * h) * 2;
#pragma unroll
              for (int ks = 0; ks < 4; ++ks) qf[ks] = *(const bf16x8*)(qp + 32 * ks); }
            const char* Kl = (const char*)ws + OFF_KVB + (size_t)(gi * 2) * 32 * MiB + ((size_t)bg * 2048 + ((size_t)res << lsh)) * 128 + lane * 16;
            const char* Vl = (const char*)ws + OFF_KVB + (size_t)(gi * 2 + 1) * 32 * MiB + ((size_t)bg * 2048 + ((size_t)res << lsh)) * 128 + lane * 16;
            const int ql = s >> dsh, qmin = s0 >> dsh, qmax = (s0 + 112) >> dsh, ql_lo = qmin - 128, kt_lo = ql_lo < 0 ? 0 : (ql_lo >> 5), kt_hi = qmax >> 5;
            const unsigned tb_head = (unsigned)(ATT_TAB + (gi * 16 + head) * ATT_HS_B * 4);
            run_range(st, qf, Kl, Vl, kt_lo, kt_hi, ql, qmin, qmax, 128, tb_head, lds, h);
        }
        const float lt = st.l + __shfl_xor(st.l, 32), sc = 1.f / fmaxf(lt, 1e-30f);
        const f32x16 tot0 = st.o0 * sc, tot1 = st.o1 * sc;
        { unsigned char* op = ws + OFF_O + (tok * 1024 + head * 64 + 4 * h) * 2;
#pragma unroll
          for (int q = 0; q < 4; ++q) { u32x2 w; w.x = cvt_pk_bf16(tot0[4 * q], tot0[4 * q + 1]); w.y = cvt_pk_bf16(tot0[4 * q + 2], tot0[4 * q + 3]); *(u32x2*)(op + 16 * q) = w;
              u32x2 w2; w2.x = cvt_pk_bf16(tot1[4 * q], tot1[4 * q + 1]); w2.y = cvt_pk_bf16(tot1[4 * q + 2], tot1[4 * q + 3]); *(u32x2*)(op + 64 + 16 * q) = w2; } }
    }
}

__device__ __forceinline__ void phase_cmp2(unsigned char* ws, int gw, int NGW) {
    const int lane = threadIdx.x & 63;
    const int r = lane & 31, h = lane >> 5;
    for (int item = gw; item < 1024; item += NGW) {
        const int kv = item >> 9, rt = item & 511;
        const char* ap = (const char*)ws + OFF_G1 + (((size_t)kv * 16384 + rt * 32 + r) * 256 + 8 * h) * 2;
        const char* bp = (const char*)ws + OFF_W2 + (size_t)kv * 32768 + ((size_t)r * 256 + 8 * h) * 2;
        f32x16 a0 = {0.f, 0.f, 0.f, 0.f, 0.f, 0.f, 0.f, 0.f, 0.f, 0.f, 0.f, 0.f, 0.f, 0.f, 0.f, 0.f}, a1 = a0;
#pragma unroll
        for (int ks = 0; ks < 16; ++ks) { const bf16x8 a = *(const bf16x8*)(ap + 32 * ks);
            a0 = mfma32(a, *(const bf16x8*)(bp + 32 * ks), a0); a1 = mfma32(a, *(const bf16x8*)(bp + 32 * 256 * 2 + 32 * ks), a1); }
#pragma unroll
        for (int i = 0; i < 16; ++i) { const int row = rt * 32 + (i & 3) + 8 * (i >> 2) + 4 * h, gq = row & 3, n = (row >> 2) & 127, b = row >> 9, bgi = b * 4 + gq;
            if (kv == 0) { bf16_t* o = (bf16_t*)(ws + OFF_KCMP) + ((size_t)bgi * 128 + n) * 64; o[r] = f2bf(a0[i]); o[r + 32] = f2bf(a1[i]); }
            else { bf16_t* o = (bf16_t*)(ws + OFF_VCMPT) + (size_t)bgi * 64 * 128 + n; o[(size_t)r * 128] = f2bf(a0[i]); o[(size_t)(r + 32) * 128] = f2bf(a1[i]); } }
    }
}

__global__ __launch_bounds__(512, 2) void yoco_mega(Params p) {
    extern __shared__ __attribute__((aligned(16))) unsigned char shm[];
    cg::grid_group grid = cg::this_grid();
    LAS unsigned char* lds = (LAS unsigned char*)shm;
    const int tid = threadIdx.x, lane = tid & 63, wave = __builtin_amdgcn_readfirstlane(tid >> 6), gw = blockIdx.x * 8 + wave, NGW = gridDim.x * 8;
    unsigned char* ws = p.ws;
    const float* x_in = p.in[0];
    float* X = p.out;
    { LAS unsigned char* lut = lds + LDS_LUT; LAS float* bias2 = (LAS float*)(lds + LDS_BIAS);
      for (int d = tid; d < 2048; d += 512) { int bk = d; if (d >= 16) bk = 16 + (d >= 22) + (d >= 30) + (d >= 40) + (d >= 54) + (d >= 73) + (d >= 99) + (d >= 134) + (d >= 182) + (d >= 246) + (d >= 332) + (d >= 450) + (d >= 609) + (d >= 825) + (d >= 1117) + (d >= 1513); lut[d] = (unsigned char)bk; }
      bias2[tid] = p.in[1][tid] * LOG2E;
      __syncthreads(); }
    {
        LAS float* scr = (LAS float*)(lds + wave * 8448);
        const float* nm = p.in[2]; const float* nf = p.in[3];
        conv_weight(p.in[4], 1024, 2608, nm, (bf16_t*)(ws + OFF_WIN), 0, 0, scr, gw, NGW, lane);
        conv_weight(p.in[7], 2048, 256, nullptr, (bf16_t*)(ws + OFF_W1), 0, 0, scr, gw, NGW, lane);
        conv_weight(p.in[10], 2048, 256, nullptr, (bf16_t*)(ws + OFF_W1), 256, 0, scr, gw, NGW, lane);
        conv_weight(p.in[8], 256, 64, nullptr, (bf16_t*)(ws + OFF_W2), 0, 0, scr, gw, NGW, lane);
        conv_weight(p.in[11], 256, 64, nullptr, (bf16_t*)(ws + OFF_W2), 64, 0, scr, gw, NGW, lane);
        conv_weight(p.in[12], 1024, 1024, nullptr, (bf16_t*)(ws + OFF_WOUTA), 0, 0, scr, gw, NGW, lane);
        conv_weight(p.in[15], 1024, 3072, nm + 1024, (bf16_t*)(ws + OFF_WQKVB), 0, 0, scr, gw, NGW, lane);
        conv_weight(p.in[14], 1024, 1536, p.in[13], (bf16_t*)(ws + OFF_WQKVB), 3072, 0, scr, gw, NGW, lane);
        conv_weight(p.in[16], 1024, 1024, nullptr, (bf16_t*)(ws + OFF_WOUTB), 0, 0, scr, gw, NGW, lane);
        conv_weight(p.in[17], 1024, 5632, nf, (bf16_t*)(ws + OFF_WUP0), 0, 1, scr, gw, NGW, lane);
        conv_weight(p.in[17] + (size_t)1024 * 5632, 1024, 5632, nf + 1024, (bf16_t*)(ws + OFF_WUP1), 0, 1, scr, gw, NGW, lane);
        conv_weight(p.in[18], 2816, 1024, nullptr, (bf16_t*)(ws + OFF_WDN0), 0, 0, scr, gw, NGW, lane);
        conv_weight(p.in[18] + (size_t)2816 * 1024, 2816, 1024, nullptr, (bf16_t*)(ws + OFF_WDN1), 0, 0, scr, gw, NGW, lane);
        for (int item = gw; item < 512; item += NGW) { const int kv = item >> 8, ksl = (item >> 2) & 63, c = (item & 3) * 64 + lane;
            const float* pe = kv ? p.in[9] : p.in[6]; const float* w1 = kv ? p.in[10] : p.in[7]; float a = 0.f;
#pragma unroll 8
            for (int kk = ksl * 32; kk < ksl * 32 + 32; ++kk) a += pe[kk] * w1[(size_t)kk * 256 + c];
            ((float*)(ws + OFF_BIASP))[(kv * 64 + ksl) * 256 + c] = a; }
        cast_rows(x_in, (bf16_t*)(ws + OFF_H), (float*)(ws + OFF_SSQ), gw, NGW, lane);
    }
    grid.sync();
    pg8::StaticOrder S;
    float* const SSQ = (float*)(ws + OFF_SSQ);
    { pg8::Gemm g{(const char*)ws + OFF_H, (const char*)ws + OFF_WIN, 1024, 1024, 0, 0};
      { S.init(256, 9, gridDim.x, blockIdx.x, 1); EpiWin E{ws, p.in[5], SSQ}; pg8::gemm_phase<false>(lds, g, S, E); }
      { S.init(256, 2, gridDim.x, blockIdx.x, 2); EpiV<0> E{ws, SSQ}; pg8::gemm_phase<true>(lds, g, S, E); }
      if (gw < 8) { const int o = gw * 64 + lane; const float* pp = (const float*)(ws + OFF_BIASP) + (o >> 8) * 64 * 256 + (o & 255); float a = 0.f;
#pragma unroll 8
          for (int q = 0; q < 64; ++q) a += pp[q * 256];
          ((float*)(ws + OFF_BIAS1))[o] = a; } }
    grid.sync();
    { pg8::Gemm g{(const char*)ws + OFF_BRA, (const char*)ws + OFF_W1, 2048, 0, 1, 32 * MiB}; S.init(64, 2, gridDim.x, blockIdx.x); EpiCmp1 E{ws}; pg8::gemm_phase<false>(lds, g, S, E); }
    grid.sync();
    phase_cmp2(ws, gw, NGW);
    grid.sync();
    phaseA_attn(ws, lds, gw, NGW);
    grid.sync();
    { pg8::Gemm g{(const char*)ws + OFF_O, (const char*)ws + OFF_WOUTA, 1024, 1024, 0, 0}; S.init(256, 4, gridDim.x, blockIdx.x); EpiResid<0> E{x_in, ws + OFF_H, SSQ + 16 * T_TOK}; pg8::gemm_phase<false>(lds, g, S, E); }
    grid.sync();
    { pg8::Gemm g{(const char*)ws + OFF_H, (const char*)ws + OFF_WUP0, 1024, 1024, 0, 0}; S.init(256, 22, gridDim.x, blockIdx.x); EpiSwiglu E{ws + OFF_ACT, SSQ + 16 * T_TOK}; pg8::gemm_phase<false>(lds, g, S, E); }
    grid.sync();
    { pg8::Gemm g{(const char*)ws + OFF_ACT, (const char*)ws + OFF_WDN0, 2816, 2816, 0, 0}; S.init(256, 4, gridDim.x, blockIdx.x); EpiResid<1> E{x_in, ws + OFF_H, SSQ + 32 * T_TOK}; pg8::gemm_phase<false>(lds, g, S, E); }
    grid.sync();
    { pg8::Gemm g{(const char*)ws + OFF_H, (const char*)ws + OFF_WQKVB, 1024, 1024, 0, 0};
      { S.init(256, 15, gridDim.x, blockIdx.x, 3); EpiQKVB E{ws, SSQ + 32 * T_TOK}; pg8::gemm_phase<false>(lds, g, S, E); }
      { S.init(256, 3, gridDim.x, blockIdx.x, 4); EpiV<1> E{ws, SSQ + 32 * T_TOK}; pg8::gemm_phase<true>(lds, g, S, E); } }
    grid.sync();
    phaseB_attn(ws, lds, gw, NGW);
    grid.sync();
    { pg8::Gemm g{(const char*)ws + OFF_O, (const char*)ws + OFF_WOUTB, 1024, 1024, 0, 0}; S.init(256, 4, gridDim.x, blockIdx.x); EpiResid<1> E{x_in, ws + OFF_H, SSQ + 48 * T_TOK}; pg8::gemm_phase<false>(lds, g, S, E); }
    grid.sync();
    { pg8::Gemm g{(const char*)ws + OFF_H, (const char*)ws + OFF_WUP1, 1024, 1024, 0, 0}; S.init(256, 22, gridDim.x, blockIdx.x); EpiSwiglu E{ws + OFF_ACT, SSQ + 48 * T_TOK}; pg8::gemm_phase<false>(lds, g, S, E); }
    grid.sync();
    { pg8::Gemm g{(const char*)ws + OFF_ACT, (const char*)ws + OFF_WDN1, 2816, 2816, 0, 0}; S.init(256, 4, gridDim.x, blockIdx.x); EpiResid<2> E{x_in, ws + OFF_H, SSQ}; pg8::gemm_phase<false>(lds, g, S, E); }
    grid.sync();
    final_norm_rows((const bf16_t*)(ws + OFF_H), X, p.in[19], gw, NGW);
}

extern "C" void kernel_launch(void* const* d_in, const int* in_sizes, int n_in, void* d_out, int out_size, void* d_ws, size_t ws_size, hipStream_t stream) {
    static int grid_blocks = 0;
    if (grid_blocks == 0) {
        if (n_in != 20 || out_size != T_TOK * DM || ws_size < WS_NEED) { fprintf(stderr, "kernel_launch: unexpected shapes (n_in %d out %d ws %zu)\n", n_in, out_size, ws_size); grid_blocks = -1; return; }
        int dev = 0, cus = 0, per_cu = 0;
        hipGetDevice(&dev); hipDeviceGetAttribute(&cus, hipDeviceAttributeMultiprocessorCount, dev);
        if (hipFuncSetAttribute((const void*)yoco_mega, hipFuncAttributeMaxDynamicSharedMemorySize, LDS_TOTAL) != hipSuccess) { fprintf(stderr, "kernel_launch: hipFuncSetAttribute failed\n"); grid_blocks = -1; return; }
        if (hipOccupancyMaxActiveBlocksPerMultiprocessor(&per_cu, (const void*)yoco_mega, 512, LDS_TOTAL) != hipSuccess || per_cu < 1) { fprintf(stderr, "kernel_launch: occupancy query gave %d\n", per_cu); per_cu = 1; }
        (void)hipGetLastError();
        grid_blocks = cus * 1;
    }
    if (grid_blocks < 0) return;
    Params p{};
    for (int i = 0; i < 20; ++i) p.in[i] = (const float*)d_in[i];
    p.out = (float*)d_out; p.ws = (unsigned char*)d_ws;
    void* args[] = {&p};
    hipError_t e = hipLaunchCooperativeKernel((const void*)yoco_mega, dim3(grid_blocks), dim3(512), args, LDS_TOTAL, stream);
    if (e != hipSuccess) fprintf(stderr, "cooperative launch failed: %s (grid %d)\n", hipGetErrorString(e), grid_blocks);
}
```

```cpp
#include <hip/hip_runtime.h>
#include <hip/hip_cooperative_groups.h>
#include <cstdio>
namespace cg = cooperative_groups;

#define LAS __attribute__((address_space(3)))
typedef unsigned short bf16_t;
typedef short bf16x8 __attribute__((ext_vector_type(8)));
typedef float f32x4 __attribute__((ext_vector_type(4)));
typedef float f32x16 __attribute__((ext_vector_type(16)));
typedef unsigned u32x4 __attribute__((ext_vector_type(4)));
typedef unsigned u32x2 __attribute__((ext_vector_type(2)));
typedef unsigned long long u64;

constexpr int T_TOK = 65536, DM = 1024, SEQ = 2048, FFH = 2816;
constexpr size_t MiB = 1ull << 20;
constexpr size_t OFF_WIN = 0, OFF_WOUTA = 6 * MiB, OFF_WUP0 = 8 * MiB, OFF_WUP1 = 19 * MiB, OFF_WDN0 = 30 * MiB, OFF_WDN1 = 36 * MiB,
                 OFF_WQKVB = 42 * MiB, OFF_WOUTB = 51 * MiB, OFF_W1 = 53 * MiB  , OFF_W2 = 55 * MiB  ,
                 OFF_BIASP = 55 * MiB + 128 * 1024  , OFF_BIAS1 = 55 * MiB + 512 * 1024  , OFF_XBAR = 55 * MiB + 768 * 1024  , OFF_KCMP = 56 * MiB, OFF_VCMPT = 58 * MiB, OFF_GATE = 60 * MiB,
                 OFF_SSQ = 330 * MiB + 600 * MiB  , OFF_H = 74 * MiB,
                 OFF_O = 202 * MiB, OFF_BIG = 330 * MiB, WS_NEED = 1024 * MiB;
constexpr size_t OFF_QA = OFF_BIG, OFF_BRA = OFF_BIG + 128 * MiB  , OFF_ACT = OFF_BIG,
                 OFF_QB = OFF_BIG, OFF_KVB = OFF_BIG + 384 * MiB  , OFF_G1 = OFF_O;
constexpr int LDS_STAGE = 131072, LDS_NEG = 132608  , LDS_LUT = 133120, LDS_BIAS = LDS_LUT + 2048, LDS_XB = LDS_BIAS + 2048  , LDS_RS = LDS_XB + 16  , LDS_TOTAL = LDS_RS + 8192;
constexpr int STAGGER = 0;
constexpr float LOG2E = 1.4426950408889634f;
constexpr float SC2 = 0.125f * LOG2E;

struct Params { const float* in[20]; float* out; unsigned char* ws; };

__device__ __forceinline__ unsigned cvt_pk_bf16(float lo, float hi) { unsigned r; asm volatile("v_cvt_pk_bf16_f32 %0, %1, %2" : "=v"(r) : "v"(lo), "v"(hi)); return r; }
__device__ __forceinline__ bf16_t f2bf(float f) { return (bf16_t)(cvt_pk_bf16(f, 0.f) & 0xffffu); }
__device__ __forceinline__ u32x4 pack8(f32x4 a, f32x4 b) { u32x4 o; o.x = cvt_pk_bf16(a[0], a[1]); o.y = cvt_pk_bf16(a[2], a[3]); o.z = cvt_pk_bf16(b[0], b[1]); o.w = cvt_pk_bf16(b[2], b[3]); return o; }
__device__ __forceinline__ float fexp2(float x) { return __builtin_amdgcn_exp2f(x); }
__device__ __forceinline__ float frcp(float x) { return __builtin_amdgcn_rcpf(x); }
__device__ __forceinline__ float sigmoidf_(float x) { return frcp(1.f + fexp2(-x * LOG2E)); }
__device__ __forceinline__ float wave_sum(float v) {
#pragma unroll
    for (int o = 1; o < 64; o <<= 1) v += __shfl_xor(v, o);
    return v;
}
__device__ __forceinline__ f32x16 mfma32(bf16x8 a, bf16x8 b, f32x16 c) { return __builtin_amdgcn_mfma_f32_32x32x16_bf16(a, b, c, 0, 0, 0); }
#define LDS_WAIT() asm volatile("s_waitcnt lgkmcnt(0)" ::: "memory")

#define XB_TMO      128
#define XB_XCNT(j)  (256  + 64 * (j))
#define XB_XSUB(j)  (1280 + 64 * (j))
#define XB_XGEN(j)  (2304 + 64 * (j))
#define XB_TOP      3328
#define XB_TOPGEN   3392
#define XCD_BAR_WORDS 3456
#define XB_SPIN_CAP (1u << 18)
__device__ __forceinline__ unsigned xb_ld(unsigned* p)              { return __hip_atomic_load(p, __ATOMIC_RELAXED, __HIP_MEMORY_SCOPE_AGENT); }
__device__ __forceinline__ unsigned xb_add(unsigned* p, unsigned v) { return __hip_atomic_fetch_add(p, v, __ATOMIC_RELAXED, __HIP_MEMORY_SCOPE_AGENT); }
__device__ __forceinline__ unsigned xb_xcc_id() { return (unsigned)__builtin_amdgcn_s_getreg((3 << 11) | 20) & 0xFu; }
#define XB_SPIN(cond, bar) do { unsigned _sp = 0; while (cond) { __builtin_amdgcn_s_sleep(1); \
    if ((++_sp & 255u) == 0u) { if (xb_ld(&(bar)[XB_TMO])) break; if (_sp > XB_SPIN_CAP) { atomicAdd(&(bar)[XB_TMO], 1u); break; } } } } while (0)
struct XcdBarrier { unsigned* bar; unsigned x; volatile LAS unsigned* st; };
__device__ __forceinline__ XcdBarrier xcd_barrier_post(unsigned* bar, volatile LAS unsigned* st) {
    XcdBarrier b; b.bar = bar; b.x = xb_xcc_id(); b.st = st;
    if (threadIdx.x == 0) (void)xb_add(&bar[XB_XCNT(b.x)], 1u);
    return b;
}
__device__ __forceinline__ void xcd_barrier_complete(unsigned* bar, unsigned x, unsigned& nloc, unsigned& nx) {
    const unsigned G = gridDim.x * gridDim.y * gridDim.z;
    unsigned sum, cnt, mine, sp = 0u;
    for (;;) {
        sum = 0u; cnt = 0u; mine = 0u;
#pragma unroll
        for (unsigned j = 0; j < 16; ++j) { const unsigned c = xb_ld(&bar[XB_XCNT(j)]); sum += c; cnt += (c > 0u) ? 1u : 0u; mine = (j == x) ? c : mine; }
        if (sum == G) break;
        __builtin_amdgcn_s_sleep(1);
        if ((++sp & 255u) == 0u) { if (xb_ld(&bar[XB_TMO])) break; if (sp > XB_SPIN_CAP) { atomicAdd(&bar[XB_TMO], 1u); break; } }
    }
    nloc = mine > 0u ? mine : 1u; nx = cnt > 0u ? cnt : 1u;
}
__device__ __forceinline__ void xcd_barrier(const XcdBarrier& b) {
    asm volatile("s_waitcnt vmcnt(0)" ::: "memory");
    __syncthreads();
    if (threadIdx.x == 0) {
        unsigned* bar = b.bar;
        __builtin_amdgcn_s_waitcnt(0);
        unsigned nloc = b.st[0], nx = b.st[1];
        if (nloc == 0u) { xcd_barrier_complete(bar, b.x, nloc, nx); b.st[0] = nloc; b.st[1] = nx; }
        const unsigned old = xb_add(&bar[XB_XSUB(b.x)], 1u);
        const unsigned gen = old / nloc;
        if (old + 1u == (gen + 1u) * nloc) {
            __builtin_amdgcn_fence(__ATOMIC_RELEASE, "agent");
            asm volatile("s_waitcnt vmcnt(0)" ::: "memory");
            const unsigned og = xb_add(&bar[XB_TOP], 1u);
            const unsigned tg = og / nx;
            if (og + 1u == (tg + 1u) * nx) xb_add(&bar[XB_TOPGEN], 1u);
            else XB_SPIN(xb_ld(&bar[XB_TOPGEN]) == tg, bar);
            __builtin_amdgcn_fence(__ATOMIC_ACQUIRE, "agent");
            xb_add(&bar[XB_XGEN(b.x)], 1u);
            asm volatile("s_waitcnt vmcnt(0)" ::: "memory");
        } else {
            XB_SPIN(xb_ld(&bar[XB_XGEN(b.x)]) == gen, bar);
            __builtin_amdgcn_fence(__ATOMIC_ACQUIRE, "agent");
            asm volatile("s_waitcnt vmcnt(0)" ::: "memory");
        }
    }
    __syncthreads();
}

namespace pg8 {
constexpr int BM = 256, BK = 64, HALF = 128, HTB = HALF * BK * 2, NXCD = 8, WGM = 8;
__device__ __forceinline__ int lds_byte(int r, int c) { const int st = (r >> 4) * 2 + (c >> 5), rr = r & 15, cc = c & 31, ob = rr * 64 + cc * 2; return st * 1024 + (ob ^ (((ob >> 9) & 1) << 5)); }
__device__ __forceinline__ void stage_rc(int b, int& R, int& C) { const int st = b / 1024, sb = b % 1024, swz = sb ^ (((sb >> 9) & 1) << 5); R = (st >> 1) * 16 + swz / 64; C = (st & 1) * 32 + (swz % 64) / 2; }
__device__ __forceinline__ int perm32(int rho) { const int n = rho >> 4, i = rho & 15; return 8 * (i >> 2) + 4 * n + (i & 3); }
struct Unit { int pm, pn; };
struct Gemm { const char* A; const char* Bt; int K; int lda; int amode; size_t a_pn_step; };
struct StaticOrder {
    int nM, nN, nwg, G, c, map;
    __device__ void init(int nM_, int nN_, int G_, int c_, int map_ = 0) { nM = nM_; nN = nN_; nwg = nM * nN; G = G_; c = c_; map = map_; }
    __device__ bool next(int i, Unit& u) const {
        const long L = (long)i * G + c; if (L >= nwg) return false;
        int wgid = (int)L; { const int q = nwg / NXCD, r = nwg % NXCD, xcd = wgid % NXCD, off = wgid / NXCD; wgid = (xcd < r ? xcd * (q + 1) : r * (q + 1) + (xcd - r) * q) + off; }
        const int nig = WGM * nN, gid = wgid / nig, fm = gid * WGM, gsz = (nM - fm) < WGM ? (nM - fm) : WGM;
        u.pm = fm + ((wgid % nig) % gsz); int pn = (wgid % nig) / gsz;
        if (map == 1) pn = pn < 7 ? pn : (pn == 7 ? 8 : 10); else if (map == 2) pn = 7 + 2 * pn; else if (map == 3) pn = pn < 12 ? pn : 12 + 2 * (pn - 12); else if (map == 4) pn = 13 + 2 * pn;
        u.pn = pn; return true;
    }
};

template <bool SWAP = false, class Epi>
__device__ __forceinline__ void gemm_phase(LAS unsigned char* lds, const Gemm g, const StaticOrder& S, const Epi& E, int stagger = 0, const float* ssq = nullptr) {
    if (stagger > 0) { const unsigned long long t0 = __builtin_amdgcn_s_memrealtime(), dl = (unsigned long long)((blockIdx.x >> 3) * stagger);
        while (__builtin_amdgcn_s_memrealtime() - t0 < dl) __builtin_amdgcn_s_sleep(4); }
    int tid = threadIdx.x; asm volatile("" : "+v"(tid));
    const int wid = __builtin_amdgcn_readfirstlane(tid >> 6), lane = tid & 63, wr = wid >> 2, wc = wid & 3, fr = lane & 15, fq = lane >> 4;
    const int K = g.K, nt = K / BK;
    unsigned voffA[2], voffB[2];
#pragma unroll
    for (int i = 0; i < 2; ++i) { int R, C; stage_rc(tid * 16 + i * 8192, R, C); const int Rb = SWAP ? R : (R & ~31) + perm32(R & 31);
        voffA[i] = g.amode ? (unsigned)((R >> 2) * 8192 + (R & 3) * 128 + C * 2) : (unsigned)(R * g.lda + C) * 2u;
        voffB[i] = (unsigned)(Rb * K + C) * 2u; }
    const size_t kstepA = g.amode ? 512 : (size_t)(BK * 2), kstepB = (size_t)(BK * 2);
    const size_t hstepA = g.amode ? (size_t)262144 : (size_t)HALF * g.lda * 2, hstepB = (size_t)HALF * K * 2;
    const size_t tstepA = 2 * hstepA, tstepB = 2 * hstepB;
    const unsigned ldsw = (unsigned)wid * 1024u;
    const int aoff = lds_byte(wr * 64 + fr, fq * 8), boff = lds_byte(wc * 32 + fr, fq * 8);
#define PG8_SA(b, h) (((b) * 2 + (h)) * HTB)
#define PG8_SB(b, h) ((4 + (b) * 2 + (h)) * HTB)
#define PG8_STAGE(bufoff, gbase, voff) do { _Pragma("unroll") for (int _i = 0; _i < 2; ++_i) \
        __builtin_amdgcn_global_load_lds((const unsigned*)((const char*)(gbase) + (voff)[_i]), (LAS unsigned*)(lds + (bufoff) + ldsw + _i * 8192), 16, 0, 0); } while (0)
#define PG8_LDA(dst, b, h) do { _Pragma("unroll") for (int m = 0; m < 4; ++m) _Pragma("unroll") for (int k = 0; k < 2; ++k) dst[m][k] = *(const LAS bf16x8*)(lds + PG8_SA(b, h) + aoff + m * 2048 + k * 1024); } while (0)
#define PG8_LDB(dst, b, h) do { _Pragma("unroll") for (int n = 0; n < 2; ++n) _Pragma("unroll") for (int k = 0; k < 2; ++k) dst[n][k] = *(const LAS bf16x8*)(lds + PG8_SB(b, h) + boff + n * 2048 + k * 1024); } while (0)
#define PG8_MMA(ai, bj, At, Bt) do { __builtin_amdgcn_s_setprio(1); _Pragma("unroll") for (int m = 0; m < 4; ++m) _Pragma("unroll") for (int n = 0; n < 2; ++n) _Pragma("unroll") for (int k = 0; k < 2; ++k) \
        acc[ai][bj][m][n] = SWAP ? __builtin_amdgcn_mfma_f32_16x16x32_bf16(At[m][k], Bt[n][k], acc[ai][bj][m][n], 0, 0, 0) : __builtin_amdgcn_mfma_f32_16x16x32_bf16(Bt[n][k], At[m][k], acc[ai][bj][m][n], 0, 0, 0); __builtin_amdgcn_s_setprio(0); } while (0)
#define PG8_WAIT_V(n) asm volatile("s_waitcnt vmcnt(" #n ")" ::: "memory")
#define PG8_WAIT_L(n) asm volatile("s_waitcnt lgkmcnt(" #n ")" ::: "memory")
#define PG8_BAR __builtin_amdgcn_s_barrier()
#define PG8_SCHED __builtin_amdgcn_sched_barrier(0)
    Unit cur, nxt; int ui = 0, slot = 0;
    if (!S.next(0, cur)) return;
    if (ssq) {
        Unit u; int sl = 0, ppm = cur.pm;
        for (int i = 0; S.next(i, u); ++i) { if (i == 0 || u.pm != ppm) { if (i) ++sl; ppm = u.pm;
                const unsigned char* sp = (const unsigned char*)(ssq + ((size_t)u.pm * 256 + (tid >> 1)) * 16) + (tid & 1) * 32;
                const f32x4 a = *(const f32x4*)sp, b = *(const f32x4*)(sp + 16); float v = ((a[0] + a[1]) + (a[2] + a[3])) + ((b[0] + b[1]) + (b[2] + b[3])); v += __shfl_xor(v, 1);
                if (!(tid & 1)) ((LAS float*)(lds + LDS_RS))[(sl & 7) * 256 + (tid >> 1)] = 1.f / sqrtf(v * (1.f / DM) + 1e-6f); } }
        __syncthreads(); }
    f32x4 acc[2][2][4][2];
#pragma unroll
    for (int a = 0; a < 2; ++a)
#pragma unroll
        for (int b = 0; b < 2; ++b)
#pragma unroll
            for (int m = 0; m < 4; ++m)
#pragma unroll
                for (int n = 0; n < 2; ++n) acc[a][b][m][n] = (f32x4){0.f, 0.f, 0.f, 0.f};
    bf16x8 At[4][2], B0[2][2], B1[2][2];
    const char* cA = g.A + (size_t)cur.pm * tstepA + (size_t)cur.pn * g.a_pn_step; const char* cB = g.Bt + (size_t)cur.pn * tstepB;
    PG8_STAGE(PG8_SB(0, 0), cB, voffB); PG8_STAGE(PG8_SA(0, 0), cA, voffA); PG8_STAGE(PG8_SB(0, 1), cB + hstepB, voffB); PG8_STAGE(PG8_SA(0, 1), cA + hstepA, voffA);
    if (wr == 1) PG8_BAR;
    PG8_WAIT_V(4); PG8_BAR;
    PG8_STAGE(PG8_SB(1, 0), cB + kstepB, voffB); PG8_STAGE(PG8_SA(1, 0), cA + kstepA, voffA); PG8_STAGE(PG8_SB(1, 1), cB + hstepB + kstepB, voffB);
    PG8_WAIT_V(6); PG8_BAR;
    for (;;) {
        const bool has_next = S.next(ui + 1, nxt);
        const char* nA = has_next ? g.A + (size_t)nxt.pm * tstepA + (size_t)nxt.pn * g.a_pn_step : cA; const char* nB = has_next ? g.Bt + (size_t)nxt.pn * tstepB : cB;
        for (int t = 0; t < nt; t += 2) {
            const bool last = (t == nt - 2);
            const char* a1 = cA + (size_t)(t + 1) * kstepA;
            const char* a2 = last ? nA : cA + (size_t)(t + 2) * kstepA; const char* b2 = last ? nB : cB + (size_t)(t + 2) * kstepB;
            const char* a3 = a2 + kstepA; const char* b3 = b2 + kstepB;
            PG8_LDB(B0, 0, 0); PG8_SCHED; PG8_LDA(At, 0, 0); PG8_STAGE(PG8_SA(1, 1), a1 + hstepA, voffA);
            PG8_WAIT_L(8); PG8_BAR; PG8_WAIT_L(0); PG8_MMA(0, 0, At, B0); PG8_BAR; PG8_SCHED;
            PG8_LDB(B1, 0, 1); PG8_STAGE(PG8_SB(0, 0), b2, voffB);
            PG8_BAR; PG8_WAIT_L(0); PG8_MMA(0, 1, At, B1); PG8_BAR;
            PG8_LDA(At, 0, 1); PG8_STAGE(PG8_SA(0, 0), a2, voffA);
            PG8_BAR; PG8_WAIT_L(0); PG8_MMA(1, 0, At, B0); PG8_BAR; PG8_SCHED;
            PG8_STAGE(PG8_SB(0, 1), b2 + hstepB, voffB);
            PG8_WAIT_V(6); PG8_BAR; PG8_MMA(1, 1, At, B1); PG8_BAR;
            PG8_LDB(B0, 1, 0); PG8_SCHED; PG8_LDA(At, 1, 0); PG8_STAGE(PG8_SA(0, 1), a2 + hstepA, voffA);
            PG8_WAIT_L(8); PG8_BAR; PG8_WAIT_L(0); PG8_MMA(0, 0, At, B0); PG8_BAR; PG8_SCHED;
            PG8_LDB(B1, 1, 1); PG8_STAGE(PG8_SB(1, 0), b3, voffB);
            PG8_BAR; PG8_WAIT_L(0); PG8_MMA(0, 1, At, B1); PG8_BAR;
            PG8_LDA(At, 1, 1); PG8_STAGE(PG8_SA(1, 0), a3, voffA);
            PG8_BAR; PG8_WAIT_L(0); PG8_MMA(1, 0, At, B0); PG8_BAR; PG8_SCHED;
            PG8_STAGE(PG8_SB(1, 1), b3 + hstepB, voffB);
            PG8_WAIT_V(6); PG8_BAR; PG8_MMA(1, 1, At, B1); PG8_BAR;
        }
        E(acc, cur, wr, wc, fr, fq, (const LAS float*)(lds + LDS_RS) + (slot & 7) * 256);
        if (!has_next) break;
#pragma unroll
        for (int a = 0; a < 2; ++a)
#pragma unroll
            for (int b = 0; b < 2; ++b)
#pragma unroll
                for (int m = 0; m < 4; ++m)
#pragma unroll
                    for (int n = 0; n < 2; ++n) acc[a][b][m][n] = (f32x4){0.f, 0.f, 0.f, 0.f};
        slot += (nxt.pm != cur.pm) ? 1 : 0; cur = nxt; cA = nA; cB = nB; ++ui;
    }
    PG8_WAIT_V(0);
    if (wr == 0) PG8_BAR;
    PG8_BAR;
#undef PG8_SA
#undef PG8_SB
#undef PG8_STAGE
#undef PG8_LDA
#undef PG8_LDB
#undef PG8_MMA
#undef PG8_WAIT_V
#undef PG8_WAIT_L
#undef PG8_BAR
#undef PG8_SCHED
}
}
using pg8::Unit;
typedef f32x4 Acc[2][2][4][2];

#define OPAQUE(v) asm volatile("" : "+v"(v))
__device__ __forceinline__ void load_row_rs(float (&rv)[2], const unsigned char* sp, int wr, int fr, int fq);
__device__ __forceinline__ float row_rs(float ssq) { return 1.f / sqrtf(ssq * (1.f / DM) + 1e-6f); }
__device__ __forceinline__ float row_rs16(const unsigned char* p) { const f32x4 a = *(const f32x4*)p, b = *(const f32x4*)(p + 16), c = *(const f32x4*)(p + 32), d = *(const f32x4*)(p + 48);
    return row_rs(((a[0] + a[1]) + (a[2] + a[3])) + ((b[0] + b[1]) + (b[2] + b[3])) + ((c[0] + c[1]) + (c[2] + c[3])) + ((d[0] + d[1]) + (d[2] + d[3]))); }
__device__ __forceinline__ void load_row_rs(float (&rv)[2], const unsigned char* sp, int wr, int fr, int fq) {
    unsigned so = (unsigned)(wr * 64 + fq * 16 + fr) * 64u; OPAQUE(so);
    rv[0] = row_rs16(sp + so); rv[1] = row_rs16(sp + (so + 128u * 64u));
}
struct EpiWin {
    unsigned char* ws; const float* b_gate; const float* ssq;
    __device__ __forceinline__ void operator()(const Acc& acc, const Unit& u, int wr, int wc, int fr, int fq, const LAS float* rsl) const {
        const int pn = u.pn; unsigned rl = wr * 64 + fr, cw = wc * 32 + 8 * fq; OPAQUE(rl); OPAQUE(cw); const size_t rowt = (size_t)u.pm * 256;
        float rs[2][4];
#pragma unroll
        for (int ai = 0; ai < 2; ++ai)
#pragma unroll
            for (int m = 0; m < 4; ++m) rs[ai][m] = rsl[ai * 128 + wr * 64 + m * 16 + fr];
        if (pn < 4) {
            unsigned char* base = ws + OFF_QA + (rowt * 1024 + pn * 256) * 2; unsigned lo = (rl * 1024 + cw) * 2; OPAQUE(lo);
#pragma unroll
            for (int ai = 0; ai < 2; ++ai)
#pragma unroll
                for (int m = 0; m < 4; ++m)
#pragma unroll
                    for (int bj = 0; bj < 2; ++bj) *(u32x4*)(base + (lo + (unsigned)(((ai * 128 + m * 16) * 1024 + bj * 128) * 2))) = pack8(acc[ai][bj][m][0] * rs[ai][m], acc[ai][bj][m][1] * rs[ai][m]);
        } else if (pn < 10) {
            const int br = pn - 4; const int b = u.pm >> 3, tb = (u.pm & 7) * 8;
            if (br == 2 || br == 4) {
                unsigned char* base = ws + OFF_BRA + (size_t)br * 32 * MiB + ((size_t)b * 4 * 2048 * 64 + (size_t)tb * 2048) * 2;
                unsigned lo = ((cw >> 6) * 2048 * 64 + ((wr * 8 + ((cw & 63) >> 4)) * 64 + ((cw >> 3) & 1) * 32 + fr) * 8) * 2; OPAQUE(lo);
#pragma unroll
                for (int ai = 0; ai < 2; ++ai)
#pragma unroll
                    for (int m = 0; m < 4; ++m)
#pragma unroll
                        for (int bj = 0; bj < 2; ++bj) *(u32x4*)(base + (lo + (unsigned)((bj * 2 * 2048 * 64 + ((ai * 4 + (m >> 1)) * 4 * 64 + (m & 1) * 16) * 8) * 2))) = pack8(acc[ai][bj][m][0] * rs[ai][m], acc[ai][bj][m][1] * rs[ai][m]);
            } else {
                unsigned char* base = ws + OFF_BRA + (size_t)br * 32 * MiB + rowt * 256 * 2; unsigned lo = (rl * 256 + cw) * 2; OPAQUE(lo);
#pragma unroll
                for (int ai = 0; ai < 2; ++ai)
#pragma unroll
                    for (int m = 0; m < 4; ++m)
#pragma unroll
                        for (int bj = 0; bj < 2; ++bj) *(u32x4*)(base + (lo + (unsigned)(((ai * 128 + m * 16) * 256 + bj * 128) * 2))) = pack8(acc[ai][bj][m][0] * rs[ai][m], acc[ai][bj][m][1] * rs[ai][m]);
            }
        } else {
            if (cw < 48) {
                unsigned char* base = ws + OFF_GATE + rowt * 48 * 4; unsigned lo = (rl * 48 + cw) * 4; OPAQUE(lo);
                float bg[8];
#pragma unroll
                for (int e = 0; e < 8; ++e) bg[e] = (cw + e < 48) ? b_gate[cw + e] : 0.f;
#pragma unroll
                for (int ai = 0; ai < 2; ++ai)
#pragma unroll
                    for (int m = 0; m < 4; ++m) { const f32x4 v0 = acc[ai][0][m][0] * rs[ai][m], v1 = acc[ai][0][m][1] * rs[ai][m];
#pragma unroll
                        for (int e = 0; e < 4; ++e) { if (cw + e < 48) *(float*)(base + (lo + (unsigned)(((ai * 128 + m * 16) * 48 + e) * 4))) = sigmoidf_(v0[e] + bg[e]);
                            if (cw + 4 + e < 48) *(float*)(base + (lo + (unsigned)(((ai * 128 + m * 16) * 48 + e + 4) * 4))) = sigmoidf_(v1[e] + bg[4 + e]); } }
            }
        }
    }
};
template <int LAYER>
struct EpiV {
    unsigned char* ws; const float* ssq;
    __device__ __forceinline__ void operator()(const Acc& acc, const Unit& u, int wr, int wc, int fr, int fq, const LAS float* rsl) const {
        const int pn = u.pn, b = u.pm >> 3; const size_t rowt = (size_t)u.pm * 256;
        const int idx = LAYER ? pn - 12 : 0, dsh = LAYER ? 2 * (idx >> 1) : 0, lsh = 11 - dsh;
        unsigned char* base = ws + (LAYER ? OFF_KVB + (size_t)idx * 32 * MiB : OFF_BRA + (size_t)(pn - 4) * 32 * MiB) + ((size_t)b * 4 * 2048 * 64) * 2;
        unsigned lo = ((wc >> 1) * 2048 * 64 + ((wc & 1) * 128 + fr) * 8) * 2; OPAQUE(lo);
        f32x4 rsv[2][4];
#pragma unroll
        for (int ai = 0; ai < 2; ++ai)
#pragma unroll
            for (int m = 0; m < 4; ++m) rsv[ai][m] = *(const LAS f32x4*)(rsl + ai * 128 + wr * 64 + m * 16 + 4 * fq);
        if (dsh == 0) {
            const unsigned tb = (u.pm & 7) * 8;
            unsigned lk = (((tb + wr * 2) * 4) * 64 + (fq & 1) * 32) * 16 + (fq >> 1) * 8; OPAQUE(lk);
#pragma unroll
            for (int ai = 0; ai < 2; ++ai)
#pragma unroll
                for (int m = 0; m < 4; ++m) { const f32x4 rs = rsv[ai][m];
#pragma unroll
                    for (int bj = 0; bj < 2; ++bj)
#pragma unroll
                        for (int n = 0; n < 2; ++n) { const f32x4 v = acc[ai][bj][m][n] * rs; u32x2 w; w.x = cvt_pk_bf16(v[0], v[1]); w.y = cvt_pk_bf16(v[2], v[3]);
                            *(u32x2*)(base + (lo + lk + (unsigned)((bj * 2 * 2048 * 64 + ((((ai * 4 + (m >> 1)) * 4 + (m & 1)) * 64) + 16 * n) * 8) * 2))) = w; }
                    __builtin_amdgcn_sched_barrier(0); }
        } else {
            const unsigned sb = ((u.pm & 7) * 256) >> dsh; unsigned slb = wr * 64 + 4 * fq; OPAQUE(slb);
#pragma unroll
            for (int ai = 0; ai < 2; ++ai)
#pragma unroll
                for (int m = 0; m < 4; ++m) {
#pragma unroll
                    for (int j = 0; j < 4; ++j) { const float rs = rsv[ai][m][j]; const unsigned sl = slb + (unsigned)(ai * 128 + m * 16 + j);
                        const unsigned p = ((sl & ((1u << dsh) - 1u)) << lsh) + (sl >> dsh) + sb, kk = p & 31u, k16 = kk & 15u;
                        const unsigned po = (((p >> 5) * 4 + (kk >> 4)) * 64 + ((k16 >> 2) & 1u) * 32) * 16 + (((k16 >> 3) << 2) + (k16 & 3u)) * 2;
#pragma unroll
                        for (int bj = 0; bj < 2; ++bj)
#pragma unroll
                            for (int n = 0; n < 2; ++n) *(bf16_t*)(base + (lo + po + (unsigned)((bj * 2 * 2048 * 64 + 16 * n * 8) * 2))) = f2bf(acc[ai][bj][m][n][j] * rs); }
                    __builtin_amdgcn_sched_barrier(0); }
        }
    }
};
struct EpiQKVB {
    unsigned char* ws; const float* ssq;
    __device__ __forceinline__ void operator()(const Acc& acc, const Unit& u, int wr, int wc, int fr, int fq, const LAS float* rsl) const {
        const int pn = u.pn; unsigned rl = wr * 64 + fr, cw = wc * 32 + 8 * fq; OPAQUE(rl); OPAQUE(cw); const size_t rowt = (size_t)u.pm * 256;
        float rs[2][4];
#pragma unroll
        for (int ai = 0; ai < 2; ++ai)
#pragma unroll
            for (int m = 0; m < 4; ++m) rs[ai][m] = rsl[ai * 128 + wr * 64 + m * 16 + fr];
        if (pn < 12) {
            unsigned char* base = ws + OFF_QB + (rowt * 3072 + pn * 256) * 2; unsigned lo = (rl * 3072 + cw) * 2; OPAQUE(lo);
#pragma unroll
            for (int ai = 0; ai < 2; ++ai)
#pragma unroll
                for (int m = 0; m < 4; ++m)
#pragma unroll
                    for (int bj = 0; bj < 2; ++bj) *(u32x4*)(base + (lo + (unsigned)(((ai * 128 + m * 16) * 3072 + bj * 128) * 2))) = pack8(acc[ai][bj][m][0] * rs[ai][m], acc[ai][bj][m][1] * rs[ai][m]);
        } else {
            const int idx = pn - 12, gi = idx >> 1, dsh = 2 * gi, lsh = 11 - dsh, b = u.pm >> 3, sb = ((u.pm & 7) * 256) >> dsh;
            unsigned posl = ((rl & ((1u << dsh) - 1u)) << lsh) + (rl >> dsh) + sb; OPAQUE(posl);
            unsigned char* base = ws + OFF_KVB + (size_t)idx * 32 * MiB + ((size_t)b * 4 * 2048 * 64) * 2;
            unsigned lo = ((cw >> 6) * 2048 * 64 + (((cw & 63) >> 4) * 64 + ((cw >> 3) & 1) * 32) * 8) * 2; OPAQUE(lo);
#pragma unroll
            for (int ai = 0; ai < 2; ++ai)
#pragma unroll
                for (int m = 0; m < 4; ++m) { const unsigned p = posl + (unsigned)((ai * 128 + m * 16) >> dsh), po = ((p >> 5) * 256 + (p & 31u)) * 16;
#pragma unroll
                    for (int bj = 0; bj < 2; ++bj) *(u32x4*)(base + (lo + po + (unsigned)(bj * 2 * 2048 * 64 * 2))) = pack8(acc[ai][bj][m][0] * rs[ai][m], acc[ai][bj][m][1] * rs[ai][m]); }
        }
    }
};
__device__ __forceinline__ f32x4 bf_lo4(u32x4 w) { f32x4 r; r[0] = __uint_as_float(w.x << 16); r[1] = __uint_as_float(w.x & 0xffff0000u); r[2] = __uint_as_float(w.y << 16); r[3] = __uint_as_float(w.y & 0xffff0000u); return r; }
__device__ __forceinline__ f32x4 bf_hi4(u32x4 w) { f32x4 r; r[0] = __uint_as_float(w.z << 16); r[1] = __uint_as_float(w.z & 0xffff0000u); r[2] = __uint_as_float(w.w << 16); r[3] = __uint_as_float(w.w & 0xffff0000u); return r; }
template <int MODE>
struct EpiResid {
    const float* xin; unsigned char* hout; float* ssq;
    __device__ __forceinline__ void operator()(const Acc& acc, const Unit& u, int wr, int wc, int fr, int fq, const LAS float* rsl) const {
        unsigned rl = wr * 64 + fr, cw = wc * 32 + 8 * fq; OPAQUE(rl); OPAQUE(cw); const size_t t0 = ((size_t)u.pm * 256 * 1024 + u.pn * 256) * 2;
        const unsigned char* bi = (const unsigned char*)xin + 2 * t0; unsigned char* bh = hout + t0; unsigned lo = (rl * 1024 + cw) * 2; OPAQUE(lo);
        float* sq = ssq + ((size_t)u.pm * 256 + rl) * 16 + u.pn * 4 + wc;
#pragma unroll
        for (int ai = 0; ai < 2; ++ai) {
            f32x4 xa[4][2][2];
#pragma unroll
            for (int m = 0; m < 4; ++m)
#pragma unroll
                for (int bj = 0; bj < 2; ++bj) { const unsigned o = lo + (unsigned)(((ai * 128 + m * 16) * 1024 + bj * 128) * 2);
                    if (MODE == 0) { xa[m][bj][0] = *(const f32x4*)(bi + 2 * o); xa[m][bj][1] = *(const f32x4*)(bi + 2 * o + 16); }
                    else { const u32x4 w = *(const u32x4*)(bh + o); xa[m][bj][0] = bf_lo4(w); xa[m][bj][1] = bf_hi4(w); } }
            __builtin_amdgcn_sched_barrier(0);
#pragma unroll
            for (int m = 0; m < 4; ++m) { float q = 0.f;
#pragma unroll
                for (int bj = 0; bj < 2; ++bj) { const unsigned o = lo + (unsigned)(((ai * 128 + m * 16) * 1024 + bj * 128) * 2);
                    const u32x4 w = pack8(xa[m][bj][0] + acc[ai][bj][m][0], xa[m][bj][1] + acc[ai][bj][m][1]);
                    *(u32x4*)(bh + o) = w;
                    if (MODE != 2) { const f32x4 a = bf_lo4(w), c = bf_hi4(w); q += (a[0] * a[0] + a[1] * a[1]) + (a[2] * a[2] + a[3] * a[3]) + (c[0] * c[0] + c[1] * c[1]) + (c[2] * c[2] + c[3] * c[3]); } }
                if (MODE != 2) { q += __shfl_xor(q, 16); q += __shfl_xor(q, 32); if (fq == 0) sq[(ai * 128 + m * 16) * 16] = q; } }
        }
    }
};
struct EpiSwiglu {
    unsigned char* act; const float* ssq;
    __device__ __forceinline__ void operator()(const Acc& acc, const Unit& u, int wr, int wc, int fr, int fq, const LAS float* rsl) const {
        unsigned rl = wr * 64 + fr, cw = wc * 32 + 8 * fq; OPAQUE(rl); OPAQUE(cw); unsigned char* base = act + ((size_t)u.pm * 256 * FFH + u.pn * 128) * 2; unsigned lo = (rl * FFH + cw) * 2; OPAQUE(lo);
        float rsv[2][4];
#pragma unroll
        for (int ai = 0; ai < 2; ++ai)
#pragma unroll
            for (int m = 0; m < 4; ++m) rsv[ai][m] = rsl[ai * 128 + wr * 64 + m * 16 + fr];
#pragma unroll
        for (int ai = 0; ai < 2; ++ai)
#pragma unroll
            for (int m = 0; m < 4; ++m) { f32x4 h0, h1; const float rs = rsv[ai][m];
#pragma unroll
                for (int e = 0; e < 4; ++e) { const float a0 = acc[ai][0][m][0][e] * rs, a1 = acc[ai][0][m][1][e] * rs;
                    h0[e] = a0 * sigmoidf_(a0) * (acc[ai][1][m][0][e] * rs); h1[e] = a1 * sigmoidf_(a1) * (acc[ai][1][m][1][e] * rs); }
                *(u32x4*)(base + (lo + (unsigned)((ai * 128 + m * 16) * FFH * 2))) = pack8(h0, h1); }
    }
};
struct EpiCmp1 {
    unsigned char* ws;
    __device__ __forceinline__ void operator()(const Acc& acc, const Unit& u, int wr, int wc, int fr, int fq, const LAS float* rsl) const {
        const int kv = u.pn; unsigned rl = wr * 64 + fr, cw = wc * 32 + 8 * fq; OPAQUE(rl); OPAQUE(cw);
        unsigned char* base = ws + OFF_G1 + (((size_t)kv * 16384 + (size_t)u.pm * 256) * 256) * 2; unsigned lo = (rl * 256 + cw) * 2; OPAQUE(lo);
        const unsigned char* bp = ws + OFF_BIAS1 + (size_t)kv * 256 * 4; unsigned blo = cw * 4; OPAQUE(blo);
#pragma unroll
        for (int bj = 0; bj < 2; ++bj) {
            const f32x4 b0 = *(const f32x4*)(bp + (blo + (unsigned)(bj * 128 * 4))), b1 = *(const f32x4*)(bp + (blo + (unsigned)(bj * 128 * 4 + 16)));
#pragma unroll
            for (int ai = 0; ai < 2; ++ai)
#pragma unroll
                for (int m = 0; m < 4; ++m) { f32x4 h0, h1;
#pragma unroll
                    for (int e = 0; e < 4; ++e) {
                        const float x0 = acc[ai][bj][m][0][e] + b0[e], x1 = acc[ai][bj][m][1][e] + b1[e];
                        const float u0 = 0.7978845608028654f * (x0 + 0.044715f * x0 * x0 * x0), u1 = 0.7978845608028654f * (x1 + 0.044715f * x1 * x1 * x1);
                        h0[e] = x0 * sigmoidf_(2.f * u0); h1[e] = x1 * sigmoidf_(2.f * u1); }
                    *(u32x4*)(base + (lo + (unsigned)(((ai * 128 + m * 16) * 256 + bj * 128) * 2))) = pack8(h0, h1); }
        }
    }
};

__device__ __forceinline__ void conv_weight(const float* W, int K, int N, const float* gain, bf16_t* WT, int row_off, int mode, LAS float* scr, int gw, int NGW, int lane) {
    const int nnb = (N + 31) / 32, nitems = (K / 64) * nnb;
    for (int item = gw; item < nitems; item += NGW) {
        const int kb = item / nnb, nb = item % nnb, k0 = 64 * kb, n0 = 32 * nb;
#pragma unroll 8
        for (int i = 0; i < 32; ++i) { const int kk = 2 * i + (lane >> 5), n = n0 + (lane & 31);
            float v = (n < N) ? W[(size_t)(k0 + kk) * N + n] : 0.f; if (gain) v *= gain[k0 + kk]; scr[kk * 33 + (lane & 31)] = v; }
        LDS_WAIT();
        int dr0 = row_off + n0;
        if (mode == 1) dr0 = (n0 < FFH) ? ((n0 >> 7) * 256 + (n0 & 127)) : ((((n0 - FFH) >> 7) * 256) + 128 + ((n0 - FFH) & 127));
        const int c = lane & 7;
#pragma unroll
        for (int j = 0; j < 4; ++j) { const int nn = (lane >> 3) + 8 * j; const LAS float* s = scr + (8 * c) * 33 + nn;
            u32x4 o; o.x = cvt_pk_bf16(s[0 * 33], s[1 * 33]); o.y = cvt_pk_bf16(s[2 * 33], s[3 * 33]); o.z = cvt_pk_bf16(s[4 * 33], s[5 * 33]); o.w = cvt_pk_bf16(s[6 * 33], s[7 * 33]);
            if (n0 + nn < N) *(u32x4*)(WT + (size_t)(dr0 + nn) * K + k0 + 8 * c) = o; }
        LDS_WAIT();
    }
}
__device__ __forceinline__ void cast_rows(const float* x, bf16_t* h, float* ssq, int gw, int NGW, int lane) {
    for (int row = gw; row < T_TOK; row += NGW) {
        const f32x4* xr = (const f32x4*)(x + (size_t)row * DM) + lane; f32x4 v[4]; float s = 0.f;
#pragma unroll
        for (int j = 0; j < 4; ++j) { v[j] = xr[64 * j]; s += (v[j][0] * v[j][0] + v[j][1] * v[j][1]) + (v[j][2] * v[j][2] + v[j][3] * v[j][3]); }
        s = wave_sum(s);
        u32x2* o = (u32x2*)(h + (size_t)row * DM) + lane;
#pragma unroll
        for (int j = 0; j < 4; ++j) { u32x2 w; w.x = cvt_pk_bf16(v[j][0], v[j][1]); w.y = cvt_pk_bf16(v[j][2], v[j][3]); o[64 * j] = w; }
        if (lane < 16) ssq[(size_t)row * 16 + lane] = lane == 0 ? s : 0.f;
    }
}
__device__ __forceinline__ void final_norm_rows(const bf16_t* hsrc, float* out, const float* gain, int gw, int NGW) {
    const int lane = threadIdx.x & 63;
    f32x4 gv[4];
#pragma unroll
    for (int j = 0; j < 4; ++j) gv[j] = ((const f32x4*)gain)[lane + 64 * j];
    for (int row = gw; row < T_TOK; row += NGW) {
        const u32x2* hr = (const u32x2*)(hsrc + (size_t)row * DM) + lane; f32x4* xr = (f32x4*)(out + (size_t)row * DM) + lane; f32x4 v[4]; float s = 0.f;
#pragma unroll
        for (int j = 0; j < 4; ++j) { const u32x2 w = hr[64 * j]; v[j][0] = __uint_as_float(w.x << 16); v[j][1] = __uint_as_float(w.x & 0xffff0000u); v[j][2] = __uint_as_float(w.y << 16); v[j][3] = __uint_as_float(w.y & 0xffff0000u);
            s += (v[j][0] * v[j][0] + v[j][1] * v[j][1]) + (v[j][2] * v[j][2] + v[j][3] * v[j][3]); }
        const float r = 1.f / sqrtf(wave_sum(s) * (1.f / DM) + 1e-6f);
#pragma unroll
        for (int j = 0; j < 4; ++j) xr[64 * j] = v[j] * r * gv[j];
    }
}

struct SoftState { float l; f32x16 cin, o0, o1; };
struct KFrag { bf16x8 k0, k1, k2, k3; const char* vp; };
__device__ __forceinline__ bf16x8 ld_v8(const char* p) { const u64 lo = *(const u64*)p, hi = *(const u64*)(p + 16); u32x4 t; t.x = (unsigned)lo; t.y = (unsigned)(lo >> 32); t.z = (unsigned)hi; t.w = (unsigned)(hi >> 32); return __builtin_bit_cast(bf16x8, t); }
__device__ __forceinline__ bf16x8 pk_lo(const f32x16& p) { u32x4 t; t.x = cvt_pk_bf16(p[0], p[1]); t.y = cvt_pk_bf16(p[2], p[3]); t.z = cvt_pk_bf16(p[4], p[5]); t.w = cvt_pk_bf16(p[6], p[7]); return __builtin_bit_cast(bf16x8, t); }
__device__ __forceinline__ bf16x8 pk_hi(const f32x16& p) { u32x4 t; t.x = cvt_pk_bf16(p[8], p[9]); t.y = cvt_pk_bf16(p[10], p[11]); t.z = cvt_pk_bf16(p[12], p[13]); t.w = cvt_pk_bf16(p[14], p[15]); return __builtin_bit_cast(bf16x8, t); }
__device__ __forceinline__ void load_k(KFrag& f, const char* kp, const char* vp) { f.k0 = *(const bf16x8*)kp; f.k1 = *(const bf16x8*)(kp + 1024); f.k2 = *(const bf16x8*)(kp + 2048); f.k3 = *(const bf16x8*)(kp + 3072);
    f.vp = vp; }
__device__ __forceinline__ f32x16 tile_scores(const SoftState& st, const bf16x8 (&qf)[4], const KFrag& f, const LAS unsigned char* lds, unsigned vb, int dist0, int max_dist, bool masked) {
    f32x16 bv;
#pragma unroll
    for (int i = 0; i < 16; ++i) bv[i] = *(const LAS float*)(lds + vb + 4 * (27 - ((i & 3) + 8 * (i >> 2))));
    __builtin_amdgcn_sched_barrier(0);
    __builtin_amdgcn_s_setprio(1);
    f32x16 s = mfma32(f.k0, qf[0], st.cin); s = mfma32(f.k1, qf[1], s); s = mfma32(f.k2, qf[2], s); s = mfma32(f.k3, qf[3], s);
    __builtin_amdgcn_s_setprio(0);
    f32x16 t = s * SC2 + bv;
    if (masked) {
#pragma unroll
        for (int i = 0; i < 16; ++i) t[i] = ((unsigned)(dist0 - ((i & 3) + 8 * (i >> 2))) <= (unsigned)max_dist) ? t[i] : -__builtin_inff();
    }
    return t;
}
__device__ __forceinline__ float exp_sum(f32x16& t) {
#pragma unroll
    for (int i = 0; i < 16; ++i) t[i] = fexp2(t[i]);
    typedef float f32x2 __attribute__((ext_vector_type(2)));
    f32x2 a2 = (f32x2){t[0], t[1]} + (f32x2){t[2], t[3]}, b2 = (f32x2){t[4], t[5]} + (f32x2){t[6], t[7]};
    a2 += (f32x2){t[8], t[9]}; b2 += (f32x2){t[10], t[11]}; a2 += (f32x2){t[12], t[13]}; b2 += (f32x2){t[14], t[15]}; a2 += b2;
    return a2.x + a2.y;
}
__device__ __forceinline__ void tile_compute(SoftState& st, const bf16x8 (&qf)[4], const KFrag& f, const LAS unsigned char* lds, unsigned vb, int dist0, int max_dist, bool masked, bool first) {
    const bf16x8 v00 = *(const bf16x8*)f.vp, v01 = *(const bf16x8*)(f.vp + 1024), v10 = *(const bf16x8*)(f.vp + 2048), v11 = *(const bf16x8*)(f.vp + 3072);
    f32x16 t = tile_scores(st, qf, f, lds, vb, dist0, max_dist, masked);
    float ls = 0.f; bool redo = first;
    if (!first) { ls = exp_sum(t); redo = __builtin_amdgcn_ballot_w64(!(ls < 3.0e38f)) != 0ull; if (redo) t = tile_scores(st, qf, f, lds, vb, dist0, max_dist, masked); }
    if (redo) {
        float mx = fmaxf(fmaxf(t[0], t[1]), t[2]), my = fmaxf(fmaxf(t[8], t[9]), t[10]);
        mx = fmaxf(fmaxf(mx, t[3]), t[4]); my = fmaxf(fmaxf(my, t[11]), t[12]); mx = fmaxf(fmaxf(mx, t[5]), t[6]); my = fmaxf(fmaxf(my, t[13]), t[14]); mx = fmaxf(fmaxf(mx, t[7]), t[15]); mx = fmaxf(mx, my);
        mx = fmaxf(mx, __shfl_xor(mx, 32));
        const float delta = mx > -1e29f ? mx : 0.f, alpha = fexp2(-delta); st.l *= alpha; st.o0 *= alpha; st.o1 *= alpha; st.cin -= delta * (1.f / SC2); t -= delta;
        ls = exp_sum(t);
    }
    st.l += ls;
    const bf16x8 pb0 = pk_lo(t), pb1 = pk_hi(t);
    __builtin_amdgcn_s_setprio(1);
    st.o0 = mfma32(v00, pb0, st.o0); st.o1 = mfma32(v10, pb0, st.o1); st.o0 = mfma32(v01, pb1, st.o0); st.o1 = mfma32(v11, pb1, st.o1);
    __builtin_amdgcn_s_setprio(0);
}
__device__ __forceinline__ void soft_init(SoftState& st) { st.l = 0.f;
#pragma unroll
    for (int i = 0; i < 16; ++i) { st.cin[i] = 0.f; st.o0[i] = 0.f; st.o1[i] = 0.f; } }

__device__ __forceinline__ void run_range(SoftState& st, const bf16x8 (&qf)[4], const char* Kl, const char* Vl, int kt_lo, int kt_hi,
                                          int qpos, int qmin, int qmax, int max_dist, unsigned tb_head, const LAS unsigned char* lds, int h, bool first_run) {
    KFrag A, B; int kt = kt_lo;
    load_k(A, Kl + (size_t)kt_lo * 4096, Vl + (size_t)kt_lo * 4096);
#define RR_STEP(F) do { const int kbase = 32 * kt, dist0 = qpos - kbase - 4 * h; const unsigned vb = tb_head + (unsigned)(4 * (dist0 - 27)); \
        const bool masked = !(qmin - kbase - 31 >= 0 && qmax - kbase <= max_dist); \
        tile_compute(st, qf, F, lds, vb, dist0, max_dist, masked, first_run && kt == kt_lo); } while (0)
#pragma unroll 1
    for (;;) {
        { const int kn = kt + 1 <= kt_hi ? kt + 1 : kt_hi; load_k(B, Kl + (size_t)kn * 4096, Vl + (size_t)kn * 4096); }
        RR_STEP(A); if (++kt > kt_hi) break;
        { const int kn = kt + 1 <= kt_hi ? kt + 1 : kt_hi; load_k(A, Kl + (size_t)kn * 4096, Vl + (size_t)kn * 4096); }
        RR_STEP(B); if (++kt > kt_hi) break;
    }
#undef RR_STEP
}

constexpr int ATT_TAB = 1024  , ATT_HS_A = 2056  , ATT_HS_B = 136  , ATT_B0C = 16 * 136 + 1  , ATT_NEG = LDS_NEG;

__device__ __forceinline__ void phaseA_attn(unsigned char* ws, LAS unsigned char* lds, int gw, int NGW) {
    const int lane = threadIdx.x & 63;
    const int r = lane & 31, h = lane >> 5, tk = r >> 2, rr = r & 3;
    const LAS unsigned char* lut = lds + LDS_LUT; const LAS float* bias2 = (const LAS float*)(lds + LDS_BIAS);
    { LAS float* tab = (LAS float*)(lds + ATT_TAB);
      for (int i = threadIdx.x; i < 16 * ATT_HS_A; i += 512) { const int hd = i / ATT_HS_A, d = i - hd * ATT_HS_A; tab[i] = d < 2048 ? bias2[(int)lut[d] * 16 + hd] : 0.f; }
      if (threadIdx.x < 256) ((LAS float*)lds)[threadIdx.x] = 0.f;
      if (threadIdx.x < 64) ((LAS float*)(lds + ATT_NEG))[threadIdx.x] = -__builtin_inff();
      __syncthreads(); }
    const int xcd = blockIdx.x & 7, wx = (blockIdx.x >> 3) * 8 + (gw & 7), nwx = (NGW >> 3);
    for (int it = wx; it < 16 * 256; it += nwx) {
        const int rnd = it >> 8, bg = xcd * 16 + rnd, ti = ((it & 255) + 16 * rnd) & 255, b = bg >> 2, g = bg & 3, s0 = ti * 8, s = s0 + tk, head = g * 4 + rr, cur = s0 >> 6;
        const size_t tok = (size_t)b * 2048 + s;
        const LAS float* bias2h = bias2 + head;
        const unsigned tb_head = (unsigned)(ATT_TAB + head * ATT_HS_A * 4);
        bf16x8 qf[4];
        { const char* qp = (const char*)ws + OFF_QA + (tok * 1024 + head * 64 + 8 * h) * 2;
#pragma unroll
          for (int ks = 0; ks < 4; ++ks) qf[ks] = *(const bf16x8*)(qp + 32 * ks); }
        const float* gp = (const float*)(ws + OFF_GATE) + tok * 48 + head * 3; const float g_cmp = gp[0], g_sel = gp[1], g_win = gp[2];
        unsigned tp[16]; unsigned sel;
        {
            const char* Kc = (const char*)ws + OFF_KCMP + (size_t)bg * 16384 + lane * 16; const char* Vc = (const char*)ws + OFF_VCMPT + (size_t)bg * 16384 + lane * 16;
            f32x16 sc[4];
#pragma unroll
            for (int c = 0; c < 4; ++c) { f32x16 a = {0.f, 0.f, 0.f, 0.f, 0.f, 0.f, 0.f, 0.f, 0.f, 0.f, 0.f, 0.f, 0.f, 0.f, 0.f, 0.f};
#pragma unroll
                for (int ks = 0; ks < 4; ++ks) a = mfma32(*(const bf16x8*)(Kc + (c * 4 + ks) * 1024), qf[ks], a); sc[c] = a; }
            __builtin_amdgcn_sched_barrier(0);
            float mx = -1e30f;
#pragma unroll
            for (int c = 0; c < 4; ++c)
#pragma unroll
                for (int i = 0; i < 16; ++i) { const int n = 32 * c + (i & 3) + 8 * (i >> 2) + 4 * h, dist = s - 16 * n - 31; const bool valid = dist >= 0; const int idx = dist < 0 ? 0 : dist;
                    const float t = valid ? sc[c][i] * SC2 + bias2h[(int)lut[idx] * 16] : -1e30f; sc[c][i] = t; mx = fmaxf(mx, t); }
            mx = fmaxf(mx, __shfl_xor(mx, 32)); float l = 0.f;
#pragma unroll
            for (int c = 0; c < 4; ++c)
#pragma unroll
                for (int i = 0; i < 16; ++i) { const float pv = sc[c][i] > -1e29f ? fexp2(sc[c][i] - mx) : 0.f; sc[c][i] = pv; l += pv; }
            l += __shfl_xor(l, 32); const float inv = 1.f / fmaxf(l, 1e-30f);
#pragma unroll
            for (int c = 0; c < 4; ++c) sc[c] *= inv;
            __builtin_amdgcn_sched_barrier(0);
            f32x16 oc0 = {0.f, 0.f, 0.f, 0.f, 0.f, 0.f, 0.f, 0.f, 0.f, 0.f, 0.f, 0.f, 0.f, 0.f, 0.f, 0.f}, oc1 = oc0;
#pragma unroll
            for (int c = 0; c < 4; ++c) { const bf16x8 pb0 = pk_lo(sc[c]), pb1 = pk_hi(sc[c]);
                oc0 = mfma32(*(const bf16x8*)(Vc + (c * 4) * 1024), pb0, oc0); oc0 = mfma32(*(const bf16x8*)(Vc + (c * 4 + 1) * 1024), pb1, oc0); oc1 = mfma32(*(const bf16x8*)(Vc + (c * 4 + 2) * 1024), pb0, oc1); oc1 = mfma32(*(const bf16x8*)(Vc + (c * 4 + 3) * 1024), pb1, oc1); }
            oc0 *= g_cmp; oc1 *= g_cmp;
#pragma unroll
            for (int q = 0; q < 8; ++q) { tp[q] = cvt_pk_bf16(oc0[2 * q], oc0[2 * q + 1]); tp[8 + q] = cvt_pk_bf16(oc1[2 * q], oc1[2 * q + 1]); }
            __builtin_amdgcn_sched_barrier(0);
            float own[16], oth[16], pl[16];
#pragma unroll
            for (int cgi = 0; cgi < 16; ++cgi) pl[cgi] = __shfl_xor(sc[cgi >> 2][4 * (cgi & 3) + 3], 32);
#pragma unroll
            for (int cgi = 0; cgi < 16; ++cgi) { const int c = cgi >> 2, q4 = 4 * (cgi & 3); float v = (sc[c][q4] + sc[c][q4 + 1]) + (sc[c][q4 + 2] + sc[c][q4 + 3]);
                const float prevh0 = cgi > 0 ? pl[cgi > 0 ? cgi - 1 : 0] : 0.f; v += h ? pl[cgi] : prevh0;
                v += __shfl_xor(v, 1); v += __shfl_xor(v, 2); own[cgi] = v; }
#pragma unroll
            for (int cgi = 0; cgi < 16; ++cgi) oth[cgi] = __shfl_xor(own[cgi], 32);
            __builtin_amdgcn_sched_barrier(0);
            float cand[32];
#pragma unroll
            for (int cgi = 0; cgi < 16; ++cgi) { const float ve = h ? oth[cgi] : own[cgi], vo = h ? own[cgi] : oth[cgi];
                cand[2 * cgi] = (2 * cgi >= 1 && 2 * cgi <= cur - 2) ? ve : -2.f; cand[2 * cgi + 1] = (2 * cgi + 1 <= cur - 2) ? vo : -2.f; }
            float prev = 3.0e38f;
#pragma unroll 1
            for (int round = 0; round < 5; ++round) { float best = -1.f;
#pragma unroll
                for (int j = 0; j < 32; ++j) { const float v = cand[j] < prev ? cand[j] : -2.f; best = fmaxf(best, v); }
                prev = best; }
            const float thr = fmaxf(prev, 0.f);
            sel = 1u | (1u << cur) | (cur > 0 ? (1u << (cur - 1)) : 0u);
#pragma unroll
            for (int j = 1; j < 32; ++j) sel |= (cand[j] >= thr) ? (1u << j) : 0u;
        }
        {
            unsigned um = sel; um |= __shfl_xor(um, 4); um |= __shfl_xor(um, 8); um |= __shfl_xor(um, 16); um = __builtin_amdgcn_readfirstlane(um);
            const char* Kl = (const char*)ws + OFF_BRA + 2 * 32 * MiB + (size_t)bg * 2048 * 128 + lane * 16;
            const char* Vl = (const char*)ws + OFF_BRA + 3 * 32 * MiB + (size_t)bg * 2048 * 128 + lane * 16;
            SoftState st; soft_init(st);
            KFrag A, B; int half = 0, kb = 64 * __builtin_ctz(um), kbn = 0; bool has, first = true;
            load_k(A, Kl + (size_t)kb * 128, Vl + (size_t)kb * 128);
#define SEL_STEP(F, G) do { if (half) um &= um - 1; half ^= 1; has = um != 0u; kbn = has ? 64 * __builtin_ctz(um) + 32 * half : kb; load_k(G, Kl + (size_t)kbn * 128, Vl + (size_t)kbn * 128); \
                { const int jb = kb >> 6, dist0 = s - kb - 4 * h; const unsigned vb = ((sel >> jb) & 1u) ? tb_head + (unsigned)(4 * (dist0 - 27)) : (unsigned)ATT_NEG; \
                  tile_compute(st, qf, F, lds, vb, dist0, 1 << 20, jb >= cur, first); } first = false; kb = kbn; } while (0)
#pragma unroll 1
            for (;;) {
                SEL_STEP(A, B); if (!has) break;
                SEL_STEP(B, A); if (!has) break;
            }
#undef SEL_STEP
            const float lt = st.l + __shfl_xor(st.l, 32), sc = g_sel / fmaxf(lt, 1e-30f);
#pragma unroll
            for (int q = 0; q < 8; ++q) { tp[q] = cvt_pk_bf16(__uint_as_float(tp[q] << 16) + st.o0[2 * q] * sc, __uint_as_float(tp[q] & 0xffff0000u) + st.o0[2 * q + 1] * sc);
                tp[8 + q] = cvt_pk_bf16(__uint_as_float(tp[8 + q] << 16) + st.o1[2 * q] * sc, __uint_as_float(tp[8 + q] & 0xffff0000u) + st.o1[2 * q + 1] * sc); }
        }
        {
            const char* Kl = (const char*)ws + OFF_BRA + 4 * 32 * MiB + (size_t)bg * 2048 * 128 + lane * 16;
            const char* Vl = (const char*)ws + OFF_BRA + 5 * 32 * MiB + (size_t)bg * 2048 * 128 + lane * 16;
            SoftState st; soft_init(st);
            const int lo = s0 - 255, kt_lo = lo < 0 ? 0 : (lo >> 5), kt_hi = (s0 + 7) >> 5;
            run_range(st, qf, Kl, Vl, kt_lo, kt_hi, s, s0, s0 + 7, 255, tb_head, lds, h, true);
            const float lt = st.l + __shfl_xor(st.l, 32), sc = g_win / fmaxf(lt, 1e-30f);
#pragma unroll
            for (int q = 0; q < 8; ++q) { tp[q] = cvt_pk_bf16(__uint_as_float(tp[q] << 16) + st.o0[2 * q] * sc, __uint_as_float(tp[q] & 0xffff0000u) + st.o0[2 * q + 1] * sc);
                tp[8 + q] = cvt_pk_bf16(__uint_as_float(tp[8 + q] << 16) + st.o1[2 * q] * sc, __uint_as_float(tp[8 + q] & 0xffff0000u) + st.o1[2 * q + 1] * sc); }
        }
        { unsigned char* op = ws + OFF_O + (tok * 1024 + head * 64 + 4 * h) * 2;
#pragma unroll
          for (int q = 0; q < 4; ++q) { u32x2 w; w.x = tp[2 * q]; w.y = tp[2 * q + 1]; *(u32x2*)(op + 16 * q) = w; u32x2 w2; w2.x = tp[8 + 2 * q]; w2.y = tp[8 + 2 * q + 1]; *(u32x2*)(op + 64 + 16 * q) = w2; } }
    }
}

__device__ __forceinline__ void phaseB_attn(unsigned char* ws, LAS unsigned char* lds, int gw, int NGW) {
    const int lane = threadIdx.x & 63;
    const int r = lane & 31, h = lane >> 5, tk = r >> 2, rr = r & 3;
    const LAS unsigned char* lut = lds + LDS_LUT; const LAS float* bias2 = (const LAS float*)(lds + LDS_BIAS);
    { LAS float* tab = (LAS float*)(lds + ATT_TAB);
      for (int i = threadIdx.x; i < 3 * 16 * ATT_HS_B; i += 512) { const int gh = i / ATT_HS_B, d = i - gh * ATT_HS_B, gi = gh >> 4, hd = gh & 15; int td = d << (2 * gi); td = td > 2047 ? 2047 : td;
          tab[i] = bias2[(int)lut[td] * 16 + hd]; }
      for (int i = threadIdx.x; i < 4 * 16 * ATT_HS_B; i += 512) { const int cp = i / (16 * ATT_HS_B), j = i - cp * 16 * ATT_HS_B, hd = j / ATT_HS_B, d = j - hd * ATT_HS_B; const int td = d > 2047 ? 2047 : d;
          tab[3 * 16 * ATT_HS_B + cp * ATT_B0C + j] = bias2[(int)lut[td] * 16 + hd]; }
      if (threadIdx.x < 256) ((LAS float*)lds)[threadIdx.x] = 0.f;
      __syncthreads(); }
    const int xcd = blockIdx.x & 7, wx = (blockIdx.x >> 3) * 8 + (gw & 7), nwx = (NGW >> 3);
    for (int it = wx; it < 16 * 256; it += nwx) {
        const int rnd = it >> 8, bg = xcd * 16 + rnd, cc = ((it >> 4) + rnd) & 15  , r16 = it & 15, b = bg >> 2, g = bg & 3, s0 = cc * 128 + r16, s = s0 + 16 * tk, head = g * 4 + rr;
        const size_t tok = (size_t)b * 2048 + s;
        SoftState st; soft_init(st);
#pragma unroll 1
        for (int gi = 0; gi < 3; ++gi) {
            const int dsh = 2 * gi, lsh = 11 - dsh, res = s0 & ((1 << dsh) - 1);
            bf16x8 qf[4];
            { const char* qp = (const char*)ws + OFF_QB + (tok * 3072 + gi * 1024 + head * 64 + 8 * h) * 2;
#pragma unroll
              for (int ks = 0; ks < 4; ++ks) qf[ks] = *(const bf16x8*)(qp + 32 * ks); }
            const char* Kl = (const char*)ws + OFF_KVB + (size_t)(gi * 2) * 32 * MiB + ((size_t)bg * 2048 + ((size_t)res << lsh)) * 128 + lane * 16;
            const char* Vl = (const char*)ws + OFF_KVB + (size_t)(gi * 2 + 1) * 32 * MiB + ((size_t)bg * 2048 + ((size_t)res << lsh)) * 128 + lane * 16;
            const int ql = s >> dsh, qmin = s0 >> dsh, qmax = (s0 + 112) >> dsh, ql_lo = qmin - 128, kt_lo = ql_lo < 0 ? 0 : (ql_lo >> 5), kt_hi = qmax >> 5;
            const unsigned tb_head = gi == 0 ? (unsigned)(ATT_TAB + (3 * 16 * ATT_HS_B + (tk >> 1) * ATT_B0C + head * ATT_HS_B) * 4) : (unsigned)(ATT_TAB + (gi * 16 + head) * ATT_HS_B * 4);
            run_range(st, qf, Kl, Vl, kt_lo, kt_hi, ql, qmin, qmax, 128, tb_head, lds, h, gi == 0);
        }
        const float lt = st.l + __shfl_xor(st.l, 32), sc = 1.f / fmaxf(lt, 1e-30f);
        const f32x16 tot0 = st.o0 * sc, tot1 = st.o1 * sc;
        { unsigned char* op = ws + OFF_O + (tok * 1024 + head * 64 + 4 * h) * 2;
#pragma unroll
          for (int q = 0; q < 4; ++q) { u32x2 w; w.x = cvt_pk_bf16(tot0[4 * q], tot0[4 * q + 1]); w.y = cvt_pk_bf16(tot0[4 * q + 2], tot0[4 * q + 3]); *(u32x2*)(op + 16 * q) = w;
              u32x2 w2; w2.x = cvt_pk_bf16(tot1[4 * q], tot1[4 * q + 1]); w2.y = cvt_pk_bf16(tot1[4 * q + 2], tot1[4 * q + 3]); *(u32x2*)(op + 64 + 16 * q) = w2; } }
    }
}

__device__ __forceinline__ void phase_cmp2(unsigned char* ws, int gw, int NGW) {
    const int lane = threadIdx.x & 63;
    const int r = lane & 31, h = lane >> 5;
    for (int item = gw; item < 1024; item += NGW) {
        const int kv = item >> 9, rt = item & 511;
        const char* ap = (const char*)ws + OFF_G1 + (((size_t)kv * 16384 + rt * 32 + r) * 256 + 8 * h) * 2;
        const char* bp = (const char*)ws + OFF_W2 + (size_t)kv * 32768 + ((size_t)r * 256 + 8 * h) * 2;
        f32x16 a0 = {0.f, 0.f, 0.f, 0.f, 0.f, 0.f, 0.f, 0.f, 0.f, 0.f, 0.f, 0.f, 0.f, 0.f, 0.f, 0.f}, a1 = a0;
#pragma unroll
        for (int ks = 0; ks < 16; ++ks) { const bf16x8 a = *(const bf16x8*)(ap + 32 * ks);
            a0 = mfma32(a, *(const bf16x8*)(bp + 32 * ks), a0); a1 = mfma32(a, *(const bf16x8*)(bp + 32 * 256 * 2 + 32 * ks), a1); }
#pragma unroll
        for (int i = 0; i < 16; ++i) { const int row = rt * 32 + (i & 3) + 8 * (i >> 2) + 4 * h, gq = row & 3, n = (row >> 2) & 127, b = row >> 9, bgi = b * 4 + gq;
            if (kv == 0) { bf16_t* o = (bf16_t*)(ws + OFF_KCMP) + (size_t)bgi * 8192 + ((n >> 5) * 4 * 64 + (n & 31)) * 8;
                o[((r >> 4) * 64 + ((r >> 3) & 1) * 32) * 8 + (r & 7)] = f2bf(a0[i]); o[(((r >> 4) + 2) * 64 + ((r >> 3) & 1) * 32) * 8 + (r & 7)] = f2bf(a1[i]); }
            else { const int kk = n & 31, k16 = kk & 15; bf16_t* o = (bf16_t*)(ws + OFF_VCMPT) + (size_t)bgi * 8192 + (((n >> 5) * 4 + (kk >> 4)) * 64 + ((k16 >> 2) & 1) * 32 + r) * 8 + ((k16 >> 3) << 2) + (k16 & 3);
                o[0] = f2bf(a0[i]); o[2 * 64 * 8] = f2bf(a1[i]); } }
    }
}

__global__ __launch_bounds__(512, 2) void yoco_mega(Params p) {
    extern __shared__ __attribute__((aligned(16))) unsigned char shm[];
    cg::grid_group grid = cg::this_grid();
    LAS unsigned char* lds = (LAS unsigned char*)shm;
    const int tid = threadIdx.x, lane = tid & 63, wave = __builtin_amdgcn_readfirstlane(tid >> 6), gw = blockIdx.x * 8 + wave, NGW = gridDim.x * 8;
    unsigned char* ws = p.ws;
    const float* x_in = p.in[0];
    float* X = p.out;
    { LAS unsigned char* lut = lds + LDS_LUT; LAS float* bias2 = (LAS float*)(lds + LDS_BIAS);
      for (int d = tid; d < 2048; d += 512) { int bk = d; if (d >= 16) bk = 16 + (d >= 22) + (d >= 30) + (d >= 40) + (d >= 54) + (d >= 73) + (d >= 99) + (d >= 134) + (d >= 182) + (d >= 246) + (d >= 332) + (d >= 450) + (d >= 609) + (d >= 825) + (d >= 1117) + (d >= 1513); lut[d] = (unsigned char)bk; }
      bias2[tid] = p.in[1][tid] * LOG2E;
      if (tid < 4) ((LAS unsigned*)(lds + LDS_XB))[tid] = 0u;
      __syncthreads(); }
    const XcdBarrier xbar = xcd_barrier_post((unsigned*)(ws + OFF_XBAR), (volatile LAS unsigned*)(lds + LDS_XB));
    {
        LAS float* scr = (LAS float*)(lds + wave * 8448);
        const float* nm = p.in[2]; const float* nf = p.in[3];
        conv_weight(p.in[4], 1024, 2608, nm, (bf16_t*)(ws + OFF_WIN), 0, 0, scr, gw, NGW, lane);
        conv_weight(p.in[7], 2048, 256, nullptr, (bf16_t*)(ws + OFF_W1), 0, 0, scr, gw, NGW, lane);
        conv_weight(p.in[10], 2048, 256, nullptr, (bf16_t*)(ws + OFF_W1), 256, 0, scr, gw, NGW, lane);
        conv_weight(p.in[8], 256, 64, nullptr, (bf16_t*)(ws + OFF_W2), 0, 0, scr, gw, NGW, lane);
        conv_weight(p.in[11], 256, 64, nullptr, (bf16_t*)(ws + OFF_W2), 64, 0, scr, gw, NGW, lane);
        for (int item = gw; item < 512; item += NGW) { const int kv = item >> 8, ksl = (item >> 2) & 63, c = (item & 3) * 64 + lane;
            const float* pe = kv ? p.in[9] : p.in[6]; const float* w1 = kv ? p.in[10] : p.in[7]; float a = 0.f;
#pragma unroll 8
            for (int kk = ksl * 32; kk < ksl * 32 + 32; ++kk) a += pe[kk] * w1[(size_t)kk * 256 + c];
            ((float*)(ws + OFF_BIASP))[(kv * 64 + ksl) * 256 + c] = a; }
        cast_rows(x_in, (bf16_t*)(ws + OFF_H), (float*)(ws + OFF_SSQ), gw, NGW, lane);
    }
    grid.sync();
    pg8::StaticOrder S;
    float* const SSQ = (float*)(ws + OFF_SSQ);
    { pg8::Gemm g{(const char*)ws + OFF_H, (const char*)ws + OFF_WIN, 1024, 1024, 0, 0};
      { S.init(256, 9, gridDim.x, blockIdx.x, 1); EpiWin E{ws, p.in[5], SSQ}; pg8::gemm_phase<false>(lds, g, S, E, STAGGER, SSQ); }
      { S.init(256, 2, gridDim.x, blockIdx.x, 2); EpiV<0> E{ws, SSQ}; pg8::gemm_phase<true>(lds, g, S, E, 0, SSQ); }
      if (gw < 8) { const int o = gw * 64 + lane; const float* pp = (const float*)(ws + OFF_BIASP) + (o >> 8) * 64 * 256 + (o & 255); float a = 0.f;
#pragma unroll 8
          for (int q = 0; q < 64; ++q) a += pp[q * 256];
          ((float*)(ws + OFF_BIAS1))[o] = a; } }
    xcd_barrier(xbar);
    { pg8::Gemm g{(const char*)ws + OFF_BRA, (const char*)ws + OFF_W1, 2048, 0, 1, 32 * MiB}; S.init(64, 2, gridDim.x, blockIdx.x); EpiCmp1 E{ws}; pg8::gemm_phase<false>(lds, g, S, E); }
    if (blockIdx.x >= 128) { LAS float* scr = (LAS float*)(lds + wave * 8448); const float* nm = p.in[2]; const float* nf = p.in[3];
        const int gw2 = (blockIdx.x - 128) * 8 + wave, NGW2 = (gridDim.x - 128) * 8;
            conv_weight(p.in[12], 1024, 1024, nullptr, (bf16_t*)(ws + OFF_WOUTA), 0, 0, scr, gw2, NGW2, lane);
            conv_weight(p.in[15], 1024, 3072, nm + 1024, (bf16_t*)(ws + OFF_WQKVB), 0, 0, scr, gw2, NGW2, lane);
            conv_weight(p.in[14], 1024, 1536, p.in[13], (bf16_t*)(ws + OFF_WQKVB), 3072, 0, scr, gw2, NGW2, lane);
            conv_weight(p.in[16], 1024, 1024, nullptr, (bf16_t*)(ws + OFF_WOUTB), 0, 0, scr, gw2, NGW2, lane);
            conv_weight(p.in[17], 1024, 5632, nf, (bf16_t*)(ws + OFF_WUP0), 0, 1, scr, gw2, NGW2, lane);
            conv_weight(p.in[17] + (size_t)1024 * 5632, 1024, 5632, nf + 1024, (bf16_t*)(ws + OFF_WUP1), 0, 1, scr, gw2, NGW2, lane);
            conv_weight(p.in[18], 2816, 1024, nullptr, (bf16_t*)(ws + OFF_WDN0), 0, 0, scr, gw2, NGW2, lane);
            conv_weight(p.in[18] + (size_t)2816 * 1024, 2816, 1024, nullptr, (bf16_t*)(ws + OFF_WDN1), 0, 0, scr, gw2, NGW2, lane);
    }
    xcd_barrier(xbar);
    phase_cmp2(ws, gw, NGW);
    xcd_barrier(xbar);
    phaseA_attn(ws, lds, gw, NGW);
    xcd_barrier(xbar);
    { pg8::Gemm g{(const char*)ws + OFF_O, (const char*)ws + OFF_WOUTA, 1024, 1024, 0, 0}; S.init(256, 4, gridDim.x, blockIdx.x); EpiResid<0> E{x_in, ws + OFF_H, SSQ + 16 * T_TOK}; pg8::gemm_phase<false>(lds, g, S, E, STAGGER); }
    xcd_barrier(xbar);
    { pg8::Gemm g{(const char*)ws + OFF_H, (const char*)ws + OFF_WUP0, 1024, 1024, 0, 0}; S.init(256, 22, gridDim.x, blockIdx.x); EpiSwiglu E{ws + OFF_ACT, SSQ + 16 * T_TOK}; pg8::gemm_phase<false>(lds, g, S, E, STAGGER, SSQ + 16 * T_TOK); }
    xcd_barrier(xbar);
    { pg8::Gemm g{(const char*)ws + OFF_ACT, (const char*)ws + OFF_WDN0, 2816, 2816, 0, 0}; S.init(256, 4, gridDim.x, blockIdx.x); EpiResid<1> E{x_in, ws + OFF_H, SSQ + 32 * T_TOK}; pg8::gemm_phase<false>(lds, g, S, E, STAGGER); }
    xcd_barrier(xbar);
    { pg8::Gemm g{(const char*)ws + OFF_H, (const char*)ws + OFF_WQKVB, 1024, 1024, 0, 0};
      { S.init(256, 15, gridDim.x, blockIdx.x, 3); EpiQKVB E{ws, SSQ + 32 * T_TOK}; pg8::gemm_phase<false>(lds, g, S, E, STAGGER, SSQ + 32 * T_TOK); }
      { S.init(256, 3, gridDim.x, blockIdx.x, 4); EpiV<1> E{ws, SSQ + 32 * T_TOK}; pg8::gemm_phase<true>(lds, g, S, E, 0, SSQ + 32 * T_TOK); } }
    xcd_barrier(xbar);
    phaseB_attn(ws, lds, gw, NGW);
    xcd_barrier(xbar);
    { pg8::Gemm g{(const char*)ws + OFF_O, (const char*)ws + OFF_WOUTB, 1024, 1024, 0, 0}; S.init(256, 4, gridDim.x, blockIdx.x); EpiResid<1> E{x_in, ws + OFF_H, SSQ + 48 * T_TOK}; pg8::gemm_phase<false>(lds, g, S, E, STAGGER); }
    xcd_barrier(xbar);
    { pg8::Gemm g{(const char*)ws + OFF_H, (const char*)ws + OFF_WUP1, 1024, 1024, 0, 0}; S.init(256, 22, gridDim.x, blockIdx.x); EpiSwiglu E{ws + OFF_ACT, SSQ + 48 * T_TOK}; pg8::gemm_phase<false>(lds, g, S, E, STAGGER, SSQ + 48 * T_TOK); }
    xcd_barrier(xbar);
    { pg8::Gemm g{(const char*)ws + OFF_ACT, (const char*)ws + OFF_WDN1, 2816, 2816, 0, 0}; S.init(256, 4, gridDim.x, blockIdx.x); EpiResid<2> E{x_in, ws + OFF_H, SSQ}; pg8::gemm_phase<false>(lds, g, S, E, STAGGER); }
    xcd_barrier(xbar);
    final_norm_rows((const bf16_t*)(ws + OFF_H), X, p.in[19], gw, NGW);
}

extern "C" void kernel_launch(void* const* d_in, const int* in_sizes, int n_in, void* d_out, int out_size, void* d_ws, size_t ws_size, hipStream_t stream) {
    static int grid_blocks = 0;
    if (grid_blocks == 0) {
        if (n_in != 20 || out_size != T_TOK * DM || ws_size < WS_NEED) { fprintf(stderr, "kernel_launch: unexpected shapes (n_in %d out %d ws %zu)\n", n_in, out_size, ws_size); grid_blocks = -1; return; }
        int dev = 0, cus = 0, per_cu = 0;
        hipGetDevice(&dev); hipDeviceGetAttribute(&cus, hipDeviceAttributeMultiprocessorCount, dev);
        if (hipFuncSetAttribute((const void*)yoco_mega, hipFuncAttributeMaxDynamicSharedMemorySize, LDS_TOTAL) != hipSuccess) { fprintf(stderr, "kernel_launch: hipFuncSetAttribute failed\n"); grid_blocks = -1; return; }
        if (hipOccupancyMaxActiveBlocksPerMultiprocessor(&per_cu, (const void*)yoco_mega, 512, LDS_TOTAL) != hipSuccess || per_cu < 1) { fprintf(stderr, "kernel_launch: occupancy query gave %d\n", per_cu); per_cu = 1; }
        (void)hipGetLastError();
        grid_blocks = cus >= 256 ? 256 : cus;
        if (grid_blocks != 256) { fprintf(stderr, "kernel_launch: built for a 256-CU device (found %d CUs)\n", cus); grid_blocks = -1; return; }
    }
    if (grid_blocks < 0) return;
    if (hipMemsetAsync((unsigned char*)d_ws + OFF_XBAR, 0, XCD_BAR_WORDS * 4, stream) != hipSuccess) { fprintf(stderr, "kernel_launch: memset of the barrier words failed\n"); return; }
    Params p{};
    for (int i = 0; i < 20; ++i) p.in[i] = (const float*)d_in[i];
    p.out = (float*)d_out; p.ws = (unsigned char*)d_ws;
    void* args[] = {&p};
    hipError_t e = hipLaunchCooperativeKernel((const void*)yoco_mega, dim3(grid_blocks), dim3(512), args, LDS_TOTAL, stream);
    if (e != hipSuccess) fprintf(stderr, "cooperative launch failed: %s (grid %d)\n", hipGetErrorString(e), grid_blocks);
}
```

```cpp
#include <hip/hip_runtime.h>
#include <hip/hip_cooperative_groups.h>
#include <cstdio>
namespace cg = cooperative_groups;

#define LAS __attribute__((address_space(3)))
typedef unsigned short bf16_t;
typedef short bf16x8 __attribute__((ext_vector_type(8)));
typedef float f32x4 __attribute__((ext_vector_type(4)));
typedef float f32x16 __attribute__((ext_vector_type(16)));
typedef unsigned u32x4 __attribute__((ext_vector_type(4)));
typedef unsigned u32x2 __attribute__((ext_vector_type(2)));
typedef unsigned long long u64;

constexpr int T_TOK = 65536, DM = 1024, SEQ = 2048, FFH = 2816;
constexpr size_t MiB = 1ull << 20;
constexpr size_t OFF_WIN = 0, OFF_WOUTA = 6 * MiB, OFF_WUP0 = 8 * MiB, OFF_WUP1 = 19 * MiB, OFF_WDN0 = 30 * MiB, OFF_WDN1 = 36 * MiB,
                 OFF_WQKVB = 42 * MiB, OFF_WOUTB = 51 * MiB, OFF_W1 = 53 * MiB  , OFF_W2 = 55 * MiB  ,
                 OFF_BIASP = 55 * MiB + 128 * 1024  , OFF_BIAS1 = 55 * MiB + 512 * 1024  , OFF_XBAR = 55 * MiB + 768 * 1024  , OFF_KCMP = 56 * MiB, OFF_VCMPT = 58 * MiB, OFF_GATE = 60 * MiB,
                 OFF_SSQ = 330 * MiB + 600 * MiB  , OFF_H = 74 * MiB,
                 OFF_O = 202 * MiB, OFF_BIG = 330 * MiB, WS_NEED = 1024 * MiB;
constexpr size_t OFF_QA = OFF_BIG, OFF_BRA = OFF_BIG + 128 * MiB  , OFF_ACT = OFF_BIG,
                 OFF_QB = OFF_BIG, OFF_KVB = OFF_BIG + 384 * MiB  , OFF_G1 = OFF_O;
constexpr int LDS_STAGE = 131072, LDS_NEG = 132608  , LDS_LUT = 133120, LDS_BIAS = LDS_LUT + 2048, LDS_XB = LDS_BIAS + 2048  , LDS_RS = LDS_XB + 16  , LDS_TOTAL = LDS_RS + 8192;
constexpr int STAGGER = 0;
constexpr float LOG2E = 1.4426950408889634f;
constexpr float SC2 = 0.125f * LOG2E;

struct Params { const float* in[20]; float* out; unsigned char* ws; };

__device__ __forceinline__ unsigned cvt_pk_bf16(float lo, float hi) { unsigned r; asm volatile("v_cvt_pk_bf16_f32 %0, %1, %2" : "=v"(r) : "v"(lo), "v"(hi)); return r; }
__device__ __forceinline__ bf16_t f2bf(float f) { return (bf16_t)(cvt_pk_bf16(f, 0.f) & 0xffffu); }
__device__ __forceinline__ u32x4 pack8(f32x4 a, f32x4 b) { u32x4 o; o.x = cvt_pk_bf16(a[0], a[1]); o.y = cvt_pk_bf16(a[2], a[3]); o.z = cvt_pk_bf16(b[0], b[1]); o.w = cvt_pk_bf16(b[2], b[3]); return o; }
__device__ __forceinline__ float fexp2(float x) { return __builtin_amdgcn_exp2f(x); }
__device__ __forceinline__ float frcp(float x) { return __builtin_amdgcn_rcpf(x); }
__device__ __forceinline__ float sigmoidf_(float x) { return frcp(1.f + fexp2(-x * LOG2E)); }
__device__ __forceinline__ float wave_sum(float v) {
#pragma unroll
    for (int o = 1; o < 64; o <<= 1) v += __shfl_xor(v, o);
    return v;
}
__device__ __forceinline__ f32x16 mfma32(bf16x8 a, bf16x8 b, f32x16 c) { return __builtin_amdgcn_mfma_f32_32x32x16_bf16(a, b, c, 0, 0, 0); }
#define LDS_WAIT() asm volatile("s_waitcnt lgkmcnt(0)" ::: "memory")

#define XB_TMO      128
#define XB_XCNT(j)  (256  + 64 * (j))
#define XB_XSUB(j)  (1280 + 64 * (j))
#define XB_XGEN(j)  (2304 + 64 * (j))
#define XB_TOP      3328
#define XB_TOPGEN   3392
#define XCD_BAR_WORDS 3456
#define XB_SPIN_CAP (1u << 18)
__device__ __forceinline__ unsigned xb_ld(unsigned* p)              { return __hip_atomic_load(p, __ATOMIC_RELAXED, __HIP_MEMORY_SCOPE_AGENT); }
__device__ __forceinline__ unsigned xb_add(unsigned* p, unsigned v) { return __hip_atomic_fetch_add(p, v, __ATOMIC_RELAXED, __HIP_MEMORY_SCOPE_AGENT); }
__device__ __forceinline__ unsigned xb_xcc_id() { return (unsigned)__builtin_amdgcn_s_getreg((3 << 11) | 20) & 0xFu; }
#define XB_SPIN(cond, bar) do { unsigned _sp = 0; while (cond) { __builtin_amdgcn_s_sleep(1); \
    if ((++_sp & 255u) == 0u) { if (xb_ld(&(bar)[XB_TMO])) break; if (_sp > XB_SPIN_CAP) { atomicAdd(&(bar)[XB_TMO], 1u); break; } } } } while (0)
struct XcdBarrier { unsigned* bar; unsigned x; volatile LAS unsigned* st; };
__device__ __forceinline__ XcdBarrier xcd_barrier_post(unsigned* bar, volatile LAS unsigned* st) {
    XcdBarrier b; b.bar = bar; b.x = xb_xcc_id(); b.st = st;
    if (threadIdx.x == 0) (void)xb_add(&bar[XB_XCNT(b.x)], 1u);
    return b;
}
__device__ __forceinline__ void xcd_barrier_complete(unsigned* bar, unsigned x, unsigned& nloc, unsigned& nx) {
    const unsigned G = gridDim.x * gridDim.y * gridDim.z;
    unsigned sum, cnt, mine, sp = 0u;
    for (;;) {
        sum = 0u; cnt = 0u; mine = 0u;
#pragma unroll
        for (unsigned j = 0; j < 16; ++j) { const unsigned c = xb_ld(&bar[XB_XCNT(j)]); sum += c; cnt += (c > 0u) ? 1u : 0u; mine = (j == x) ? c : mine; }
        if (sum == G) break;
        __builtin_amdgcn_s_sleep(1);
        if ((++sp & 255u) == 0u) { if (xb_ld(&bar[XB_TMO])) break; if (sp > XB_SPIN_CAP) { atomicAdd(&bar[XB_TMO], 1u); break; } }
    }
    nloc = mine > 0u ? mine : 1u; nx = cnt > 0u ? cnt : 1u;
}
__device__ __forceinline__ void xcd_barrier(const XcdBarrier& b) {
    asm volatile("s_waitcnt vmcnt(0)" ::: "memory");
    __syncthreads();
    if (threadIdx.x == 0) {
        unsigned* bar = b.bar;
        __builtin_amdgcn_s_waitcnt(0);
        unsigned nloc = b.st[0], nx = b.st[1];
        if (nloc == 0u) { xcd_barrier_complete(bar, b.x, nloc, nx); b.st[0] = nloc; b.st[1] = nx; }
        const unsigned old = xb_add(&bar[XB_XSUB(b.x)], 1u);
        const unsigned gen = old / nloc;
        if (old + 1u == (gen + 1u) * nloc) {
            __builtin_amdgcn_fence(__ATOMIC_RELEASE, "agent");
            asm volatile("s_waitcnt vmcnt(0)" ::: "memory");
            const unsigned og = xb_add(&bar[XB_TOP], 1u);
            const unsigned tg = og / nx;
            if (og + 1u == (tg + 1u) * nx) xb_add(&bar[XB_TOPGEN], 1u);
            else XB_SPIN(xb_ld(&bar[XB_TOPGEN]) == tg, bar);
            __builtin_amdgcn_fence(__ATOMIC_ACQUIRE, "agent");
            xb_add(&bar[XB_XGEN(b.x)], 1u);
            asm volatile("s_waitcnt vmcnt(0)" ::: "memory");
        } else {
            XB_SPIN(xb_ld(&bar[XB_XGEN(b.x)]) == gen, bar);
            __builtin_amdgcn_fence(__ATOMIC_ACQUIRE, "agent");
            asm volatile("s_waitcnt vmcnt(0)" ::: "memory");
        }
    }
    __syncthreads();
}

namespace pg8 {
constexpr int BM = 256, BK = 64, HALF = 128, HTB = HALF * BK * 2, NXCD = 8, WGM = 8;
__device__ __forceinline__ int lds_byte(int r, int c) { const int st = (r >> 4) * 2 + (c >> 5), rr = r & 15, cc = c & 31, ob = rr * 64 + cc * 2; return st * 1024 + (ob ^ (((ob >> 9) & 1) << 5)); }
__device__ __forceinline__ void stage_rc(int b, int& R, int& C) { const int st = b / 1024, sb = b % 1024, swz = sb ^ (((sb >> 9) & 1) << 5); R = (st >> 1) * 16 + swz / 64; C = (st & 1) * 32 + (swz % 64) / 2; }
__device__ __forceinline__ int perm32(int rho) { const int n = rho >> 4, i = rho & 15; return 8 * (i >> 2) + 4 * n + (i & 3); }
struct Unit { int pm, pn; };
struct Gemm { const char* A; const char* Bt; int K; int lda; int amode; size_t a_pn_step; };
struct StaticOrder {
    int nM, nN, nwg, G, c, map;
    __device__ void init(int nM_, int nN_, int G_, int c_, int map_ = 0) { nM = nM_; nN = nN_; nwg = nM * nN; G = G_; c = c_; map = map_; }
    __device__ bool next(int i, Unit& u) const {
        const long L = (long)i * G + c; if (L >= nwg) return false;
        int wgid = (int)L; { const int q = nwg / NXCD, r = nwg % NXCD, xcd = wgid % NXCD, off = wgid / NXCD; wgid = (xcd < r ? xcd * (q + 1) : r * (q + 1) + (xcd - r) * q) + off; }
        const int nig = WGM * nN, gid = wgid / nig, fm = gid * WGM, gsz = (nM - fm) < WGM ? (nM - fm) : WGM;
        u.pm = fm + ((wgid % nig) % gsz); int pn = (wgid % nig) / gsz;
        if (map == 1) pn = pn < 7 ? pn : (pn == 7 ? 8 : 10); else if (map == 2) pn = 7 + 2 * pn; else if (map == 3) pn = pn < 12 ? pn : 12 + 2 * (pn - 12); else if (map == 4) pn = 13 + 2 * pn;
        u.pn = pn; return true;
    }
};

template <bool SWAP = false, class Epi>
__device__ __forceinline__ void gemm_phase(LAS unsigned char* lds, const Gemm g, const StaticOrder& S, const Epi& E, int stagger = 0, const float* ssq = nullptr) {
    if (stagger > 0) { const unsigned long long t0 = __builtin_amdgcn_s_memrealtime(), dl = (unsigned long long)((blockIdx.x >> 3) * stagger);
        while (__builtin_amdgcn_s_memrealtime() - t0 < dl) __builtin_amdgcn_s_sleep(4); }
    int tid = threadIdx.x; asm volatile("" : "+v"(tid));
    const int wid = __builtin_amdgcn_readfirstlane(tid >> 6), lane = tid & 63, wr = wid >> 2, wc = wid & 3, fr = lane & 15, fq = lane >> 4;
    const int K = g.K, nt = K / BK;
    unsigned voffA[2], voffB[2];
#pragma unroll
    for (int i = 0; i < 2; ++i) { int R, C; stage_rc(tid * 16 + i * 8192, R, C); const int Rb = SWAP ? R : (R & ~31) + perm32(R & 31);
        voffA[i] = g.amode ? (unsigned)((R >> 2) * 8192 + (R & 3) * 128 + C * 2) : (unsigned)(R * g.lda + C) * 2u;
        voffB[i] = (unsigned)(Rb * K + C) * 2u; }
    const size_t kstepA = g.amode ? 512 : (size_t)(BK * 2), kstepB = (size_t)(BK * 2);
    const size_t hstepA = g.amode ? (size_t)262144 : (size_t)HALF * g.lda * 2, hstepB = (size_t)HALF * K * 2;
    const size_t tstepA = 2 * hstepA, tstepB = 2 * hstepB;
    const unsigned ldsw = (unsigned)wid * 1024u;
    const int aoff = lds_byte(wr * 64 + fr, fq * 8), boff = lds_byte(wc * 32 + fr, fq * 8);
#define PG8_SA(b, h) (((b) * 2 + (h)) * HTB)
#define PG8_SB(b, h) ((4 + (b) * 2 + (h)) * HTB)
#define PG8_STAGE(bufoff, gbase, voff) do { _Pragma("unroll") for (int _i = 0; _i < 2; ++_i) \
        __builtin_amdgcn_global_load_lds((const unsigned*)((const char*)(gbase) + (voff)[_i]), (LAS unsigned*)(lds + (bufoff) + ldsw + _i * 8192), 16, 0, 0); } while (0)
#define PG8_LDA(dst, b, h) do { _Pragma("unroll") for (int m = 0; m < 4; ++m) _Pragma("unroll") for (int k = 0; k < 2; ++k) dst[m][k] = *(const LAS bf16x8*)(lds + PG8_SA(b, h) + aoff + m * 2048 + k * 1024); } while (0)
#define PG8_LDB(dst, b, h) do { _Pragma("unroll") for (int n = 0; n < 2; ++n) _Pragma("unroll") for (int k = 0; k < 2; ++k) dst[n][k] = *(const LAS bf16x8*)(lds + PG8_SB(b, h) + boff + n * 2048 + k * 1024); } while (0)
#define PG8_MMA(ai, bj, At, Bt) do { __builtin_amdgcn_s_setprio(1); _Pragma("unroll") for (int m = 0; m < 4; ++m) _Pragma("unroll") for (int n = 0; n < 2; ++n) _Pragma("unroll") for (int k = 0; k < 2; ++k) \
        acc[ai][bj][m][n] = SWAP ? __builtin_amdgcn_mfma_f32_16x16x32_bf16(At[m][k], Bt[n][k], acc[ai][bj][m][n], 0, 0, 0) : __builtin_amdgcn_mfma_f32_16x16x32_bf16(Bt[n][k], At[m][k], acc[ai][bj][m][n], 0, 0, 0); __builtin_amdgcn_s_setprio(0); } while (0)
#define PG8_WAIT_V(n) asm volatile("s_waitcnt vmcnt(" #n ")" ::: "memory")
#define PG8_WAIT_L(n) asm volatile("s_waitcnt lgkmcnt(" #n ")" ::: "memory")
#define PG8_BAR __builtin_amdgcn_s_barrier()
#define PG8_SCHED __builtin_amdgcn_sched_barrier(0)
    Unit cur, nxt; int ui = 0, slot = 0;
    if (!S.next(0, cur)) return;
    if (ssq) {
        Unit u; int sl = 0, ppm = cur.pm;
        for (int i = 0; S.next(i, u); ++i) { if (i == 0 || u.pm != ppm) { if (i) ++sl; ppm = u.pm;
                const unsigned char* sp = (const unsigned char*)(ssq + ((size_t)u.pm * 256 + (tid >> 1)) * 16) + (tid & 1) * 32;
                const f32x4 a = *(const f32x4*)sp, b = *(const f32x4*)(sp + 16); float v = ((a[0] + a[1]) + (a[2] + a[3])) + ((b[0] + b[1]) + (b[2] + b[3])); v += __shfl_xor(v, 1);
                if (!(tid & 1)) ((LAS float*)(lds + LDS_RS))[(sl & 7) * 256 + (tid >> 1)] = 1.f / sqrtf(v * (1.f / DM) + 1e-6f); } }
        __syncthreads(); }
    f32x4 acc[2][2][4][2];
#pragma unroll
    for (int a = 0; a < 2; ++a)
#pragma unroll
        for (int b = 0; b < 2; ++b)
#pragma unroll
            for (int m = 0; m < 4; ++m)
#pragma unroll
                for (int n = 0; n < 2; ++n) acc[a][b][m][n] = (f32x4){0.f, 0.f, 0.f, 0.f};
    bf16x8 At[4][2], B0[2][2], B1[2][2];
    const char* cA = g.A + (size_t)cur.pm * tstepA + (size_t)cur.pn * g.a_pn_step; const char* cB = g.Bt + (size_t)cur.pn * tstepB;
    PG8_STAGE(PG8_SB(0, 0), cB, voffB); PG8_STAGE(PG8_SA(0, 0), cA, voffA); PG8_STAGE(PG8_SB(0, 1), cB + hstepB, voffB); PG8_STAGE(PG8_SA(0, 1), cA + hstepA, voffA);
    if (wr == 1) PG8_BAR;
    PG8_WAIT_V(4); PG8_BAR;
    PG8_STAGE(PG8_SB(1, 0), cB + kstepB, voffB); PG8_STAGE(PG8_SA(1, 0), cA + kstepA, voffA); PG8_STAGE(PG8_SB(1, 1), cB + hstepB + kstepB, voffB);
    PG8_WAIT_V(6); PG8_BAR;
    for (;;) {
        const bool has_next = S.next(ui + 1, nxt);
        const char* nA = has_next ? g.A + (size_t)nxt.pm * tstepA + (size_t)nxt.pn * g.a_pn_step : cA; const char* nB = has_next ? g.Bt + (size_t)nxt.pn * tstepB : cB;
        for (int t = 0; t < nt; t += 2) {
            const bool last = (t == nt - 2);
            const char* a1 = cA + (size_t)(t + 1) * kstepA;
            const char* a2 = last ? nA : cA + (size_t)(t + 2) * kstepA; const char* b2 = last ? nB : cB + (size_t)(t + 2) * kstepB;
            const char* a3 = a2 + kstepA; const char* b3 = b2 + kstepB;
            PG8_LDB(B0, 0, 0); PG8_SCHED; PG8_LDA(At, 0, 0); PG8_STAGE(PG8_SA(1, 1), a1 + hstepA, voffA);
            PG8_WAIT_L(8); PG8_BAR; PG8_WAIT_L(0); PG8_MMA(0, 0, At, B0); PG8_BAR; PG8_SCHED;
            PG8_LDB(B1, 0, 1); PG8_STAGE(PG8_SB(0, 0), b2, voffB);
            PG8_BAR; PG8_WAIT_L(0); PG8_MMA(0, 1, At, B1); PG8_BAR;
            PG8_LDA(At, 0, 1); PG8_STAGE(PG8_SA(0, 0), a2, voffA);
            PG8_BAR; PG8_WAIT_L(0); PG8_MMA(1, 0, At, B0); PG8_BAR; PG8_SCHED;
            PG8_STAGE(PG8_SB(0, 1), b2 + hstepB, voffB);
            PG8_WAIT_V(6); PG8_BAR; PG8_MMA(1, 1, At, B1); PG8_BAR;
            PG8_LDB(B0, 1, 0); PG8_SCHED; PG8_LDA(At, 1, 0); PG8_STAGE(PG8_SA(0, 1), a2 + hstepA, voffA);
            PG8_WAIT_L(8); PG8_BAR; PG8_WAIT_L(0); PG8_MMA(0, 0, At, B0); PG8_BAR; PG8_SCHED;
            PG8_LDB(B1, 1, 1); PG8_STAGE(PG8_SB(1, 0), b3, voffB);
            PG8_BAR; PG8_WAIT_L(0); PG8_MMA(0, 1, At, B1); PG8_BAR;
            PG8_LDA(At, 1, 1); PG8_STAGE(PG8_SA(1, 0), a3, voffA);
            PG8_BAR; PG8_WAIT_L(0); PG8_MMA(1, 0, At, B0); PG8_BAR; PG8_SCHED;
            PG8_STAGE(PG8_SB(1, 1), b3 + hstepB, voffB);
            PG8_WAIT_V(6); PG8_BAR; PG8_MMA(1, 1, At, B1); PG8_BAR;
        }
        E(acc, cur, wr, wc, fr, fq, (const LAS float*)(lds + LDS_RS) + (slot & 7) * 256);
        if (!has_next) break;
#pragma unroll
        for (int a = 0; a < 2; ++a)
#pragma unroll
            for (int b = 0; b < 2; ++b)
#pragma unroll
                for (int m = 0; m < 4; ++m)
#pragma unroll
                    for (int n = 0; n < 2; ++n) acc[a][b][m][n] = (f32x4){0.f, 0.f, 0.f, 0.f};
        slot += (nxt.pm != cur.pm) ? 1 : 0; cur = nxt; cA = nA; cB = nB; ++ui;
    }
    PG8_WAIT_V(0);
    if (wr == 0) PG8_BAR;
    PG8_BAR;
#undef PG8_SA
#undef PG8_SB
#undef PG8_STAGE
#undef PG8_LDA
#undef PG8_LDB
#undef PG8_MMA
#undef PG8_WAIT_V
#undef PG8_WAIT_L
#undef PG8_BAR
#undef PG8_SCHED
}
}
using pg8::Unit;
typedef f32x4 Acc[2][2][4][2];

#define OPAQUE(v) asm volatile("" : "+v"(v))
__device__ __forceinline__ void load_row_rs(float (&rv)[2], const unsigned char* sp, int wr, int fr, int fq);
__device__ __forceinline__ float row_rs(float ssq) { return 1.f / sqrtf(ssq * (1.f / DM) + 1e-6f); }
__device__ __forceinline__ float row_rs16(const unsigned char* p) { const f32x4 a = *(const f32x4*)p, b = *(const f32x4*)(p + 16), c = *(const f32x4*)(p + 32), d = *(const f32x4*)(p + 48);
    return row_rs(((a[0] + a[1]) + (a[2] + a[3])) + ((b[0] + b[1]) + (b[2] + b[3])) + ((c[0] + c[1]) + (c[2] + c[3])) + ((d[0] + d[1]) + (d[2] + d[3]))); }
__device__ __forceinline__ void load_row_rs(float (&rv)[2], const unsigned char* sp, int wr, int fr, int fq) {
    unsigned so = (unsigned)(wr * 64 + fq * 16 + fr) * 64u; OPAQUE(so);
    rv[0] = row_rs16(sp + so); rv[1] = row_rs16(sp + (so + 128u * 64u));
}
struct EpiWin {
    unsigned char* ws; const float* b_gate; const float* ssq;
    __device__ __forceinline__ void operator()(const Acc& acc, const Unit& u, int wr, int wc, int fr, int fq, const LAS float* rsl) const {
        const int pn = u.pn; unsigned rl = wr * 64 + fr, cw = wc * 32 + 8 * fq; OPAQUE(rl); OPAQUE(cw); const size_t rowt = (size_t)u.pm * 256;
        float rs[2][4];
#pragma unroll
        for (int ai = 0; ai < 2; ++ai)
#pragma unroll
            for (int m = 0; m < 4; ++m) rs[ai][m] = rsl[ai * 128 + wr * 64 + m * 16 + fr];
        if (pn < 4) {
            unsigned char* base = ws + OFF_QA + (rowt * 1024 + pn * 256) * 2; unsigned lo = (rl * 1024 + cw) * 2; OPAQUE(lo);
#pragma unroll
            for (int ai = 0; ai < 2; ++ai)
#pragma unroll
                for (int m = 0; m < 4; ++m)
#pragma unroll
                    for (int bj = 0; bj < 2; ++bj) *(u32x4*)(base + (lo + (unsigned)(((ai * 128 + m * 16) * 1024 + bj * 128) * 2))) = pack8(acc[ai][bj][m][0] * rs[ai][m], acc[ai][bj][m][1] * rs[ai][m]);
        } else if (pn < 10) {
            const int br = pn - 4; const int b = u.pm >> 3, tb = (u.pm & 7) * 8;
            if (br == 2 || br == 4) {
                unsigned char* base = ws + OFF_BRA + (size_t)br * 32 * MiB + ((size_t)b * 4 * 2048 * 64 + (size_t)tb * 2048) * 2;
                unsigned lo = ((cw >> 6) * 2048 * 64 + ((wr * 8 + ((cw & 63) >> 4)) * 64 + ((cw >> 3) & 1) * 32 + fr) * 8) * 2; OPAQUE(lo);
#pragma unroll
                for (int ai = 0; ai < 2; ++ai)
#pragma unroll
                    for (int m = 0; m < 4; ++m)
#pragma unroll
                        for (int bj = 0; bj < 2; ++bj) *(u32x4*)(base + (lo + (unsigned)((bj * 2 * 2048 * 64 + ((ai * 4 + (m >> 1)) * 4 * 64 + (m & 1) * 16) * 8) * 2))) = pack8(acc[ai][bj][m][0] * rs[ai][m], acc[ai][bj][m][1] * rs[ai][m]);
            } else {
                unsigned char* base = ws + OFF_BRA + (size_t)br * 32 * MiB + rowt * 256 * 2; unsigned lo = (rl * 256 + cw) * 2; OPAQUE(lo);
#pragma unroll
                for (int ai = 0; ai < 2; ++ai)
#pragma unroll
                    for (int m = 0; m < 4; ++m)
#pragma unroll
                        for (int bj = 0; bj < 2; ++bj) *(u32x4*)(base + (lo + (unsigned)(((ai * 128 + m * 16) * 256 + bj * 128) * 2))) = pack8(acc[ai][bj][m][0] * rs[ai][m], acc[ai][bj][m][1] * rs[ai][m]);
            }
        } else {
            if (cw < 48) {
                unsigned char* base = ws + OFF_GATE + rowt * 48 * 4; unsigned lo = (rl * 48 + cw) * 4; OPAQUE(lo);
                float bg[8];
#pragma unroll
                for (int e = 0; e < 8; ++e) bg[e] = (cw + e < 48) ? b_gate[cw + e] : 0.f;
#pragma unroll
                for (int ai = 0; ai < 2; ++ai)
#pragma unroll
                    for (int m = 0; m < 4; ++m) { const f32x4 v0 = acc[ai][0][m][0] * rs[ai][m], v1 = acc[ai][0][m][1] * rs[ai][m];
#pragma unroll
                        for (int e = 0; e < 4; ++e) { if (cw + e < 48) *(float*)(base + (lo + (unsigned)(((ai * 128 + m * 16) * 48 + e) * 4))) = sigmoidf_(v0[e] + bg[e]);
                            if (cw + 4 + e < 48) *(float*)(base + (lo + (unsigned)(((ai * 128 + m * 16) * 48 + e + 4) * 4))) = sigmoidf_(v1[e] + bg[4 + e]); } }
            }
        }
    }
};
template <int LAYER>
struct EpiV {
    unsigned char* ws; const float* ssq;
    __device__ __forceinline__ void operator()(const Acc& acc, const Unit& u, int wr, int wc, int fr, int fq, const LAS float* rsl) const {
        const int pn = u.pn, b = u.pm >> 3; const size_t rowt = (size_t)u.pm * 256;
        const int idx = LAYER ? pn - 12 : 0, dsh = LAYER ? 2 * (idx >> 1) : 0, lsh = 11 - dsh;
        unsigned char* base = ws + (LAYER ? OFF_KVB + (size_t)idx * 32 * MiB : OFF_BRA + (size_t)(pn - 4) * 32 * MiB) + ((size_t)b * 4 * 2048 * 64) * 2;
        unsigned lo = ((wc >> 1) * 2048 * 64 + ((wc & 1) * 128 + fr) * 8) * 2; OPAQUE(lo);
        f32x4 rsv[2][4];
#pragma unroll
        for (int ai = 0; ai < 2; ++ai)
#pragma unroll
            for (int m = 0; m < 4; ++m) rsv[ai][m] = *(const LAS f32x4*)(rsl + ai * 128 + wr * 64 + m * 16 + 4 * fq);
        if (dsh == 0) {
            const unsigned tb = (u.pm & 7) * 8;
            unsigned lk = (((tb + wr * 2) * 4) * 64 + (fq & 1) * 32) * 16 + (fq >> 1) * 8; OPAQUE(lk);
#pragma unroll
            for (int ai = 0; ai < 2; ++ai)
#pragma unroll
                for (int m = 0; m < 4; ++m) { const f32x4 rs = rsv[ai][m];
#pragma unroll
                    for (int bj = 0; bj < 2; ++bj)
#pragma unroll
                        for (int n = 0; n < 2; ++n) { const f32x4 v = acc[ai][bj][m][n] * rs; u32x2 w; w.x = cvt_pk_bf16(v[0], v[1]); w.y = cvt_pk_bf16(v[2], v[3]);
                            *(u32x2*)(base + (lo + lk + (unsigned)((bj * 2 * 2048 * 64 + ((((ai * 4 + (m >> 1)) * 4 + (m & 1)) * 64) + 16 * n) * 8) * 2))) = w; }
                    __builtin_amdgcn_sched_barrier(0); }
        } else {
            const unsigned sb = ((u.pm & 7) * 256) >> dsh; unsigned slb = wr * 64 + 4 * fq; OPAQUE(slb);
#pragma unroll
            for (int ai = 0; ai < 2; ++ai)
#pragma unroll
                for (int m = 0; m < 4; ++m) {
#pragma unroll
                    for (int j = 0; j < 4; ++j) { const float rs = rsv[ai][m][j]; const unsigned sl = slb + (unsigned)(ai * 128 + m * 16 + j);
                        const unsigned p = ((sl & ((1u << dsh) - 1u)) << lsh) + (sl >> dsh) + sb, kk = p & 31u, k16 = kk & 15u;
                        const unsigned po = (((p >> 5) * 4 + (kk >> 4)) * 64 + ((k16 >> 2) & 1u) * 32) * 16 + (((k16 >> 3) << 2) + (k16 & 3u)) * 2;
#pragma unroll
                        for (int bj = 0; bj < 2; ++bj)
#pragma unroll
                            for (int n = 0; n < 2; ++n) *(bf16_t*)(base + (lo + po + (unsigned)((bj * 2 * 2048 * 64 + 16 * n * 8) * 2))) = f2bf(acc[ai][bj][m][n][j] * rs); }
                    __builtin_amdgcn_sched_barrier(0); }
        }
    }
};
struct EpiQKVB {
    unsigned char* ws; const float* ssq;
    __device__ __forceinline__ void operator()(const Acc& acc, const Unit& u, int wr, int wc, int fr, int fq, const LAS float* rsl) const {
        const int pn = u.pn; unsigned rl = wr * 64 + fr, cw = wc * 32 + 8 * fq; OPAQUE(rl); OPAQUE(cw); const size_t rowt = (size_t)u.pm * 256;
        float rs[2][4];
#pragma unroll
        for (int ai = 0; ai < 2; ++ai)
#pragma unroll
            for (int m = 0; m < 4; ++m) rs[ai][m] = rsl[ai * 128 + wr * 64 + m * 16 + fr];
        if (pn < 12) {
            unsigned char* base = ws + OFF_QB + (rowt * 3072 + pn * 256) * 2; unsigned lo = (rl * 3072 + cw) * 2; OPAQUE(lo);
#pragma unroll
            for (int ai = 0; ai < 2; ++ai)
#pragma unroll
                for (int m = 0; m < 4; ++m)
#pragma unroll
                    for (int bj = 0; bj < 2; ++bj) *(u32x4*)(base + (lo + (unsigned)(((ai * 128 + m * 16) * 3072 + bj * 128) * 2))) = pack8(acc[ai][bj][m][0] * rs[ai][m], acc[ai][bj][m][1] * rs[ai][m]);
        } else {
            const int idx = pn - 12, gi = idx >> 1, dsh = 2 * gi, lsh = 11 - dsh, b = u.pm >> 3, sb = ((u.pm & 7) * 256) >> dsh;
            unsigned posl = ((rl & ((1u << dsh) - 1u)) << lsh) + (rl >> dsh) + sb; OPAQUE(posl);
            unsigned char* base = ws + OFF_KVB + (size_t)idx * 32 * MiB + ((size_t)b * 4 * 2048 * 64) * 2;
            unsigned lo = ((cw >> 6) * 2048 * 64 + (((cw & 63) >> 4) * 64 + ((cw >> 3) & 1) * 32) * 8) * 2; OPAQUE(lo);
#pragma unroll
            for (int ai = 0; ai < 2; ++ai)
#pragma unroll
                for (int m = 0; m < 4; ++m) { const unsigned p = posl + (unsigned)((ai * 128 + m * 16) >> dsh), po = ((p >> 5) * 256 + (p & 31u)) * 16;
#pragma unroll
                    for (int bj = 0; bj < 2; ++bj) *(u32x4*)(base + (lo + po + (unsigned)(bj * 2 * 2048 * 64 * 2))) = pack8(acc[ai][bj][m][0] * rs[ai][m], acc[ai][bj][m][1] * rs[ai][m]); }
        }
    }
};
__device__ __forceinline__ f32x4 bf_lo4(u32x4 w) { f32x4 r; r[0] = __uint_as_float(w.x << 16); r[1] = __uint_as_float(w.x & 0xffff0000u); r[2] = __uint_as_float(w.y << 16); r[3] = __uint_as_float(w.y & 0xffff0000u); return r; }
__device__ __forceinline__ f32x4 bf_hi4(u32x4 w) { f32x4 r; r[0] = __uint_as_float(w.z << 16); r[1] = __uint_as_float(w.z & 0xffff0000u); r[2] = __uint_as_float(w.w << 16); r[3] = __uint_as_float(w.w & 0xffff0000u); return r; }
template <int MODE>
struct EpiResid {
    const float* xin; unsigned char* hout; float* ssq;
    __device__ __forceinline__ void operator()(const Acc& acc, const Unit& u, int wr, int wc, int fr, int fq, const LAS float* rsl) const {
        unsigned rl = wr * 64 + fr, cw = wc * 32 + 8 * fq; OPAQUE(rl); OPAQUE(cw); const size_t t0 = ((size_t)u.pm * 256 * 1024 + u.pn * 256) * 2;
        const unsigned char* bi = (const unsigned char*)xin + 2 * t0; unsigned char* bh = hout + t0; unsigned lo = (rl * 1024 + cw) * 2; OPAQUE(lo);
        float* sq = ssq + ((size_t)u.pm * 256 + rl) * 16 + u.pn * 4 + wc;
#pragma unroll
        for (int ai = 0; ai < 2; ++ai) {
            f32x4 xa[4][2][2];
#pragma unroll
            for (int m = 0; m < 4; ++m)
#pragma unroll
                for (int bj = 0; bj < 2; ++bj) { const unsigned o = lo + (unsigned)(((ai * 128 + m * 16) * 1024 + bj * 128) * 2);
                    if (MODE == 0) { xa[m][bj][0] = *(const f32x4*)(bi + 2 * o); xa[m][bj][1] = *(const f32x4*)(bi + 2 * o + 16); }
                    else { const u32x4 w = *(const u32x4*)(bh + o); xa[m][bj][0] = bf_lo4(w); xa[m][bj][1] = bf_hi4(w); } }
            __builtin_amdgcn_sched_barrier(0);
#pragma unroll
            for (int m = 0; m < 4; ++m) { float q = 0.f;
#pragma unroll
                for (int bj = 0; bj < 2; ++bj) { const unsigned o = lo + (unsigned)(((ai * 128 + m * 16) * 1024 + bj * 128) * 2);
                    const u32x4 w = pack8(xa[m][bj][0] + acc[ai][bj][m][0], xa[m][bj][1] + acc[ai][bj][m][1]);
                    *(u32x4*)(bh + o) = w;
                    if (MODE != 2) { const f32x4 a = bf_lo4(w), c = bf_hi4(w); q += (a[0] * a[0] + a[1] * a[1]) + (a[2] * a[2] + a[3] * a[3]) + (c[0] * c[0] + c[1] * c[1]) + (c[2] * c[2] + c[3] * c[3]); } }
                if (MODE != 2) { q += __shfl_xor(q, 16); q += __shfl_xor(q, 32); if (fq == 0) sq[(ai * 128 + m * 16) * 16] = q; } }
        }
    }
};
struct EpiSwiglu {
    unsigned char* act; const float* ssq;
    __device__ __forceinline__ void operator()(const Acc& acc, const Unit& u, int wr, int wc, int fr, int fq, const LAS float* rsl) const {
        unsigned rl = wr * 64 + fr, cw = wc * 32 + 8 * fq; OPAQUE(rl); OPAQUE(cw); unsigned char* base = act + ((size_t)u.pm * 256 * FFH + u.pn * 128) * 2; unsigned lo = (rl * FFH + cw) * 2; OPAQUE(lo);
        float rsv[2][4];
#pragma unroll
        for (int ai = 0; ai < 2; ++ai)
#pragma unroll
            for (int m = 0; m < 4; ++m) rsv[ai][m] = rsl[ai * 128 + wr * 64 + m * 16 + fr];
#pragma unroll
        for (int ai = 0; ai < 2; ++ai)
#pragma unroll
            for (int m = 0; m < 4; ++m) { f32x4 h0, h1; const float rs = rsv[ai][m];
#pragma unroll
                for (int e = 0; e < 4; ++e) { const float a0 = acc[ai][0][m][0][e] * rs, a1 = acc[ai][0][m][1][e] * rs;
                    h0[e] = a0 * sigmoidf_(a0) * (acc[ai][1][m][0][e] * rs); h1[e] = a1 * sigmoidf_(a1) * (acc[ai][1][m][1][e] * rs); }
                *(u32x4*)(base + (lo + (unsigned)((ai * 128 + m * 16) * FFH * 2))) = pack8(h0, h1); }
    }
};
struct EpiCmp1 {
    unsigned char* ws;
    __device__ __forceinline__ void operator()(const Acc& acc, const Unit& u, int wr, int wc, int fr, int fq, const LAS float* rsl) const {
        const int kv = u.pn; unsigned rl = wr * 64 + fr, cw = wc * 32 + 8 * fq; OPAQUE(rl); OPAQUE(cw);
        unsigned char* base = ws + OFF_G1 + (((size_t)kv * 16384 + (size_t)u.pm * 256) * 256) * 2; unsigned lo = (rl * 256 + cw) * 2; OPAQUE(lo);
        const unsigned char* bp = ws + OFF_BIAS1 + (size_t)kv * 256 * 4; unsigned blo = cw * 4; OPAQUE(blo);
#pragma unroll
        for (int bj = 0; bj < 2; ++bj) {
            const f32x4 b0 = *(const f32x4*)(bp + (blo + (unsigned)(bj * 128 * 4))), b1 = *(const f32x4*)(bp + (blo + (unsigned)(bj * 128 * 4 + 16)));
#pragma unroll
            for (int ai = 0; ai < 2; ++ai)
#pragma unroll
                for (int m = 0; m < 4; ++m) { f32x4 h0, h1;
#pragma unroll
                    for (int e = 0; e < 4; ++e) {
                        const float x0 = acc[ai][bj][m][0][e] + b0[e], x1 = acc[ai][bj][m][1][e] + b1[e];
                        const float u0 = 0.7978845608028654f * (x0 + 0.044715f * x0 * x0 * x0), u1 = 0.7978845608028654f * (x1 + 0.044715f * x1 * x1 * x1);
                        h0[e] = x0 * sigmoidf_(2.f * u0); h1[e] = x1 * sigmoidf_(2.f * u1); }
                    *(u32x4*)(base + (lo + (unsigned)(((ai * 128 + m * 16) * 256 + bj * 128) * 2))) = pack8(h0, h1); }
        }
    }
};

__device__ __forceinline__ void conv_weight(const float* W, int K, int N, const float* gain, bf16_t* WT, int row_off, int mode, LAS float* scr, int gw, int NGW, int lane) {
    const int nnb = (N + 31) / 32, nitems = (K / 64) * nnb;
    for (int item = gw; item < nitems; item += NGW) {
        const int kb = item / nnb, nb = item % nnb, k0 = 64 * kb, n0 = 32 * nb;
#pragma unroll 8
        for (int i = 0; i < 32; ++i) { const int kk = 2 * i + (lane >> 5), n = n0 + (lane & 31);
            float v = (n < N) ? W[(size_t)(k0 + kk) * N + n] : 0.f; if (gain) v *= gain[k0 + kk]; scr[kk * 33 + (lane & 31)] = v; }
        LDS_WAIT();
        int dr0 = row_off + n0;
        if (mode == 1) dr0 = (n0 < FFH) ? ((n0 >> 7) * 256 + (n0 & 127)) : ((((n0 - FFH) >> 7) * 256) + 128 + ((n0 - FFH) & 127));
        const int c = lane & 7;
#pragma unroll
        for (int j = 0; j < 4; ++j) { const int nn = (lane >> 3) + 8 * j; const LAS float* s = scr + (8 * c) * 33 + nn;
            u32x4 o; o.x = cvt_pk_bf16(s[0 * 33], s[1 * 33]); o.y = cvt_pk_bf16(s[2 * 33], s[3 * 33]); o.z = cvt_pk_bf16(s[4 * 33], s[5 * 33]); o.w = cvt_pk_bf16(s[6 * 33], s[7 * 33]);
            if (n0 + nn < N) *(u32x4*)(WT + (size_t)(dr0 + nn) * K + k0 + 8 * c) = o; }
        LDS_WAIT();
    }
}
__device__ __forceinline__ void cast_rows(const float* x, bf16_t* h, float* ssq, int gw, int NGW, int lane) {
    for (int row = gw; row < T_TOK; row += NGW) {
        const f32x4* xr = (const f32x4*)(x + (size_t)row * DM) + lane; f32x4 v[4]; float s = 0.f;
#pragma unroll
        for (int j = 0; j < 4; ++j) { v[j] = xr[64 * j]; s += (v[j][0] * v[j][0] + v[j][1] * v[j][1]) + (v[j][2] * v[j][2] + v[j][3] * v[j][3]); }
        s = wave_sum(s);
        u32x2* o = (u32x2*)(h + (size_t)row * DM) + lane;
#pragma unroll
        for (int j = 0; j < 4; ++j) { u32x2 w; w.x = cvt_pk_bf16(v[j][0], v[j][1]); w.y = cvt_pk_bf16(v[j][2], v[j][3]); o[64 * j] = w; }
        if (lane < 16) ssq[(size_t)row * 16 + lane] = lane == 0 ? s : 0.f;
    }
}
__device__ __forceinline__ void final_norm_rows(const bf16_t* hsrc, float* out, const float* gain, int gw, int NGW) {
    const int lane = threadIdx.x & 63;
    f32x4 gv[4];
#pragma unroll
    for (int j = 0; j < 4; ++j) gv[j] = ((const f32x4*)gain)[lane + 64 * j];
    for (int row = gw; row < T_TOK; row += NGW) {
        const u32x2* hr = (const u32x2*)(hsrc + (size_t)row * DM) + lane; f32x4* xr = (f32x4*)(out + (size_t)row * DM) + lane; f32x4 v[4]; float s = 0.f;
#pragma unroll
        for (int j = 0; j < 4; ++j) { const u32x2 w = hr[64 * j]; v[j][0] = __uint_as_float(w.x << 16); v[j][1] = __uint_as_float(w.x & 0xffff0000u); v[j][2] = __uint_as_float(w.y << 16); v[j][3] = __uint_as_float(w.y & 0xffff0000u);
            s += (v[j][0] * v[j][0] + v[j][1] * v[j][1]) + (v[j][2] * v[j][2] + v[j][3] * v[j][3]); }
        const float r = 1.f / sqrtf(wave_sum(s) * (1.f / DM) + 1e-6f);
#pragma unroll
        for (int j = 0; j < 4; ++j) xr[64 * j] = v[j] * r * gv[j];
    }
}

struct SoftState { float l; f32x16 cin, o0, o1; };
struct KFrag { bf16x8 k0, k1, k2, k3; const char* vp; };
__device__ __forceinline__ bf16x8 ld_v8(const char* p) { const u64 lo = *(const u64*)p, hi = *(const u64*)(p + 16); u32x4 t; t.x = (unsigned)lo; t.y = (unsigned)(lo >> 32); t.z = (unsigned)hi; t.w = (unsigned)(hi >> 32); return __builtin_bit_cast(bf16x8, t); }
__device__ __forceinline__ bf16x8 pk_lo(const f32x16& p) { u32x4 t; t.x = cvt_pk_bf16(p[0], p[1]); t.y = cvt_pk_bf16(p[2], p[3]); t.z = cvt_pk_bf16(p[4], p[5]); t.w = cvt_pk_bf16(p[6], p[7]); return __builtin_bit_cast(bf16x8, t); }
__device__ __forceinline__ bf16x8 pk_hi(const f32x16& p) { u32x4 t; t.x = cvt_pk_bf16(p[8], p[9]); t.y = cvt_pk_bf16(p[10], p[11]); t.z = cvt_pk_bf16(p[12], p[13]); t.w = cvt_pk_bf16(p[14], p[15]); return __builtin_bit_cast(bf16x8, t); }
__device__ __forceinline__ void load_k(KFrag& f, const char* kp, const char* vp) { f.k0 = *(const bf16x8*)kp; f.k1 = *(const bf16x8*)(kp + 1024); f.k2 = *(const bf16x8*)(kp + 2048); f.k3 = *(const bf16x8*)(kp + 3072);
    f.vp = vp; }
__device__ __forceinline__ f32x16 tile_scores(const SoftState& st, const bf16x8 (&qf)[4], const KFrag& f, const LAS unsigned char* lds, unsigned vb, int dist0, int max_dist, bool masked) {
    f32x16 bv;
#pragma unroll
    for (int i = 0; i < 16; ++i) bv[i] = *(const LAS float*)(lds + vb + 4 * (27 - ((i & 3) + 8 * (i >> 2))));
    __builtin_amdgcn_sched_barrier(0);
    f32x16 s = mfma32(f.k0, qf[0], st.cin); s = mfma32(f.k1, qf[1], s); s = mfma32(f.k2, qf[2], s); s = mfma32(f.k3, qf[3], s);
    f32x16 t = s * SC2 + bv;
    if (masked) {
#pragma unroll
        for (int i = 0; i < 16; ++i) t[i] = ((unsigned)(dist0 - ((i & 3) + 8 * (i >> 2))) <= (unsigned)max_dist) ? t[i] : -__builtin_inff();
    }
    return t;
}
__device__ __forceinline__ float exp_sum(f32x16& t) {
#pragma unroll
    for (int i = 0; i < 16; ++i) t[i] = fexp2(t[i]);
    typedef float f32x2 __attribute__((ext_vector_type(2)));
    f32x2 a2 = (f32x2){t[0], t[1]} + (f32x2){t[2], t[3]}, b2 = (f32x2){t[4], t[5]} + (f32x2){t[6], t[7]};
    a2 += (f32x2){t[8], t[9]}; b2 += (f32x2){t[10], t[11]}; a2 += (f32x2){t[12], t[13]}; b2 += (f32x2){t[14], t[15]}; a2 += b2;
    return a2.x + a2.y;
}
__device__ __forceinline__ void tile_compute(SoftState& st, const bf16x8 (&qf)[4], const KFrag& f, const LAS unsigned char* lds, unsigned vb, int dist0, int max_dist, bool masked, bool first) {
    const bf16x8 v00 = *(const bf16x8*)f.vp, v01 = *(const bf16x8*)(f.vp + 1024), v10 = *(const bf16x8*)(f.vp + 2048), v11 = *(const bf16x8*)(f.vp + 3072);
    f32x16 t = tile_scores(st, qf, f, lds, vb, dist0, max_dist, masked);
    float ls = 0.f; bool redo = first;
    if (!first) { ls = exp_sum(t); redo = __builtin_amdgcn_ballot_w64(!(ls < 3.0e38f)) != 0ull; if (redo) t = tile_scores(st, qf, f, lds, vb, dist0, max_dist, masked); }
    if (redo) {
        float mx = fmaxf(fmaxf(t[0], t[1]), t[2]), my = fmaxf(fmaxf(t[8], t[9]), t[10]);
        mx = fmaxf(fmaxf(mx, t[3]), t[4]); my = fmaxf(fmaxf(my, t[11]), t[12]); mx = fmaxf(fmaxf(mx, t[5]), t[6]); my = fmaxf(fmaxf(my, t[13]), t[14]); mx = fmaxf(fmaxf(mx, t[7]), t[15]); mx = fmaxf(mx, my);
        mx = fmaxf(mx, __shfl_xor(mx, 32));
        const float delta = mx > -1e29f ? mx : 0.f, alpha = fexp2(-delta); st.l *= alpha; st.o0 *= alpha; st.o1 *= alpha; st.cin -= delta * (1.f / SC2); t -= delta;
        ls = exp_sum(t);
    }
    st.l += ls;
    const bf16x8 pb0 = pk_lo(t), pb1 = pk_hi(t);
    st.o0 = mfma32(v00, pb0, st.o0); st.o0 = mfma32(v01, pb1, st.o0); st.o1 = mfma32(v10, pb0, st.o1); st.o1 = mfma32(v11, pb1, st.o1);
}
__device__ __forceinline__ void soft_init(SoftState& st) { st.l = 0.f;
#pragma unroll
    for (int i = 0; i < 16; ++i) { st.cin[i] = 0.f; st.o0[i] = 0.f; st.o1[i] = 0.f; } }

__device__ __forceinline__ void run_range(SoftState& st, const bf16x8 (&qf)[4], const char* Kl, const char* Vl, int kt_lo, int kt_hi,
                                          int qpos, int qmin, int qmax, int max_dist, unsigned tb_head, const LAS unsigned char* lds, int h, bool first_run) {
    KFrag A, B; int kt = kt_lo;
    load_k(A, Kl + (size_t)kt_lo * 4096, Vl + (size_t)kt_lo * 4096);
#define RR_STEP(F) do { const int kbase = 32 * kt, dist0 = qpos - kbase - 4 * h; const unsigned vb = tb_head + (unsigned)(4 * (dist0 - 27)); \
        const bool masked = !(qmin - kbase - 31 >= 0 && qmax - kbase <= max_dist); \
        tile_compute(st, qf, F, lds, vb, dist0, max_dist, masked, first_run && kt == kt_lo); } while (0)
#pragma unroll 1
    for (;;) {
        { const int kn = kt + 1 <= kt_hi ? kt + 1 : kt_hi; load_k(B, Kl + (size_t)kn * 4096, Vl + (size_t)kn * 4096); }
        RR_STEP(A); if (++kt > kt_hi) break;
        { const int kn = kt + 1 <= kt_hi ? kt + 1 : kt_hi; load_k(A, Kl + (size_t)kn * 4096, Vl + (size_t)kn * 4096); }
        RR_STEP(B); if (++kt > kt_hi) break;
    }
#undef RR_STEP
}

constexpr int ATT_TAB = 1024  , ATT_HS_A = 2056  , ATT_HS_B = 136  , ATT_B0C = 16 * 136 + 1  , ATT_NEG = LDS_NEG;

__device__ __forceinline__ void phaseA_attn(unsigned char* ws, LAS unsigned char* lds, int gw, int NGW) {
    const int lane = threadIdx.x & 63;
    const int r = lane & 31, h = lane >> 5, tk = r >> 2, rr = r & 3;
    const LAS unsigned char* lut = lds + LDS_LUT; const LAS float* bias2 = (const LAS float*)(lds + LDS_BIAS);
    { LAS float* tab = (LAS float*)(lds + ATT_TAB);
      for (int i = threadIdx.x; i < 16 * ATT_HS_A; i += 512) { const int hd = i / ATT_HS_A, d = i - hd * ATT_HS_A; tab[i] = d < 2048 ? bias2[(int)lut[d] * 16 + hd] : 0.f; }
      if (threadIdx.x < 256) ((LAS float*)lds)[threadIdx.x] = 0.f;
      if (threadIdx.x < 64) ((LAS float*)(lds + ATT_NEG))[threadIdx.x] = -__builtin_inff();
      __syncthreads(); }
    const int xcd = blockIdx.x & 7, wx = (blockIdx.x >> 3) * 8 + (gw & 7), nwx = (NGW >> 3);
    for (int it = wx; it < 16 * 256; it += nwx) {
        const int rnd = it >> 8, bg = xcd * 16 + rnd, ti = ((it & 255) + 16 * rnd) & 255, b = bg >> 2, g = bg & 3, s0 = ti * 8, s = s0 + tk, head = g * 4 + rr, cur = s0 >> 6;
        const size_t tok = (size_t)b * 2048 + s;
        const LAS float* bias2h = bias2 + head;
        const unsigned tb_head = (unsigned)(ATT_TAB + head * ATT_HS_A * 4);
        bf16x8 qf[4];
        { const char* qp = (const char*)ws + OFF_QA + (tok * 1024 + head * 64 + 8 * h) * 2;
#pragma unroll
          for (int ks = 0; ks < 4; ++ks) qf[ks] = *(const bf16x8*)(qp + 32 * ks); }
        const float* gp = (const float*)(ws + OFF_GATE) + tok * 48 + head * 3; const float g_cmp = gp[0], g_sel = gp[1], g_win = gp[2];
        unsigned tp[16]; unsigned sel;
        {
            const char* Kc = (const char*)ws + OFF_KCMP + (size_t)bg * 16384 + lane * 16; const char* Vc = (const char*)ws + OFF_VCMPT + (size_t)bg * 16384 + lane * 16;
            f32x16 sc[4];
#pragma unroll
            for (int c = 0; c < 4; ++c) { f32x16 a = {0.f, 0.f, 0.f, 0.f, 0.f, 0.f, 0.f, 0.f, 0.f, 0.f, 0.f, 0.f, 0.f, 0.f, 0.f, 0.f};
#pragma unroll
                for (int ks = 0; ks < 4; ++ks) a = mfma32(*(const bf16x8*)(Kc + (c * 4 + ks) * 1024), qf[ks], a); sc[c] = a; }
            __builtin_amdgcn_sched_barrier(0);
            float mx = -1e30f;
#pragma unroll
            for (int c = 0; c < 4; ++c)
#pragma unroll
                for (int i = 0; i < 16; ++i) { const int n = 32 * c + (i & 3) + 8 * (i >> 2) + 4 * h, dist = s - 16 * n - 31; const bool valid = dist >= 0; const int idx = dist < 0 ? 0 : dist;
                    const float t = valid ? sc[c][i] * SC2 + bias2h[(int)lut[idx] * 16] : -1e30f; sc[c][i] = t; mx = fmaxf(mx, t); }
            mx = fmaxf(mx, __shfl_xor(mx, 32)); float l = 0.f;
#pragma unroll
            for (int c = 0; c < 4; ++c)
#pragma unroll
                for (int i = 0; i < 16; ++i) { const float pv = sc[c][i] > -1e29f ? fexp2(sc[c][i] - mx) : 0.f; sc[c][i] = pv; l += pv; }
            l += __shfl_xor(l, 32); const float inv = 1.f / fmaxf(l, 1e-30f);
#pragma unroll
            for (int c = 0; c < 4; ++c) sc[c] *= inv;
            __builtin_amdgcn_sched_barrier(0);
            f32x16 oc0 = {0.f, 0.f, 0.f, 0.f, 0.f, 0.f, 0.f, 0.f, 0.f, 0.f, 0.f, 0.f, 0.f, 0.f, 0.f, 0.f}, oc1 = oc0;
#pragma unroll
            for (int c = 0; c < 4; ++c) { const bf16x8 pb0 = pk_lo(sc[c]), pb1 = pk_hi(sc[c]);
                oc0 = mfma32(*(const bf16x8*)(Vc + (c * 4) * 1024), pb0, oc0); oc0 = mfma32(*(const bf16x8*)(Vc + (c * 4 + 1) * 1024), pb1, oc0); oc1 = mfma32(*(const bf16x8*)(Vc + (c * 4 + 2) * 1024), pb0, oc1); oc1 = mfma32(*(const bf16x8*)(Vc + (c * 4 + 3) * 1024), pb1, oc1); }
            oc0 *= g_cmp; oc1 *= g_cmp;
#pragma unroll
            for (int q = 0; q < 8; ++q) { tp[q] = cvt_pk_bf16(oc0[2 * q], oc0[2 * q + 1]); tp[8 + q] = cvt_pk_bf16(oc1[2 * q], oc1[2 * q + 1]); }
            __builtin_amdgcn_sched_barrier(0);
            float own[16], oth[16], pl[16];
#pragma unroll
            for (int cgi = 0; cgi < 16; ++cgi) pl[cgi] = __shfl_xor(sc[cgi >> 2][4 * (cgi & 3) + 3], 32);
#pragma unroll
            for (int cgi = 0; cgi < 16; ++cgi) { const int c = cgi >> 2, q4 = 4 * (cgi & 3); float v = (sc[c][q4] + sc[c][q4 + 1]) + (sc[c][q4 + 2] + sc[c][q4 + 3]);
                const float prevh0 = cgi > 0 ? pl[cgi > 0 ? cgi - 1 : 0] : 0.f; v += h ? pl[cgi] : prevh0;
                v += __shfl_xor(v, 1); v += __shfl_xor(v, 2); own[cgi] = v; }
#pragma unroll
            for (int cgi = 0; cgi < 16; ++cgi) oth[cgi] = __shfl_xor(own[cgi], 32);
            __builtin_amdgcn_sched_barrier(0);
            float cand[32];
#pragma unroll
            for (int cgi = 0; cgi < 16; ++cgi) { const float ve = h ? oth[cgi] : own[cgi], vo = h ? own[cgi] : oth[cgi];
                cand[2 * cgi] = (2 * cgi >= 1 && 2 * cgi <= cur - 2) ? ve : -2.f; cand[2 * cgi + 1] = (2 * cgi + 1 <= cur - 2) ? vo : -2.f; }
            float prev = 3.0e38f;
#pragma unroll 1
            for (int round = 0; round < 5; ++round) { float best = -1.f;
#pragma unroll
                for (int j = 0; j < 32; ++j) { const float v = cand[j] < prev ? cand[j] : -2.f; best = fmaxf(best, v); }
                prev = best; }
            const float thr = fmaxf(prev, 0.f);
            sel = 1u | (1u << cur) | (cur > 0 ? (1u << (cur - 1)) : 0u);
#pragma unroll
            for (int j = 1; j < 32; ++j) sel |= (cand[j] >= thr) ? (1u << j) : 0u;
        }
        {
            unsigned um = sel; um |= __shfl_xor(um, 4); um |= __shfl_xor(um, 8); um |= __shfl_xor(um, 16); um = __builtin_amdgcn_readfirstlane(um);
            const char* Kl = (const char*)ws + OFF_BRA + 2 * 32 * MiB + (size_t)bg * 2048 * 128 + lane * 16;
            const char* Vl = (const char*)ws + OFF_BRA + 3 * 32 * MiB + (size_t)bg * 2048 * 128 + lane * 16;
            SoftState st; soft_init(st);
            KFrag A, B; int half = 0, kb = 64 * __builtin_ctz(um), kbn = 0; bool has, first = true;
            load_k(A, Kl + (size_t)kb * 128, Vl + (size_t)kb * 128);
#define SEL_STEP(F, G) do { if (half) um &= um - 1; half ^= 1; has = um != 0u; kbn = has ? 64 * __builtin_ctz(um) + 32 * half : kb; load_k(G, Kl + (size_t)kbn * 128, Vl + (size_t)kbn * 128); \
                { const int jb = kb >> 6, dist0 = s - kb - 4 * h; const unsigned vb = ((sel >> jb) & 1u) ? tb_head + (unsigned)(4 * (dist0 - 27)) : (unsigned)ATT_NEG; \
                  tile_compute(st, qf, F, lds, vb, dist0, 1 << 20, jb >= cur, first); } first = false; kb = kbn; } while (0)
#pragma unroll 1
            for (;;) {
                SEL_STEP(A, B); if (!has) break;
                SEL_STEP(B, A); if (!has) break;
            }
#undef SEL_STEP
            const float lt = st.l + __shfl_xor(st.l, 32), sc = g_sel / fmaxf(lt, 1e-30f);
#pragma unroll
            for (int q = 0; q < 8; ++q) { tp[q] = cvt_pk_bf16(__uint_as_float(tp[q] << 16) + st.o0[2 * q] * sc, __uint_as_float(tp[q] & 0xffff0000u) + st.o0[2 * q + 1] * sc);
                tp[8 + q] = cvt_pk_bf16(__uint_as_float(tp[8 + q] << 16) + st.o1[2 * q] * sc, __uint_as_float(tp[8 + q] & 0xffff0000u) + st.o1[2 * q + 1] * sc); }
        }
        {
            const char* Kl = (const char*)ws + OFF_BRA + 4 * 32 * MiB + (size_t)bg * 2048 * 128 + lane * 16;
            const char* Vl = (const char*)ws + OFF_BRA + 5 * 32 * MiB + (size_t)bg * 2048 * 128 + lane * 16;
            SoftState st; soft_init(st);
            const int lo = s0 - 255, kt_lo = lo < 0 ? 0 : (lo >> 5), kt_hi = (s0 + 7) >> 5;
            run_range(st, qf, Kl, Vl, kt_lo, kt_hi, s, s0, s0 + 7, 255, tb_head, lds, h, true);
            const float lt = st.l + __shfl_xor(st.l, 32), sc = g_win / fmaxf(lt, 1e-30f);
#pragma unroll
            for (int q = 0; q < 8; ++q) { tp[q] = cvt_pk_bf16(__uint_as_float(tp[q] << 16) + st.o0[2 * q] * sc, __uint_as_float(tp[q] & 0xffff0000u) + st.o0[2 * q + 1] * sc);
                tp[8 + q] = cvt_pk_bf16(__uint_as_float(tp[8 + q] << 16) + st.o1[2 * q] * sc, __uint_as_float(tp[8 + q] & 0xffff0000u) + st.o1[2 * q + 1] * sc); }
        }
        { unsigned char* op = ws + OFF_O + (tok * 1024 + head * 64 + 4 * h) * 2;
#pragma unroll
          for (int q = 0; q < 4; ++q) { u32x2 w; w.x = tp[2 * q]; w.y = tp[2 * q + 1]; *(u32x2*)(op + 16 * q) = w; u32x2 w2; w2.x = tp[8 + 2 * q]; w2.y = tp[8 + 2 * q + 1]; *(u32x2*)(op + 64 + 16 * q) = w2; } }
    }
}

__device__ __forceinline__ void phaseB_attn(unsigned char* ws, LAS unsigned char* lds, int gw, int NGW) {
    const int lane = threadIdx.x & 63;
    const int r = lane & 31, h = lane >> 5, tk = r >> 2, rr = r & 3;
    const LAS unsigned char* lut = lds + LDS_LUT; const LAS float* bias2 = (const LAS float*)(lds + LDS_BIAS);
    { LAS float* tab = (LAS float*)(lds + ATT_TAB);
      for (int i = threadIdx.x; i < 3 * 16 * ATT_HS_B; i += 512) { const int gh = i / ATT_HS_B, d = i - gh * ATT_HS_B, gi = gh >> 4, hd = gh & 15; int td = d << (2 * gi); td = td > 2047 ? 2047 : td;
          tab[i] = bias2[(int)lut[td] * 16 + hd]; }
      for (int i = threadIdx.x; i < 4 * 16 * ATT_HS_B; i += 512) { const int cp = i / (16 * ATT_HS_B), j = i - cp * 16 * ATT_HS_B, hd = j / ATT_HS_B, d = j - hd * ATT_HS_B; const int td = d > 2047 ? 2047 : d;
          tab[3 * 16 * ATT_HS_B + cp * ATT_B0C + j] = bias2[(int)lut[td] * 16 + hd]; }
      if (threadIdx.x < 256) ((LAS float*)lds)[threadIdx.x] = 0.f;
      __syncthreads(); }
    const int xcd = blockIdx.x & 7, wx = (blockIdx.x >> 3) * 8 + (gw & 7), nwx = (NGW >> 3);
    for (int it = wx; it < 16 * 256; it += nwx) {
        const int rnd = it >> 8, bg = xcd * 16 + rnd, cc = ((it >> 4) + rnd) & 15  , r16 = it & 15, b = bg >> 2, g = bg & 3, s0 = cc * 128 + r16, s = s0 + 16 * tk, head = g * 4 + rr;
        const size_t tok = (size_t)b * 2048 + s;
        SoftState st; soft_init(st);
#pragma unroll 1
        for (int gi = 0; gi < 3; ++gi) {
            const int dsh = 2 * gi, lsh = 11 - dsh, res = s0 & ((1 << dsh) - 1);
            bf16x8 qf[4];
            { const char* qp = (const char*)ws + OFF_QB + (tok * 3072 + gi * 1024 + head * 64 + 8 * h) * 2;
#pragma unroll
              for (int ks = 0; ks < 4; ++ks) qf[ks] = *(const bf16x8*)(qp + 32 * ks); }
            const char* Kl = (const char*)ws + OFF_KVB + (size_t)(gi * 2) * 32 * MiB + ((size_t)bg * 2048 + ((size_t)res << lsh)) * 128 + lane * 16;
            const char* Vl = (const char*)ws + OFF_KVB + (size_t)(gi * 2 + 1) * 32 * MiB + ((size_t)bg * 2048 + ((size_t)res << lsh)) * 128 + lane * 16;
            const int ql = s >> dsh, qmin = s0 >> dsh, qmax = (s0 + 112) >> dsh, ql_lo = qmin - 128, kt_lo = ql_lo < 0 ? 0 : (ql_lo >> 5), kt_hi = qmax >> 5;
            const unsigned tb_head = gi == 0 ? (unsigned)(ATT_TAB + (3 * 16 * ATT_HS_B + (tk >> 1) * ATT_B0C + head * ATT_HS_B) * 4) : (unsigned)(ATT_TAB + (gi * 16 + head) * ATT_HS_B * 4);
            run_range(st, qf, Kl, Vl, kt_lo, kt_hi, ql, qmin, qmax, 128, tb_head, lds, h, gi == 0);
        }
        const float lt = st.l + __shfl_xor(st.l, 32), sc = 1.f / fmaxf(lt, 1e-30f);
        const f32x16 tot0 = st.o0 * sc, tot1 = st.o1 * sc;
        { unsigned char* op = ws + OFF_O + (tok * 1024 + head * 64 + 4 * h) * 2;
#pragma unroll
          for (int q = 0; q < 4; ++q) { u32x2 w; w.x = cvt_pk_bf16(tot0[4 * q], tot0[4 * q + 1]); w.y = cvt_pk_bf16(tot0[4 * q + 2], tot0[4 * q + 3]); *(u32x2*)(op + 16 * q) = w;
              u32x2 w2; w2.x = cvt_pk_bf16(tot1[4 * q], tot1[4 * q + 1]); w2.y = cvt_pk_bf16(tot1[4 * q + 2], tot1[4 * q + 3]); *(u32x2*)(op + 64 + 16 * q) = w2; } }
    }
}

__device__ __forceinline__ void phase_cmp2(unsigned char* ws, int gw, int NGW) {
    const int lane = threadIdx.x & 63;
    const int r = lane & 31, h = lane >> 5;
    for (int item = gw; item < 1024; item += NGW) {
        const int kv = item >> 9, rt = item & 511;
        const char* ap = (const char*)ws + OFF_G1 + (((size_t)kv * 16384 + rt * 32 + r) * 256 + 8 * h) * 2;
        const char* bp = (const char*)ws + OFF_W2 + (size_t)kv * 32768 + ((size_t)r * 256 + 8 * h) * 2;
        f32x16 a0 = {0.f, 0.f, 0.f, 0.f, 0.f, 0.f, 0.f, 0.f, 0.f, 0.f, 0.f, 0.f, 0.f, 0.f, 0.f, 0.f}, a1 = a0;
#pragma unroll
        for (int ks = 0; ks < 16; ++ks) { const bf16x8 a = *(const bf16x8*)(ap + 32 * ks);
            a0 = mfma32(a, *(const bf16x8*)(bp + 32 * ks), a0); a1 = mfma32(a, *(const bf16x8*)(bp + 32 * 256 * 2 + 32 * ks), a1); }
#pragma unroll
        for (int i = 0; i < 16; ++i) { const int row = rt * 32 + (i & 3) + 8 * (i >> 2) + 4 * h, gq = row & 3, n = (row >> 2) & 127, b = row >> 9, bgi = b * 4 + gq;
            if (kv == 0) { bf16_t* o = (bf16_t*)(ws + OFF_KCMP) + (size_t)bgi * 8192 + ((n >> 5) * 4 * 64 + (n & 31)) * 8;
                o[((r >> 4) * 64 + ((r >> 3) & 1) * 32) * 8 + (r & 7)] = f2bf(a0[i]); o[(((r >> 4) + 2) * 64 + ((r >> 3) & 1) * 32) * 8 + (r & 7)] = f2bf(a1[i]); }
            else { const int kk = n & 31, k16 = kk & 15; bf16_t* o = (bf16_t*)(ws + OFF_VCMPT) + (size_t)bgi * 8192 + (((n >> 5) * 4 + (kk >> 4)) * 64 + ((k16 >> 2) & 1) * 32 + r) * 8 + ((k16 >> 3) << 2) + (k16 & 3);
                o[0] = f2bf(a0[i]); o[2 * 64 * 8] = f2bf(a1[i]); } }
    }
}

__global__ __launch_bounds__(512, 2) void yoco_mega(Params p) {
    extern __shared__ __attribute__((aligned(16))) unsigned char shm[];
    cg::grid_group grid = cg::this_grid();
    LAS unsigned char* lds = (LAS unsigned char*)shm;
    const int tid = threadIdx.x, lane = tid & 63, wave = __builtin_amdgcn_readfirstlane(tid >> 6), gw = blockIdx.x * 8 + wave, NGW = gridDim.x * 8;
    unsigned char* ws = p.ws;
    const float* x_in = p.in[0];
    float* X = p.out;
    { LAS unsigned char* lut = lds + LDS_LUT; LAS float* bias2 = (LAS float*)(lds + LDS_BIAS);
      for (int d = tid; d < 2048; d += 512) { int bk = d; if (d >= 16) bk = 16 + (d >= 22) + (d >= 30) + (d >= 40) + (d >= 54) + (d >= 73) + (d >= 99) + (d >= 134) + (d >= 182) + (d >= 246) + (d >= 332) + (d >= 450) + (d >= 609) + (d >= 825) + (d >= 1117) + (d >= 1513); lut[d] = (unsigned char)bk; }
      bias2[tid] = p.in[1][tid] * LOG2E;
      if (tid < 4) ((LAS unsigned*)(lds + LDS_XB))[tid] = 0u;
      __syncthreads(); }
    const XcdBarrier xbar = xcd_barrier_post((unsigned*)(ws + OFF_XBAR), (volatile LAS unsigned*)(lds + LDS_XB));
    {
        LAS float* scr = (LAS float*)(lds + wave * 8448);
        const float* nm = p.in[2]; const float* nf = p.in[3];
        conv_weight(p.in[4], 1024, 2608, nm, (bf16_t*)(ws + OFF_WIN), 0, 0, scr, gw, NGW, lane);
        conv_weight(p.in[7], 2048, 256, nullptr, (bf16_t*)(ws + OFF_W1), 0, 0, scr, gw, NGW, lane);
        conv_weight(p.in[10], 2048, 256, nullptr, (bf16_t*)(ws + OFF_W1), 256, 0, scr, gw, NGW, lane);
        conv_weight(p.in[8], 256, 64, nullptr, (bf16_t*)(ws + OFF_W2), 0, 0, scr, gw, NGW, lane);
        conv_weight(p.in[11], 256, 64, nullptr, (bf16_t*)(ws + OFF_W2), 64, 0, scr, gw, NGW, lane);
        for (int item = gw; item < 512; item += NGW) { const int kv = item >> 8, ksl = (item >> 2) & 63, c = (item & 3) * 64 + lane;
            const float* pe = kv ? p.in[9] : p.in[6]; const float* w1 = kv ? p.in[10] : p.in[7]; float a = 0.f;
#pragma unroll 8
            for (int kk = ksl * 32; kk < ksl * 32 + 32; ++kk) a += pe[kk] * w1[(size_t)kk * 256 + c];
            ((float*)(ws + OFF_BIASP))[(kv * 64 + ksl) * 256 + c] = a; }
        cast_rows(x_in, (bf16_t*)(ws + OFF_H), (float*)(ws + OFF_SSQ), gw, NGW, lane);
    }
    grid.sync();
    pg8::StaticOrder S;
    float* const SSQ = (float*)(ws + OFF_SSQ);
    { pg8::Gemm g{(const char*)ws + OFF_H, (const char*)ws + OFF_WIN, 1024, 1024, 0, 0};
      { S.init(256, 9, gridDim.x, blockIdx.x, 1); EpiWin E{ws, p.in[5], SSQ}; pg8::gemm_phase<false>(lds, g, S, E, STAGGER, SSQ); }
      { S.init(256, 2, gridDim.x, blockIdx.x, 2); EpiV<0> E{ws, SSQ}; pg8::gemm_phase<true>(lds, g, S, E, 0, SSQ); }
      if (gw < 8) { const int o = gw * 64 + lane; const float* pp = (const float*)(ws + OFF_BIASP) + (o >> 8) * 64 * 256 + (o & 255); float a = 0.f;
#pragma unroll 8
          for (int q = 0; q < 64; ++q) a += pp[q * 256];
          ((float*)(ws + OFF_BIAS1))[o] = a; } }
    xcd_barrier(xbar);
    { pg8::Gemm g{(const char*)ws + OFF_BRA, (const char*)ws + OFF_W1, 2048, 0, 1, 32 * MiB}; S.init(64, 2, gridDim.x, blockIdx.x); EpiCmp1 E{ws}; pg8::gemm_phase<false>(lds, g, S, E); }
    if (blockIdx.x >= 128) { LAS float* scr = (LAS float*)(lds + wave * 8448); const float* nm = p.in[2]; const float* nf = p.in[3];
        const int gw2 = (blockIdx.x - 128) * 8 + wave, NGW2 = (gridDim.x - 128) * 8;
            conv_weight(p.in[12], 1024, 1024, nullptr, (bf16_t*)(ws + OFF_WOUTA), 0, 0, scr, gw2, NGW2, lane);
            conv_weight(p.in[15], 1024, 3072, nm + 1024, (bf16_t*)(ws + OFF_WQKVB), 0, 0, scr, gw2, NGW2, lane);
            conv_weight(p.in[14], 1024, 1536, p.in[13], (bf16_t*)(ws + OFF_WQKVB), 3072, 0, scr, gw2, NGW2, lane);
            conv_weight(p.in[16], 1024, 1024, nullptr, (bf16_t*)(ws + OFF_WOUTB), 0, 0, scr, gw2, NGW2, lane);
            conv_weight(p.in[17], 1024, 5632, nf, (bf16_t*)(ws + OFF_WUP0), 0, 1, scr, gw2, NGW2, lane);
            conv_weight(p.in[17] + (size_t)1024 * 5632, 1024, 5632, nf + 1024, (bf16_t*)(ws + OFF_WUP1), 0, 1, scr, gw2, NGW2, lane);
            conv_weight(p.in[18], 2816, 1024, nullptr, (bf16_t*)(ws + OFF_WDN0), 0, 0, scr, gw2, NGW2, lane);
            conv_weight(p.in[18] + (size_t)2816 * 1024, 2816, 1024, nullptr, (bf16_t*)(ws + OFF_WDN1), 0, 0, scr, gw2, NGW2, lane);
    }
    xcd_barrier(xbar);
    phase_cmp2(ws, gw, NGW);
    xcd_barrier(xbar);
    if (__builtin_amdgcn_readfirstlane(threadIdx.x) >= 256) __builtin_amdgcn_s_setprio(1);
    phaseA_attn(ws, lds, gw, NGW);
    __builtin_amdgcn_s_setprio(0);
    xcd_barrier(xbar);
    { pg8::Gemm g{(const char*)ws + OFF_O, (const char*)ws + OFF_WOUTA, 1024, 1024, 0, 0}; S.init(256, 4, gridDim.x, blockIdx.x); EpiResid<0> E{x_in, ws + OFF_H, SSQ + 16 * T_TOK}; pg8::gemm_phase<false>(lds, g, S, E, STAGGER); }
    xcd_barrier(xbar);
    { pg8::Gemm g{(const char*)ws + OFF_H, (const char*)ws + OFF_WUP0, 1024, 1024, 0, 0}; S.init(256, 22, gridDim.x, blockIdx.x); EpiSwiglu E{ws + OFF_ACT, SSQ + 16 * T_TOK}; pg8::gemm_phase<false>(lds, g, S, E, STAGGER, SSQ + 16 * T_TOK); }
    xcd_barrier(xbar);
    { pg8::Gemm g{(const char*)ws + OFF_ACT, (const char*)ws + OFF_WDN0, 2816, 2816, 0, 0}; S.init(256, 4, gridDim.x, blockIdx.x); EpiResid<1> E{x_in, ws + OFF_H, SSQ + 32 * T_TOK}; pg8::gemm_phase<false>(lds, g, S, E, STAGGER); }
    xcd_barrier(xbar);
    { pg8::Gemm g{(const char*)ws + OFF_H, (const char*)ws + OFF_WQKVB, 1024, 1024, 0, 0};
      { S.init(256, 15, gridDim.x, blockIdx.x, 3); EpiQKVB E{ws, SSQ + 32 * T_TOK}; pg8::gemm_phase<false>(lds, g, S, E, STAGGER, SSQ + 32 * T_TOK); }
      { S.init(256, 3, gridDim.x, blockIdx.x, 4); EpiV<1> E{ws, SSQ + 32 * T_TOK}; pg8::gemm_phase<true>(lds, g, S, E, 0, SSQ + 32 * T_TOK); } }
    xcd_barrier(xbar);
    if (__builtin_amdgcn_readfirstlane(threadIdx.x) >= 256) __builtin_amdgcn_s_setprio(1);
    phaseB_attn(ws, lds, gw, NGW);
    __builtin_amdgcn_s_setprio(0);
    xcd_barrier(xbar);
    { pg8::Gemm g{(const char*)ws + OFF_O, (const char*)ws + OFF_WOUTB, 1024, 1024, 0, 0}; S.init(256, 4, gridDim.x, blockIdx.x); EpiResid<1> E{x_in, ws + OFF_H, SSQ + 48 * T_TOK}; pg8::gemm_phase<false>(lds, g, S, E, STAGGER); }
    xcd_barrier(xbar);
    { pg8::Gemm g{(const char*)ws + OFF_H, (const char*)ws + OFF_WUP1, 1024, 1024, 0, 0}; S.init(256, 22, gridDim.x, blockIdx.x); EpiSwiglu E{ws + OFF_ACT, SSQ + 48 * T_TOK}; pg8::gemm_phase<false>(lds, g, S, E, STAGGER, SSQ + 48 * T_TOK); }
    xcd_barrier(xbar);
    { pg8::Gemm g{(const char*)ws + OFF_ACT, (const char*)ws + OFF_WDN1, 2816, 2816, 0, 0}; S.init(256, 4, gridDim.x, blockIdx.x); EpiResid<2> E{x_in, ws + OFF_H, SSQ}; pg8::gemm_phase<false>(lds, g, S, E, STAGGER); }
    xcd_barrier(xbar);
    final_norm_rows((const bf16_t*)(ws + OFF_H), X, p.in[19], gw, NGW);
}

extern "C" void kernel_launch(void* const* d_in, const int* in_sizes, int n_in, void* d_out, int out_size, void* d_ws, size_t ws_size, hipStream_t stream) {
    static int grid_blocks = 0;
    if (grid_blocks == 0) {
        if (n_in != 20 || out_size != T_TOK * DM || ws_size < WS_NEED) { fprintf(stderr, "kernel_launch: unexpected shapes (n_in %d out %d ws %zu)\n", n_in, out_size, ws_size); grid_blocks = -1; return; }
        int dev = 0, cus = 0, per_cu = 0;
        hipGetDevice(&dev); hipDeviceGetAttribute(&cus, hipDeviceAttributeMultiprocessorCount, dev);
        if (hipFuncSetAttribute((const void*)yoco_mega, hipFuncAttributeMaxDynamicSharedMemorySize, LDS_TOTAL) != hipSuccess) { fprintf(stderr, "kernel_launch: hipFuncSetAttribute failed\n"); grid_blocks = -1; return; }
        if (hipOccupancyMaxActiveBlocksPerMultiprocessor(&per_cu, (const void*)yoco_mega, 512, LDS_TOTAL) != hipSuccess || per_cu < 1) { fprintf(stderr, "kernel_launch: occupancy query gave %d\n", per_cu); per_cu = 1; }
        (void)hipGetLastError();
        grid_blocks = cus >= 256 ? 256 : cus;
        if (grid_blocks != 256) { fprintf(stderr, "kernel_launch: built for a 256-CU device (found %d CUs)\n", cus); grid_blocks = -1; return; }
    }
    if (grid_blocks < 0) return;
    if (hipMemsetAsync((unsigned char*)d_ws + OFF_XBAR, 0, XCD_BAR_WORDS * 4, stream) != hipSuccess) { fprintf(stderr, "kernel_launch: memset of the barrier words failed\n"); return; }
    Params p{};
    for (int i = 0; i < 20; ++i) p.in[i] = (const float*)d_in[i];
    p.out = (float*)d_out; p.ws = (unsigned char*)d_ws;
    void* args[] = {&p};
    hipError_t e = hipLaunchCooperativeKernel((const void*)yoco_mega, dim3(grid_blocks), dim3(512), args, LDS_TOTAL, stream);
    if (e != hipSuccess) fprintf(stderr, "cooperative launch failed: %s (grid %d)\n", hipGetErrorString(e), grid_blocks);
}
```

```cpp
#include <hip/hip_runtime.h>
#include <hip/hip_cooperative_groups.h>
#include <cstdio>
namespace cg = cooperative_groups;

#define LAS __attribute__((address_space(3)))
typedef unsigned short bf16_t;
typedef short bf16x8 __attribute__((ext_vector_type(8)));
typedef float f32x4 __attribute__((ext_vector_type(4)));
typedef float f32x16 __attribute__((ext_vector_type(16)));
typedef unsigned u32x4 __attribute__((ext_vector_type(4)));
typedef unsigned u32x2 __attribute__((ext_vector_type(2)));
typedef unsigned long long u64;

constexpr int T_TOK = 65536, DM = 1024, SEQ = 2048, FFH = 2816;
constexpr size_t MiB = 1ull << 20;
constexpr size_t OFF_WIN = 0, OFF_WOUTA = 6 * MiB, OFF_WUP0 = 8 * MiB, OFF_WUP1 = 19 * MiB, OFF_WDN0 = 30 * MiB, OFF_WDN1 = 36 * MiB,
                 OFF_WQKVB = 42 * MiB, OFF_WOUTB = 51 * MiB, OFF_W1 = 53 * MiB  , OFF_W2 = 55 * MiB  ,
                 OFF_BIASP = 55 * MiB + 128 * 1024  , OFF_BIAS1 = 55 * MiB + 512 * 1024  , OFF_XBAR = 55 * MiB + 768 * 1024  , OFF_KCMP = 56 * MiB, OFF_VCMPT = 58 * MiB, OFF_GATE = 60 * MiB,
                 OFF_SSQ = 330 * MiB + 600 * MiB  , OFF_H = 74 * MiB,
                 OFF_O = 202 * MiB, OFF_BIG = 330 * MiB, WS_NEED = 1024 * MiB;
constexpr size_t OFF_QA = OFF_BIG, OFF_BRA = OFF_BIG + 128 * MiB  , OFF_ACT = OFF_BIG,
                 OFF_QB = OFF_BIG, OFF_KVB = OFF_BIG + 384 * MiB  , OFF_G1 = OFF_O;
constexpr int LDS_STAGE = 131072, LDS_NEG = 132608  , LDS_LUT = 133120, LDS_BIAS = LDS_LUT + 2048, LDS_XB = LDS_BIAS + 2048  , LDS_RS = LDS_XB + 16  , LDS_TOTAL = LDS_RS + 8192;
constexpr int STAGGER = 0;
constexpr float LOG2E = 1.4426950408889634f;
constexpr float SC2 = 0.125f * LOG2E;

struct Params { const float* in[20]; float* out; unsigned char* ws; };

__device__ __forceinline__ unsigned cvt_pk_bf16(float lo, float hi) { unsigned r; asm volatile("v_cvt_pk_bf16_f32 %0, %1, %2" : "=v"(r) : "v"(lo), "v"(hi)); return r; }
__device__ __forceinline__ bf16_t f2bf(float f) { return (bf16_t)(cvt_pk_bf16(f, 0.f) & 0xffffu); }
__device__ __forceinline__ u32x4 pack8(f32x4 a, f32x4 b) { u32x4 o; o.x = cvt_pk_bf16(a[0], a[1]); o.y = cvt_pk_bf16(a[2], a[3]); o.z = cvt_pk_bf16(b[0], b[1]); o.w = cvt_pk_bf16(b[2], b[3]); return o; }
__device__ __forceinline__ float fexp2(float x) { return __builtin_amdgcn_exp2f(x); }
__device__ __forceinline__ float frcp(float x) { return __builtin_amdgcn_rcpf(x); }
__device__ __forceinline__ float sigmoidf_(float x) { return frcp(1.f + fexp2(-x * LOG2E)); }
__device__ __forceinline__ float wave_sum(float v) {
#pragma unroll
    for (int o = 1; o < 64; o <<= 1) v += __shfl_xor(v, o);
    return v;
}
__device__ __forceinline__ f32x16 mfma32(bf16x8 a, bf16x8 b, f32x16 c) { return __builtin_amdgcn_mfma_f32_32x32x16_bf16(a, b, c, 0, 0, 0); }
#define LDS_WAIT() asm volatile("s_waitcnt lgkmcnt(0)" ::: "memory")

#define XB_TMO      128
#define XB_XCNT(j)  (256  + 64 * (j))
#define XB_XSUB(j)  (1280 + 64 * (j))
#define XB_XGEN(j)  (2304 + 64 * (j))
#define XB_TOP      3328
#define XB_TOPGEN   3392
#define XCD_BAR_WORDS 3456
#define XB_SPIN_CAP (1u << 18)
__device__ __forceinline__ unsigned xb_ld(unsigned* p)              { return __hip_atomic_load(p, __ATOMIC_RELAXED, __HIP_MEMORY_SCOPE_AGENT); }
__device__ __forceinline__ unsigned xb_add(unsigned* p, unsigned v) { return __hip_atomic_fetch_add(p, v, __ATOMIC_RELAXED, __HIP_MEMORY_SCOPE_AGENT); }
__device__ __forceinline__ unsigned xb_xcc_id() { return (unsigned)__builtin_amdgcn_s_getreg((3 << 11) | 20) & 0xFu; }
#define XB_SPIN(cond, bar) do { unsigned _sp = 0; while (cond) { __builtin_amdgcn_s_sleep(1); \
    if ((++_sp & 255u) == 0u) { if (xb_ld(&(bar)[XB_TMO])) break; if (_sp > XB_SPIN_CAP) { atomicAdd(&(bar)[XB_TMO], 1u); break; } } } } while (0)
struct XcdBarrier { unsigned* bar; unsigned x; volatile LAS unsigned* st; };
__device__ __forceinline__ XcdBarrier xcd_barrier_post(unsigned* bar, volatile LAS unsigned* st) {
    XcdBarrier b; b.bar = bar; b.x = xb_xcc_id(); b.st = st;
    if (threadIdx.x == 0) (void)xb_add(&bar[XB_XCNT(b.x)], 1u);
    return b;
}
__device__ __forceinline__ void xcd_barrier_complete(unsigned* bar, unsigned x, unsigned& nloc, unsigned& nx) {
    const unsigned G = gridDim.x * gridDim.y * gridDim.z;
    unsigned sum, cnt, mine, sp = 0u;
    for (;;) {
        sum = 0u; cnt = 0u; mine = 0u;
#pragma unroll
        for (unsigned j = 0; j < 16; ++j) { const unsigned c = xb_ld(&bar[XB_XCNT(j)]); sum += c; cnt += (c > 0u) ? 1u : 0u; mine = (j == x) ? c : mine; }
        if (sum == G) break;
        __builtin_amdgcn_s_sleep(1);
        if ((++sp & 255u) == 0u) { if (xb_ld(&bar[XB_TMO])) break; if (sp > XB_SPIN_CAP) { atomicAdd(&bar[XB_TMO], 1u); break; } }
    }
    nloc = mine > 0u ? mine : 1u; nx = cnt > 0u ? cnt : 1u;
}
__device__ __forceinline__ void xcd_barrier(const XcdBarrier& b) {
    asm volatile("s_waitcnt vmcnt(0)" ::: "memory");
    __syncthreads();
    if (threadIdx.x == 0) {
        unsigned* bar = b.bar;
        __builtin_amdgcn_s_waitcnt(0);
        unsigned nloc = b.st[0], nx = b.st[1];
        if (nloc == 0u) { xcd_barrier_complete(bar, b.x, nloc, nx); b.st[0] = nloc; b.st[1] = nx; }
        const unsigned old = xb_add(&bar[XB_XSUB(b.x)], 1u);
        const unsigned gen = old / nloc;
        if (old + 1u == (gen + 1u) * nloc) {
            __builtin_amdgcn_fence(__ATOMIC_RELEASE, "agent");
            asm volatile("s_waitcnt vmcnt(0)" ::: "memory");
            const unsigned og = xb_add(&bar[XB_TOP], 1u);
            const unsigned tg = og / nx;
            if (og + 1u == (tg + 1u) * nx) xb_add(&bar[XB_TOPGEN], 1u);
            else XB_SPIN(xb_ld(&bar[XB_TOPGEN]) == tg, bar);
            __builtin_amdgcn_fence(__ATOMIC_ACQUIRE, "agent");
            xb_add(&bar[XB_XGEN(b.x)], 1u);
            asm volatile("s_waitcnt vmcnt(0)" ::: "memory");
        } else {
            XB_SPIN(xb_ld(&bar[XB_XGEN(b.x)]) == gen, bar);
            __builtin_amdgcn_fence(__ATOMIC_ACQUIRE, "agent");
            asm volatile("s_waitcnt vmcnt(0)" ::: "memory");
        }
    }
    __syncthreads();
}

namespace pg8 {
constexpr int BM = 256, BK = 64, HALF = 128, HTB = HALF * BK * 2, NXCD = 8, WGM = 8;
__device__ __forceinline__ int lds_byte(int r, int c) { const int st = (r >> 4) * 2 + (c >> 5), rr = r & 15, cc = c & 31, ob = rr * 64 + cc * 2; return st * 1024 + (ob ^ (((ob >> 9) & 1) << 5)); }
__device__ __forceinline__ void stage_rc(int b, int& R, int& C) { const int st = b / 1024, sb = b % 1024, swz = sb ^ (((sb >> 9) & 1) << 5); R = (st >> 1) * 16 + swz / 64; C = (st & 1) * 32 + (swz % 64) / 2; }
__device__ __forceinline__ int perm32(int rho) { const int n = rho >> 4, i = rho & 15; return 8 * (i >> 2) + 4 * n + (i & 3); }
struct Unit { int pm, pn; };
struct Gemm { const char* A; const char* Bt; int K; int lda; int amode; size_t a_pn_step; };
struct StaticOrder {
    int nM, nN, nwg, G, c, map;
    __device__ void init(int nM_, int nN_, int G_, int c_, int map_ = 0) { nM = nM_; nN = nN_; nwg = nM * nN; G = G_; c = c_; map = map_; }
    __device__ bool next(int i, Unit& u) const {
        const long L = (long)i * G + c; if (L >= nwg) return false;
        int wgid = (int)L; { const int q = nwg / NXCD, r = nwg % NXCD, xcd = wgid % NXCD, off = wgid / NXCD; wgid = (xcd < r ? xcd * (q + 1) : r * (q + 1) + (xcd - r) * q) + off; }
        const int nig = WGM * nN, gid = wgid / nig, fm = gid * WGM, gsz = (nM - fm) < WGM ? (nM - fm) : WGM;
        u.pm = fm + ((wgid % nig) % gsz); int pn = (wgid % nig) / gsz;
        if (map == 1) pn = pn < 7 ? pn : (pn == 7 ? 8 : 10); else if (map == 2) pn = 7 + 2 * pn; else if (map == 3) pn = pn < 12 ? pn : 12 + 2 * (pn - 12); else if (map == 4) pn = 13 + 2 * pn;
        u.pn = pn; return true;
    }
};

template <bool SWAP = false, class Epi>
__device__ __forceinline__ void gemm_phase(LAS unsigned char* lds, const Gemm g, const StaticOrder& S, const Epi& E, int stagger = 0, const float* ssq = nullptr) {
    if (stagger > 0) { const unsigned long long t0 = __builtin_amdgcn_s_memrealtime(), dl = (unsigned long long)((blockIdx.x >> 3) * stagger);
        while (__builtin_amdgcn_s_memrealtime() - t0 < dl) __builtin_amdgcn_s_sleep(4); }
    int tid = threadIdx.x; asm volatile("" : "+v"(tid));
    const int wid = __builtin_amdgcn_readfirstlane(tid >> 6), lane = tid & 63, wr = wid >> 2, wc = wid & 3, fr = lane & 15, fq = lane >> 4;
    const int K = g.K, nt = K / BK;
    unsigned voffA[2], voffB[2];
#pragma unroll
    for (int i = 0; i < 2; ++i) { int R, C; stage_rc(tid * 16 + i * 8192, R, C); const int Rb = SWAP ? R : (R & ~31) + perm32(R & 31);
        voffA[i] = g.amode ? (unsigned)((R >> 2) * 8192 + (R & 3) * 128 + C * 2) : (unsigned)(R * g.lda + C) * 2u;
        voffB[i] = (unsigned)(Rb * K + C) * 2u; }
    const size_t kstepA = g.amode ? 512 : (size_t)(BK * 2), kstepB = (size_t)(BK * 2);
    const size_t hstepA = g.amode ? (size_t)262144 : (size_t)HALF * g.lda * 2, hstepB = (size_t)HALF * K * 2;
    const size_t tstepA = 2 * hstepA, tstepB = 2 * hstepB;
    const unsigned ldsw = (unsigned)wid * 1024u;
    const int aoff = lds_byte(wr * 64 + fr, fq * 8), boff = lds_byte(wc * 32 + fr, fq * 8);
#define PG8_SA(b, h) (((b) * 2 + (h)) * HTB)
#define PG8_SB(b, h) ((4 + (b) * 2 + (h)) * HTB)
#define PG8_STAGE(bufoff, gbase, voff) do { _Pragma("unroll") for (int _i = 0; _i < 2; ++_i) \
        __builtin_amdgcn_global_load_lds((const unsigned*)((const char*)(gbase) + (voff)[_i]), (LAS unsigned*)(lds + (bufoff) + ldsw + _i * 8192), 16, 0, 0); } while (0)
#define PG8_LDA(dst, b, h) do { _Pragma("unroll") for (int m = 0; m < 4; ++m) _Pragma("unroll") for (int k = 0; k < 2; ++k) dst[m][k] = *(const LAS bf16x8*)(lds + PG8_SA(b, h) + aoff + m * 2048 + k * 1024); } while (0)
#define PG8_LDB(dst, b, h) do { _Pragma("unroll") for (int n = 0; n < 2; ++n) _Pragma("unroll") for (int k = 0; k < 2; ++k) dst[n][k] = *(const LAS bf16x8*)(lds + PG8_SB(b, h) + boff + n * 2048 + k * 1024); } while (0)
#define PG8_MMA(ai, bj, At, Bt) do { __builtin_amdgcn_s_setprio(1); _Pragma("unroll") for (int m = 0; m < 4; ++m) _Pragma("unroll") for (int n = 0; n < 2; ++n) _Pragma("unroll") for (int k = 0; k < 2; ++k) \
        acc[ai][bj][m][n] = SWAP ? __builtin_amdgcn_mfma_f32_16x16x32_bf16(At[m][k], Bt[n][k], acc[ai][bj][m][n], 0, 0, 0) : __builtin_amdgcn_mfma_f32_16x16x32_bf16(Bt[n][k], At[m][k], acc[ai][bj][m][n], 0, 0, 0); __builtin_amdgcn_s_setprio(0); } while (0)
#define PG8_WAIT_V(n) asm volatile("s_waitcnt vmcnt(" #n ")" ::: "memory")
#define PG8_WAIT_L(n) asm volatile("s_waitcnt lgkmcnt(" #n ")" ::: "memory")
#define PG8_BAR __builtin_amdgcn_s_barrier()
#define PG8_SCHED __builtin_amdgcn_sched_barrier(0)
    Unit cur, nxt; int ui = 0, slot = 0;
    if (!S.next(0, cur)) return;
    if (ssq) {
        Unit u; int sl = 0, ppm = cur.pm;
        for (int i = 0; S.next(i, u); ++i) { if (i == 0 || u.pm != ppm) { if (i) ++sl; ppm = u.pm;
                const unsigned char* sp = (const unsigned char*)(ssq + ((size_t)u.pm * 256 + (tid >> 1)) * 16) + (tid & 1) * 32;
                const f32x4 a = *(const f32x4*)sp, b = *(const f32x4*)(sp + 16); float v = ((a[0] + a[1]) + (a[2] + a[3])) + ((b[0] + b[1]) + (b[2] + b[3])); v += __shfl_xor(v, 1);
                if (!(tid & 1)) ((LAS float*)(lds + LDS_RS))[(sl & 7) * 256 + (tid >> 1)] = 1.f / sqrtf(v * (1.f / DM) + 1e-6f); } }
        __syncthreads(); }
    f32x4 acc[2][2][4][2];
#pragma unroll
    for (int a = 0; a < 2; ++a)
#pragma unroll
        for (int b = 0; b < 2; ++b)
#pragma unroll
            for (int m = 0; m < 4; ++m)
#pragma unroll
                for (int n = 0; n < 2; ++n) acc[a][b][m][n] = (f32x4){0.f, 0.f, 0.f, 0.f};
    bf16x8 At[4][2], B0[2][2], B1[2][2];
    const char* cA = g.A + (size_t)cur.pm * tstepA + (size_t)cur.pn * g.a_pn_step; const char* cB = g.Bt + (size_t)cur.pn * tstepB;
    PG8_STAGE(PG8_SB(0, 0), cB, voffB); PG8_STAGE(PG8_SA(0, 0), cA, voffA); PG8_STAGE(PG8_SB(0, 1), cB + hstepB, voffB); PG8_STAGE(PG8_SA(0, 1), cA + hstepA, voffA);
    if (wr == 1) PG8_BAR;
    PG8_WAIT_V(4); PG8_BAR;
    PG8_STAGE(PG8_SB(1, 0), cB + kstepB, voffB); PG8_STAGE(PG8_SA(1, 0), cA + kstepA, voffA); PG8_STAGE(PG8_SB(1, 1), cB + hstepB + kstepB, voffB);
    PG8_WAIT_V(6); PG8_BAR;
    for (;;) {
        const bool has_next = S.next(ui + 1, nxt);
        const char* nA = has_next ? g.A + (size_t)nxt.pm * tstepA + (size_t)nxt.pn * g.a_pn_step : cA; const char* nB = has_next ? g.Bt + (size_t)nxt.pn * tstepB : cB;
        for (int t = 0; t < nt; t += 2) {
            const bool last = (t == nt - 2);
            const char* a1 = cA + (size_t)(t + 1) * kstepA;
            const char* a2 = last ? nA : cA + (size_t)(t + 2) * kstepA; const char* b2 = last ? nB : cB + (size_t)(t + 2) * kstepB;
            const char* a3 = a2 + kstepA; const char* b3 = b2 + kstepB;
            PG8_LDB(B0, 0, 0); PG8_SCHED; PG8_LDA(At, 0, 0); PG8_STAGE(PG8_SA(1, 1), a1 + hstepA, voffA);
            PG8_WAIT_L(8); PG8_BAR; PG8_WAIT_L(0); PG8_MMA(0, 0, At, B0); PG8_BAR; PG8_SCHED;
            PG8_LDB(B1, 0, 1); PG8_STAGE(PG8_SB(0, 0), b2, voffB);
            PG8_BAR; PG8_WAIT_L(0); PG8_MMA(0, 1, At, B1); PG8_BAR;
            PG8_LDA(At, 0, 1); PG8_STAGE(PG8_SA(0, 0), a2, voffA);
            PG8_BAR; PG8_WAIT_L(0); PG8_MMA(1, 0, At, B0); PG8_BAR; PG8_SCHED;
            PG8_STAGE(PG8_SB(0, 1), b2 + hstepB, voffB);
            PG8_WAIT_V(6); PG8_BAR; PG8_MMA(1, 1, At, B1); PG8_BAR;
            PG8_LDB(B0, 1, 0); PG8_SCHED; PG8_LDA(At, 1, 0); PG8_STAGE(PG8_SA(0, 1), a2 + hstepA, voffA);
            PG8_WAIT_L(8); PG8_BAR; PG8_WAIT_L(0); PG8_MMA(0, 0, At, B0); PG8_BAR; PG8_SCHED;
            PG8_LDB(B1, 1, 1); PG8_STAGE(PG8_SB(1, 0), b3, voffB);
            PG8_BAR; PG8_WAIT_L(0); PG8_MMA(0, 1, At, B1); PG8_BAR;
            PG8_LDA(At, 1, 1); PG8_STAGE(PG8_SA(1, 0), a3, voffA);
            PG8_BAR; PG8_WAIT_L(0); PG8_MMA(1, 0, At, B0); PG8_BAR; PG8_SCHED;
            PG8_STAGE(PG8_SB(1, 1), b3 + hstepB, voffB);
            PG8_WAIT_V(6); PG8_BAR; PG8_MMA(1, 1, At, B1); PG8_BAR;
        }
        E(acc, cur, wr, wc, fr, fq, (const LAS float*)(lds + LDS_RS) + (slot & 7) * 256);
        if (!has_next) break;
#pragma unroll
        for (int a = 0; a < 2; ++a)
#pragma unroll
            for (int b = 0; b < 2; ++b)
#pragma unroll
                for (int m = 0; m < 4; ++m)
#pragma unroll
                    for (int n = 0; n < 2; ++n) acc[a][b][m][n] = (f32x4){0.f, 0.f, 0.f, 0.f};
        slot += (nxt.pm != cur.pm) ? 1 : 0; cur = nxt; cA = nA; cB = nB; ++ui;
    }
    PG8_WAIT_V(0);
    if (wr == 0) PG8_BAR;
    PG8_BAR;
#undef PG8_SA
#undef PG8_SB
#undef PG8_STAGE
#undef PG8_LDA
#undef PG8_LDB
#undef PG8_MMA
#undef PG8_WAIT_V
#undef PG8_WAIT_L
#undef PG8_BAR
#undef PG8_SCHED
}
}
using pg8::Unit;
typedef f32x4 Acc[2][2][4][2];

#define OPAQUE(v) asm volatile("" : "+v"(v))
__device__ __forceinline__ void load_row_rs(float (&rv)[2], const unsigned char* sp, int wr, int fr, int fq);
__device__ __forceinline__ float row_rs(float ssq) { return 1.f / sqrtf(ssq * (1.f / DM) + 1e-6f); }
__device__ __forceinline__ float row_rs16(const unsigned char* p) { const f32x4 a = *(const f32x4*)p, b = *(const f32x4*)(p + 16), c = *(const f32x4*)(p + 32), d = *(const f32x4*)(p + 48);
    return row_rs(((a[0] + a[1]) + (a[2] + a[3])) + ((b[0] + b[1]) + (b[2] + b[3])) + ((c[0] + c[1]) + (c[2] + c[3])) + ((d[0] + d[1]) + (d[2] + d[3]))); }
__device__ __forceinline__ void load_row_rs(float (&rv)[2], const unsigned char* sp, int wr, int fr, int fq) {
    unsigned so = (unsigned)(wr * 64 + fq * 16 + fr) * 64u; OPAQUE(so);
    rv[0] = row_rs16(sp + so); rv[1] = row_rs16(sp + (so + 128u * 64u));
}
struct EpiWin {
    unsigned char* ws; const float* b_gate; const float* ssq;
    __device__ __forceinline__ void operator()(const Acc& acc, const Unit& u, int wr, int wc, int fr, int fq, const LAS float* rsl) const {
        const int pn = u.pn; unsigned rl = wr * 64 + fr, cw = wc * 32 + 8 * fq; OPAQUE(rl); OPAQUE(cw); const size_t rowt = (size_t)u.pm * 256;
        float rs[2][4];
#pragma unroll
        for (int ai = 0; ai < 2; ++ai)
#pragma unroll
            for (int m = 0; m < 4; ++m) rs[ai][m] = rsl[ai * 128 + wr * 64 + m * 16 + fr];
        if (pn < 4) {
            unsigned char* base = ws + OFF_QA + (rowt * 1024 + pn * 256) * 2; unsigned lo = (rl * 1024 + cw) * 2; OPAQUE(lo);
#pragma unroll
            for (int ai = 0; ai < 2; ++ai)
#pragma unroll
                for (int m = 0; m < 4; ++m)
#pragma unroll
                    for (int bj = 0; bj < 2; ++bj) *(u32x4*)(base + (lo + (unsigned)(((ai * 128 + m * 16) * 1024 + bj * 128) * 2))) = pack8(acc[ai][bj][m][0] * rs[ai][m], acc[ai][bj][m][1] * rs[ai][m]);
        } else if (pn < 10) {
            const int br = pn - 4; const int b = u.pm >> 3, tb = (u.pm & 7) * 8;
            if (br == 2 || br == 4) {
                unsigned char* base = ws + OFF_BRA + (size_t)br * 32 * MiB + ((size_t)b * 4 * 2048 * 64 + (size_t)tb * 2048) * 2;
                unsigned lo = ((cw >> 6) * 2048 * 64 + ((wr * 8 + ((cw & 63) >> 4)) * 64 + ((cw >> 3) & 1) * 32 + fr) * 8) * 2; OPAQUE(lo);
#pragma unroll
                for (int ai = 0; ai < 2; ++ai)
#pragma unroll
                    for (int m = 0; m < 4; ++m)
#pragma unroll
                        for (int bj = 0; bj < 2; ++bj) *(u32x4*)(base + (lo + (unsigned)((bj * 2 * 2048 * 64 + ((ai * 4 + (m >> 1)) * 4 * 64 + (m & 1) * 16) * 8) * 2))) = pack8(acc[ai][bj][m][0] * rs[ai][m], acc[ai][bj][m][1] * rs[ai][m]);
            } else {
                unsigned char* base = ws + OFF_BRA + (size_t)br * 32 * MiB + rowt * 256 * 2; unsigned lo = (rl * 256 + cw) * 2; OPAQUE(lo);
#pragma unroll
                for (int ai = 0; ai < 2; ++ai)
#pragma unroll
                    for (int m = 0; m < 4; ++m)
#pragma unroll
                        for (int bj = 0; bj < 2; ++bj) *(u32x4*)(base + (lo + (unsigned)(((ai * 128 + m * 16) * 256 + bj * 128) * 2))) = pack8(acc[ai][bj][m][0] * rs[ai][m], acc[ai][bj][m][1] * rs[ai][m]);
            }
        } else {
            if (cw < 48) {
                unsigned char* base = ws + OFF_GATE + rowt * 48 * 4; unsigned lo = (rl * 48 + cw) * 4; OPAQUE(lo);
                float bg[8];
#pragma unroll
                for (int e = 0; e < 8; ++e) bg[e] = (cw + e < 48) ? b_gate[cw + e] : 0.f;
#pragma unroll
                for (int ai = 0; ai < 2; ++ai)
#pragma unroll
                    for (int m = 0; m < 4; ++m) { const f32x4 v0 = acc[ai][0][m][0] * rs[ai][m], v1 = acc[ai][0][m][1] * rs[ai][m];
#pragma unroll
                        for (int e = 0; e < 4; ++e) { if (cw + e < 48) *(float*)(base + (lo + (unsigned)(((ai * 128 + m * 16) * 48 + e) * 4))) = sigmoidf_(v0[e] + bg[e]);
                            if (cw + 4 + e < 48) *(float*)(base + (lo + (unsigned)(((ai * 128 + m * 16) * 48 + e + 4) * 4))) = sigmoidf_(v1[e] + bg[4 + e]); } }
            }
        }
    }
};
template <int LAYER>
struct EpiV {
    unsigned char* ws; const float* ssq;
    __device__ __forceinline__ void operator()(const Acc& acc, const Unit& u, int wr, int wc, int fr, int fq, const LAS float* rsl) const {
        const int pn = u.pn, b = u.pm >> 3; const size_t rowt = (size_t)u.pm * 256;
        const int idx = LAYER ? pn - 12 : 0, dsh = LAYER ? 2 * (idx >> 1) : 0, lsh = 11 - dsh;
        unsigned char* base = ws + (LAYER ? OFF_KVB + (size_t)idx * 32 * MiB : OFF_BRA + (size_t)(pn - 4) * 32 * MiB) + ((size_t)b * 4 * 2048 * 64) * 2;
        unsigned lo = ((wc >> 1) * 2048 * 64 + ((wc & 1) * 128 + fr) * 8) * 2; OPAQUE(lo);
        f32x4 rsv[2][4];
#pragma unroll
        for (int ai = 0; ai < 2; ++ai)
#pragma unroll
            for (int m = 0; m < 4; ++m) rsv[ai][m] = *(const LAS f32x4*)(rsl + ai * 128 + wr * 64 + m * 16 + 4 * fq);
        if (dsh == 0) {
            const unsigned tb = (u.pm & 7) * 8;
            unsigned lk = (((tb + wr * 2) * 4) * 64 + (fq & 1) * 32) * 16 + (fq >> 1) * 8; OPAQUE(lk);
#pragma unroll
            for (int ai = 0; ai < 2; ++ai)
#pragma unroll
                for (int m = 0; m < 4; ++m) { const f32x4 rs = rsv[ai][m];
#pragma unroll
                    for (int bj = 0; bj < 2; ++bj)
#pragma unroll
                        for (int n = 0; n < 2; ++n) { const f32x4 v = acc[ai][bj][m][n] * rs; u32x2 w; w.x = cvt_pk_bf16(v[0], v[1]); w.y = cvt_pk_bf16(v[2], v[3]);
                            *(u32x2*)(base + (lo + lk + (unsigned)((bj * 2 * 2048 * 64 + ((((ai * 4 + (m >> 1)) * 4 + (m & 1)) * 64) + 16 * n) * 8) * 2))) = w; }
                    __builtin_amdgcn_sched_barrier(0); }
        } else {
            const unsigned sb = ((u.pm & 7) * 256) >> dsh; unsigned slb = wr * 64 + 4 * fq; OPAQUE(slb);
#pragma unroll
            for (int ai = 0; ai < 2; ++ai)
#pragma unroll
                for (int m = 0; m < 4; ++m) {
#pragma unroll
                    for (int j = 0; j < 4; ++j) { const float rs = rsv[ai][m][j]; const unsigned sl = slb + (unsigned)(ai * 128 + m * 16 + j);
                        const unsigned p = ((sl & ((1u << dsh) - 1u)) << lsh) + (sl >> dsh) + sb, kk = p & 31u, k16 = kk & 15u;
                        const unsigned po = (((p >> 5) * 4 + (kk >> 4)) * 64 + ((k16 >> 2) & 1u) * 32) * 16 + (((k16 >> 3) << 2) + (k16 & 3u)) * 2;
#pragma unroll
                        for (int bj = 0; bj < 2; ++bj)
#pragma unroll
                            for (int n = 0; n < 2; ++n) *(bf16_t*)(base + (lo + po + (unsigned)((bj * 2 * 2048 * 64 + 16 * n * 8) * 2))) = f2bf(acc[ai][bj][m][n][j] * rs); }
                    __builtin_amdgcn_sched_barrier(0); }
        }
    }
};
struct EpiQKVB {
    unsigned char* ws; const float* ssq;
    __device__ __forceinline__ void operator()(const Acc& acc, const Unit& u, int wr, int wc, int fr, int fq, const LAS float* rsl) const {
        const int pn = u.pn; unsigned rl = wr * 64 + fr, cw = wc * 32 + 8 * fq; OPAQUE(rl); OPAQUE(cw); const size_t rowt = (size_t)u.pm * 256;
        float rs[2][4];
#pragma unroll
        for (int ai = 0; ai < 2; ++ai)
#pragma unroll
            for (int m = 0; m < 4; ++m) rs[ai][m] = rsl[ai * 128 + wr * 64 + m * 16 + fr];
        if (pn < 12) {
            unsigned char* base = ws + OFF_QB + (rowt * 3072 + pn * 256) * 2; unsigned lo = (rl * 3072 + cw) * 2; OPAQUE(lo);
#pragma unroll
            for (int ai = 0; ai < 2; ++ai)
#pragma unroll
                for (int m = 0; m < 4; ++m)
#pragma unroll
                    for (int bj = 0; bj < 2; ++bj) *(u32x4*)(base + (lo + (unsigned)(((ai * 128 + m * 16) * 3072 + bj * 128) * 2))) = pack8(acc[ai][bj][m][0] * rs[ai][m], acc[ai][bj][m][1] * rs[ai][m]);
        } else {
            const int idx = pn - 12, gi = idx >> 1, dsh = 2 * gi, lsh = 11 - dsh, b = u.pm >> 3, sb = ((u.pm & 7) * 256) >> dsh;
            unsigned posl = ((rl & ((1u << dsh) - 1u)) << lsh) + (rl >> dsh) + sb; OPAQUE(posl);
            unsigned char* base = ws + OFF_KVB + (size_t)idx * 32 * MiB + ((size_t)b * 4 * 2048 * 64) * 2;
            unsigned lo = ((cw >> 6) * 2048 * 64 + (((cw & 63) >> 4) * 64 + ((cw >> 3) & 1) * 32) * 8) * 2; OPAQUE(lo);
#pragma unroll
            for (int ai = 0; ai < 2; ++ai)
#pragma unroll
                for (int m = 0; m < 4; ++m) { const unsigned p = posl + (unsigned)((ai * 128 + m * 16) >> dsh), po = ((p >> 5) * 256 + (p & 31u)) * 16;
#pragma unroll
                    for (int bj = 0; bj < 2; ++bj) *(u32x4*)(base + (lo + po + (unsigned)(bj * 2 * 2048 * 64 * 2))) = pack8(acc[ai][bj][m][0] * rs[ai][m], acc[ai][bj][m][1] * rs[ai][m]); }
        }
    }
};
__device__ __forceinline__ f32x4 bf_lo4(u32x4 w) { f32x4 r; r[0] = __uint_as_float(w.x << 16); r[1] = __uint_as_float(w.x & 0xffff0000u); r[2] = __uint_as_float(w.y << 16); r[3] = __uint_as_float(w.y & 0xffff0000u); return r; }
__device__ __forceinline__ f32x4 bf_hi4(u32x4 w) { f32x4 r; r[0] = __uint_as_float(w.z << 16); r[1] = __uint_as_float(w.z & 0xffff0000u); r[2] = __uint_as_float(w.w << 16); r[3] = __uint_as_float(w.w & 0xffff0000u); return r; }
template <int MODE>
struct EpiResid {
    const float* xin; unsigned char* hout; float* ssq;
    __device__ __forceinline__ void operator()(const Acc& acc, const Unit& u, int wr, int wc, int fr, int fq, const LAS float* rsl) const {
        unsigned rl = wr * 64 + fr, cw = wc * 32 + 8 * fq; OPAQUE(rl); OPAQUE(cw); const size_t t0 = ((size_t)u.pm * 256 * 1024 + u.pn * 256) * 2;
        const unsigned char* bi = (const unsigned char*)xin + 2 * t0; unsigned char* bh = hout + t0; unsigned lo = (rl * 1024 + cw) * 2; OPAQUE(lo);
        float* sq = ssq + ((size_t)u.pm * 256 + rl) * 16 + u.pn * 4 + wc;
#pragma unroll
        for (int ai = 0; ai < 2; ++ai) {
            f32x4 xa[4][2][2];
#pragma unroll
            for (int m = 0; m < 4; ++m)
#pragma unroll
                for (int bj = 0; bj < 2; ++bj) { const unsigned o = lo + (unsigned)(((ai * 128 + m * 16) * 1024 + bj * 128) * 2);
                    if (MODE == 0) { xa[m][bj][0] = *(const f32x4*)(bi + 2 * o); xa[m][bj][1] = *(const f32x4*)(bi + 2 * o + 16); }
                    else { const u32x4 w = *(const u32x4*)(bh + o); xa[m][bj][0] = bf_lo4(w); xa[m][bj][1] = bf_hi4(w); } }
            __builtin_amdgcn_sched_barrier(0);
#pragma unroll
            for (int m = 0; m < 4; ++m) { float q = 0.f;
#pragma unroll
                for (int bj = 0; bj < 2; ++bj) { const unsigned o = lo + (unsigned)(((ai * 128 + m * 16) * 1024 + bj * 128) * 2);
                    const u32x4 w = pack8(xa[m][bj][0] + acc[ai][bj][m][0], xa[m][bj][1] + acc[ai][bj][m][1]);
                    *(u32x4*)(bh + o) = w;
                    if (MODE != 2) { const f32x4 a = bf_lo4(w), c = bf_hi4(w); q += (a[0] * a[0] + a[1] * a[1]) + (a[2] * a[2] + a[3] * a[3]) + (c[0] * c[0] + c[1] * c[1]) + (c[2] * c[2] + c[3] * c[3]); } }
                if (MODE != 2) { q += __shfl_xor(q, 16); q += __shfl_xor(q, 32); if (fq == 0) sq[(ai * 128 + m * 16) * 16] = q; } }
        }
    }
};
struct EpiSwiglu {
    unsigned char* act; const float* ssq;
    __device__ __forceinline__ void operator()(const Acc& acc, const Unit& u, int wr, int wc, int fr, int fq, const LAS float* rsl) const {
        unsigned rl = wr * 64 + fr, cw = wc * 32 + 8 * fq; OPAQUE(rl); OPAQUE(cw); unsigned char* base = act + ((size_t)u.pm * 256 * FFH + u.pn * 128) * 2; unsigned lo = (rl * FFH + cw) * 2; OPAQUE(lo);
        float rsv[2][4];
#pragma unroll
        for (int ai = 0; ai < 2; ++ai)
#pragma unroll
            for (int m = 0; m < 4; ++m) rsv[ai][m] = rsl[ai * 128 + wr * 64 + m * 16 + fr];
#pragma unroll
        for (int ai = 0; ai < 2; ++ai)
#pragma unroll
            for (int m = 0; m < 4; ++m) { f32x4 h0, h1; const float rs = rsv[ai][m];
#pragma unroll
                for (int e = 0; e < 4; ++e) { const float a0 = acc[ai][0][m][0][e] * rs, a1 = acc[ai][0][m][1][e] * rs;
                    h0[e] = a0 * sigmoidf_(a0) * (acc[ai][1][m][0][e] * rs); h1[e] = a1 * sigmoidf_(a1) * (acc[ai][1][m][1][e] * rs); }
                *(u32x4*)(base + (lo + (unsigned)((ai * 128 + m * 16) * FFH * 2))) = pack8(h0, h1); }
    }
};
struct EpiCmp1 {
    unsigned char* ws;
    __device__ __forceinline__ void operator()(const Acc& acc, const Unit& u, int wr, int wc, int fr, int fq, const LAS float* rsl) const {
        const int kv = u.pn; unsigned rl = wr * 64 + fr, cw = wc * 32 + 8 * fq; OPAQUE(rl); OPAQUE(cw);
        unsigned char* base = ws + OFF_G1 + (((size_t)kv * 16384 + (size_t)u.pm * 256) * 256) * 2; unsigned lo = (rl * 256 + cw) * 2; OPAQUE(lo);
        const unsigned char* bp = ws + OFF_BIAS1 + (size_t)kv * 256 * 4; unsigned blo = cw * 4; OPAQUE(blo);
#pragma unroll
        for (int bj = 0; bj < 2; ++bj) {
            const f32x4 b0 = *(const f32x4*)(bp + (blo + (unsigned)(bj * 128 * 4))), b1 = *(const f32x4*)(bp + (blo + (unsigned)(bj * 128 * 4 + 16)));
#pragma unroll
            for (int ai = 0; ai < 2; ++ai)
#pragma unroll
                for (int m = 0; m < 4; ++m) { f32x4 h0, h1;
#pragma unroll
                    for (int e = 0; e < 4; ++e) {
                        const float x0 = acc[ai][bj][m][0][e] + b0[e], x1 = acc[ai][bj][m][1][e] + b1[e];
                        const float u0 = 0.7978845608028654f * (x0 + 0.044715f * x0 * x0 * x0), u1 = 0.7978845608028654f * (x1 + 0.044715f * x1 * x1 * x1);
                        h0[e] = x0 * sigmoidf_(2.f * u0); h1[e] = x1 * sigmoidf_(2.f * u1); }
                    *(u32x4*)(base + (lo + (unsigned)(((ai * 128 + m * 16) * 256 + bj * 128) * 2))) = pack8(h0, h1); }
        }
    }
};

__device__ __forceinline__ void conv_weight(const float* W, int K, int N, const float* gain, bf16_t* WT, int row_off, int mode, LAS float* scr, int gw, int NGW, int lane) {
    const int nnb = (N + 31) / 32, nitems = (K / 64) * nnb;
    for (int item = gw; item < nitems; item += NGW) {
        const int kb = item / nnb, nb = item % nnb, k0 = 64 * kb, n0 = 32 * nb;
#pragma unroll
        for (int i = 0; i < 32; ++i) { const int kk = 2 * i + (lane >> 5), n = n0 + (lane & 31);
            float v = (n < N) ? W[(size_t)(k0 + kk) * N + n] : 0.f; if (gain) v *= gain[k0 + kk]; scr[kk * 33 + (lane & 31)] = v; }
        LDS_WAIT();
        int dr0 = row_off + n0;
        if (mode == 1) dr0 = (n0 < FFH) ? ((n0 >> 7) * 256 + (n0 & 127)) : ((((n0 - FFH) >> 7) * 256) + 128 + ((n0 - FFH) & 127));
        const int c = lane & 7;
#pragma unroll
        for (int j = 0; j < 4; ++j) { const int nn = (lane >> 3) + 8 * j; const LAS float* s = scr + (8 * c) * 33 + nn;
            u32x4 o; o.x = cvt_pk_bf16(s[0 * 33], s[1 * 33]); o.y = cvt_pk_bf16(s[2 * 33], s[3 * 33]); o.z = cvt_pk_bf16(s[4 * 33], s[5 * 33]); o.w = cvt_pk_bf16(s[6 * 33], s[7 * 33]);
            if (n0 + nn < N) *(u32x4*)(WT + (size_t)(dr0 + nn) * K + k0 + 8 * c) = o; }
        LDS_WAIT();
    }
}
__device__ __forceinline__ void cast_rows(const float* x, bf16_t* h, float* ssq, int gw, int NGW, int lane) {
    for (int row = gw; row < T_TOK; row += NGW) {
        const f32x4* xr = (const f32x4*)(x + (size_t)row * DM) + lane; f32x4 v[4]; float s = 0.f;
#pragma unroll
        for (int j = 0; j < 4; ++j) { v[j] = xr[64 * j]; s += (v[j][0] * v[j][0] + v[j][1] * v[j][1]) + (v[j][2] * v[j][2] + v[j][3] * v[j][3]); }
        s = wave_sum(s);
        u32x2* o = (u32x2*)(h + (size_t)row * DM) + lane;
#pragma unroll
        for (int j = 0; j < 4; ++j) { u32x2 w; w.x = cvt_pk_bf16(v[j][0], v[j][1]); w.y = cvt_pk_bf16(v[j][2], v[j][3]); o[64 * j] = w; }
        if (lane < 16) ssq[(size_t)row * 16 + lane] = lane == 0 ? s : 0.f;
    }
}
__device__ __forceinline__ void final_norm_rows(const bf16_t* hsrc, float* out, const float* gain, int gw, int NGW) {
    const int lane = threadIdx.x & 63;
    f32x4 gv[4];
#pragma unroll
    for (int j = 0; j < 4; ++j) gv[j] = ((const f32x4*)gain)[lane + 64 * j];
    for (int row = gw; row < T_TOK; row += NGW) {
        const u32x2* hr = (const u32x2*)(hsrc + (size_t)row * DM) + lane; f32x4* xr = (f32x4*)(out + (size_t)row * DM) + lane; f32x4 v[4]; float s = 0.f;
#pragma unroll
        for (int j = 0; j < 4; ++j) { const u32x2 w = hr[64 * j]; v[j][0] = __uint_as_float(w.x << 16); v[j][1] = __uint_as_float(w.x & 0xffff0000u); v[j][2] = __uint_as_float(w.y << 16); v[j][3] = __uint_as_float(w.y & 0xffff0000u);
            s += (v[j][0] * v[j][0] + v[j][1] * v[j][1]) + (v[j][2] * v[j][2] + v[j][3] * v[j][3]); }
        const float r = 1.f / sqrtf(wave_sum(s) * (1.f / DM) + 1e-6f);
#pragma unroll
        for (int j = 0; j < 4; ++j) xr[64 * j] = v[j] * r * gv[j];
    }
}

struct SoftState { float l; f32x16 cin, o0, o1; };
struct KFrag { bf16x8 k0, k1, k2, k3; const char* vp; };
__device__ __forceinline__ bf16x8 ld_v8(const char* p) { const u64 lo = *(const u64*)p, hi = *(const u64*)(p + 16); u32x4 t; t.x = (unsigned)lo; t.y = (unsigned)(lo >> 32); t.z = (unsigned)hi; t.w = (unsigned)(hi >> 32); return __builtin_bit_cast(bf16x8, t); }
__device__ __forceinline__ bf16x8 pk_lo(const f32x16& p) { u32x4 t; t.x = cvt_pk_bf16(p[0], p[1]); t.y = cvt_pk_bf16(p[2], p[3]); t.z = cvt_pk_bf16(p[4], p[5]); t.w = cvt_pk_bf16(p[6], p[7]); return __builtin_bit_cast(bf16x8, t); }
__device__ __forceinline__ bf16x8 pk_hi(const f32x16& p) { u32x4 t; t.x = cvt_pk_bf16(p[8], p[9]); t.y = cvt_pk_bf16(p[10], p[11]); t.z = cvt_pk_bf16(p[12], p[13]); t.w = cvt_pk_bf16(p[14], p[15]); return __builtin_bit_cast(bf16x8, t); }
__device__ __forceinline__ void load_k(KFrag& f, const char* kp, const char* vp) { f.k0 = *(const bf16x8*)kp; f.k1 = *(const bf16x8*)(kp + 1024); f.k2 = *(const bf16x8*)(kp + 2048); f.k3 = *(const bf16x8*)(kp + 3072);
    f.vp = vp; }
__device__ __forceinline__ f32x16 tile_scores(const SoftState& st, const bf16x8 (&qf)[4], const KFrag& f, const LAS unsigned char* lds, unsigned vb, int dist0, int max_dist, bool masked) {
    f32x16 bv;
#pragma unroll
    for (int i = 0; i < 16; ++i) bv[i] = *(const LAS float*)(lds + vb + 4 * (27 - ((i & 3) + 8 * (i >> 2))));
    __builtin_amdgcn_sched_barrier(0);
    f32x16 s = mfma32(f.k0, qf[0], st.cin); s = mfma32(f.k1, qf[1], s); s = mfma32(f.k2, qf[2], s); s = mfma32(f.k3, qf[3], s);
    f32x16 t = s * SC2 + bv;
    if (masked) {
#pragma unroll
        for (int i = 0; i < 16; ++i) t[i] = ((unsigned)(dist0 - ((i & 3) + 8 * (i >> 2))) <= (unsigned)max_dist) ? t[i] : -__builtin_inff();
    }
    return t;
}
__device__ __forceinline__ float exp_sum(f32x16& t) {
#pragma unroll
    for (int i = 0; i < 16; ++i) t[i] = fexp2(t[i]);
    typedef float f32x2 __attribute__((ext_vector_type(2)));
    f32x2 a2 = (f32x2){t[0], t[1]} + (f32x2){t[2], t[3]}, b2 = (f32x2){t[4], t[5]} + (f32x2){t[6], t[7]};
    a2 += (f32x2){t[8], t[9]}; b2 += (f32x2){t[10], t[11]}; a2 += (f32x2){t[12], t[13]}; b2 += (f32x2){t[14], t[15]}; a2 += b2;
    return a2.x + a2.y;
}
__device__ __forceinline__ void tile_compute(SoftState& st, const bf16x8 (&qf)[4], const KFrag& f, const LAS unsigned char* lds, unsigned vb, int dist0, int max_dist, bool masked, bool first) {
    const bf16x8 v00 = *(const bf16x8*)f.vp, v01 = *(const bf16x8*)(f.vp + 1024), v10 = *(const bf16x8*)(f.vp + 2048), v11 = *(const bf16x8*)(f.vp + 3072);
    f32x16 t = tile_scores(st, qf, f, lds, vb, dist0, max_dist, masked);
    float ls = 0.f; bool redo = first;
    if (!first) { ls = exp_sum(t); redo = __builtin_amdgcn_ballot_w64(!(ls < 3.0e38f)) != 0ull; if (redo) t = tile_scores(st, qf, f, lds, vb, dist0, max_dist, masked); }
    if (redo) {
        float mx = fmaxf(fmaxf(t[0], t[1]), t[2]), my = fmaxf(fmaxf(t[8], t[9]), t[10]);
        mx = fmaxf(fmaxf(mx, t[3]), t[4]); my = fmaxf(fmaxf(my, t[11]), t[12]); mx = fmaxf(fmaxf(mx, t[5]), t[6]); my = fmaxf(fmaxf(my, t[13]), t[14]); mx = fmaxf(fmaxf(mx, t[7]), t[15]); mx = fmaxf(mx, my);
        mx = fmaxf(mx, __shfl_xor(mx, 32));
        const float delta = mx > -1e29f ? mx : 0.f, alpha = fexp2(-delta); st.l *= alpha; st.o0 *= alpha; st.o1 *= alpha; st.cin -= delta * (1.f / SC2); t -= delta;
        ls = exp_sum(t);
    }
    st.l += ls;
    const bf16x8 pb0 = pk_lo(t), pb1 = pk_hi(t);
    st.o0 = mfma32(v00, pb0, st.o0); st.o0 = mfma32(v01, pb1, st.o0); st.o1 = mfma32(v10, pb0, st.o1); st.o1 = mfma32(v11, pb1, st.o1);
}
__device__ __forceinline__ void soft_init(SoftState& st) { st.l = 0.f;
#pragma unroll
    for (int i = 0; i < 16; ++i) { st.cin[i] = 0.f; st.o0[i] = 0.f; st.o1[i] = 0.f; } }

__device__ __forceinline__ void run_range(SoftState& st, const bf16x8 (&qf)[4], const char* Kl, const char* Vl, int kt_lo, int kt_hi,
                                          int qpos, int qmin, int qmax, int max_dist, unsigned tb_head, const LAS unsigned char* lds, int h, bool first_run) {
    KFrag A, B; int kt = kt_lo;
    load_k(A, Kl + (size_t)kt_lo * 4096, Vl + (size_t)kt_lo * 4096);
#define RR_STEP(F) do { const int kbase = 32 * kt, dist0 = qpos - kbase - 4 * h; const unsigned vb = tb_head + (unsigned)(4 * (dist0 - 27)); \
        const bool masked = !(qmin - kbase - 31 >= 0 && qmax - kbase <= max_dist); \
        tile_compute(st, qf, F, lds, vb, dist0, max_dist, masked, first_run && kt == kt_lo); } while (0)
#pragma unroll 1
    for (;;) {
        { const int kn = kt + 1 <= kt_hi ? kt + 1 : kt_hi; load_k(B, Kl + (size_t)kn * 4096, Vl + (size_t)kn * 4096); }
        RR_STEP(A); if (++kt > kt_hi) break;
        { const int kn = kt + 1 <= kt_hi ? kt + 1 : kt_hi; load_k(A, Kl + (size_t)kn * 4096, Vl + (size_t)kn * 4096); }
        RR_STEP(B); if (++kt > kt_hi) break;
    }
#undef RR_STEP
}

constexpr int ATT_TAB = 1024  , ATT_HS_A = 2056  , ATT_HS_B = 136  , ATT_B0C = 16 * 136 + 1  , ATT_NEG = LDS_NEG;

__device__ __forceinline__ void phaseA_attn(unsigned char* ws, LAS unsigned char* lds, int gw, int NGW) {
    const int lane = threadIdx.x & 63;
    const int r = lane & 31, h = lane >> 5, tk = r >> 2, rr = r & 3;
    const LAS unsigned char* lut = lds + LDS_LUT; const LAS float* bias2 = (const LAS float*)(lds + LDS_BIAS);
    { LAS float* tab = (LAS float*)(lds + ATT_TAB);
      for (int i = threadIdx.x; i < 16 * ATT_HS_A; i += 512) { const int hd = i / ATT_HS_A, d = i - hd * ATT_HS_A; tab[i] = d < 2048 ? bias2[(int)lut[d] * 16 + hd] : 0.f; }
      if (threadIdx.x < 256) ((LAS float*)lds)[threadIdx.x] = 0.f;
      if (threadIdx.x < 64) ((LAS float*)(lds + ATT_NEG))[threadIdx.x] = -__builtin_inff();
      __syncthreads(); }
    const int xcd = blockIdx.x & 7, wx = (blockIdx.x >> 3) * 8 + (gw & 7), nwx = (NGW >> 3);
    for (int it = wx; it < 16 * 256; it += nwx) {
        const int rnd = it >> 8, bg = xcd * 16 + rnd, ti = ((it & 255) + 16 * rnd) & 255, b = bg >> 2, g = bg & 3, s0 = ti * 8, s = s0 + tk, head = g * 4 + rr, cur = s0 >> 6;
        const size_t tok = (size_t)b * 2048 + s;
        const LAS float* bias2h = bias2 + head;
        const unsigned tb_head = (unsigned)(ATT_TAB + head * ATT_HS_A * 4);
        bf16x8 qf[4];
        { const char* qp = (const char*)ws + OFF_QA + (tok * 1024 + head * 64 + 8 * h) * 2;
#pragma unroll
          for (int ks = 0; ks < 4; ++ks) qf[ks] = *(const bf16x8*)(qp + 32 * ks); }
        const float* gp = (const float*)(ws + OFF_GATE) + tok * 48 + head * 3; const float g_cmp = gp[0], g_sel = gp[1], g_win = gp[2];
        unsigned tp[16]; unsigned sel;
        {
            const char* Kc = (const char*)ws + OFF_KCMP + (size_t)bg * 16384 + lane * 16; const char* Vc = (const char*)ws + OFF_VCMPT + (size_t)bg * 16384 + lane * 16;
            f32x16 sc[4];
#pragma unroll
            for (int c = 0; c < 4; ++c) { f32x16 a = {0.f, 0.f, 0.f, 0.f, 0.f, 0.f, 0.f, 0.f, 0.f, 0.f, 0.f, 0.f, 0.f, 0.f, 0.f, 0.f};
#pragma unroll
                for (int ks = 0; ks < 4; ++ks) a = mfma32(*(const bf16x8*)(Kc + (c * 4 + ks) * 1024), qf[ks], a); sc[c] = a; }
            __builtin_amdgcn_sched_barrier(0);
            float mx = -1e30f;
#pragma unroll
            for (int c = 0; c < 4; ++c)
#pragma unroll
                for (int i = 0; i < 16; ++i) { const int n = 32 * c + (i & 3) + 8 * (i >> 2) + 4 * h, dist = s - 16 * n - 31; const bool valid = dist >= 0; const int idx = dist < 0 ? 0 : dist;
                    const float t = valid ? sc[c][i] * SC2 + bias2h[(int)lut[idx] * 16] : -1e30f; sc[c][i] = t; mx = fmaxf(mx, t); }
            mx = fmaxf(mx, __shfl_xor(mx, 32)); float l = 0.f;
#pragma unroll
            for (int c = 0; c < 4; ++c)
#pragma unroll
                for (int i = 0; i < 16; ++i) { const float pv = sc[c][i] > -1e29f ? fexp2(sc[c][i] - mx) : 0.f; sc[c][i] = pv; l += pv; }
            l += __shfl_xor(l, 32); const float inv = 1.f / fmaxf(l, 1e-30f);
#pragma unroll
            for (int c = 0; c < 4; ++c) sc[c] *= inv;
            __builtin_amdgcn_sched_barrier(0);
            f32x16 oc0 = {0.f, 0.f, 0.f, 0.f, 0.f, 0.f, 0.f, 0.f, 0.f, 0.f, 0.f, 0.f, 0.f, 0.f, 0.f, 0.f}, oc1 = oc0;
#pragma unroll
            for (int c = 0; c < 4; ++c) { const bf16x8 pb0 = pk_lo(sc[c]), pb1 = pk_hi(sc[c]);
                oc0 = mfma32(*(const bf16x8*)(Vc + (c * 4) * 1024), pb0, oc0); oc0 = mfma32(*(const bf16x8*)(Vc + (c * 4 + 1) * 1024), pb1, oc0); oc1 = mfma32(*(const bf16x8*)(Vc + (c * 4 + 2) * 1024), pb0, oc1); oc1 = mfma32(*(const bf16x8*)(Vc + (c * 4 + 3) * 1024), pb1, oc1); }
            oc0 *= g_cmp; oc1 *= g_cmp;
#pragma unroll
            for (int q = 0; q < 8; ++q) { tp[q] = cvt_pk_bf16(oc0[2 * q], oc0[2 * q + 1]); tp[8 + q] = cvt_pk_bf16(oc1[2 * q], oc1[2 * q + 1]); }
            __builtin_amdgcn_sched_barrier(0);
            float own[16], oth[16], pl[16];
#pragma unroll
            for (int cgi = 0; cgi < 16; ++cgi) pl[cgi] = __shfl_xor(sc[cgi >> 2][4 * (cgi & 3) + 3], 32);
#pragma unroll
            for (int cgi = 0; cgi < 16; ++cgi) { const int c = cgi >> 2, q4 = 4 * (cgi & 3); float v = (sc[c][q4] + sc[c][q4 + 1]) + (sc[c][q4 + 2] + sc[c][q4 + 3]);
                const float prevh0 = cgi > 0 ? pl[cgi > 0 ? cgi - 1 : 0] : 0.f; v += h ? pl[cgi] : prevh0;
                v += __shfl_xor(v, 1); v += __shfl_xor(v, 2); own[cgi] = v; }
#pragma unroll
            for (int cgi = 0; cgi < 16; ++cgi) oth[cgi] = __shfl_xor(own[cgi], 32);
            __builtin_amdgcn_sched_barrier(0);
            float cand[32];
#pragma unroll
            for (int cgi = 0; cgi < 16; ++cgi) { const float ve = h ? oth[cgi] : own[cgi], vo = h ? own[cgi] : oth[cgi];
                cand[2 * cgi] = (2 * cgi >= 1 && 2 * cgi <= cur - 2) ? ve : -2.f; cand[2 * cgi + 1] = (2 * cgi + 1 <= cur - 2) ? vo : -2.f; }
            float prev = 3.0e38f;
#pragma unroll 1
            for (int round = 0; round < 5; ++round) { float best = -1.f;
#pragma unroll
                for (int j = 0; j < 32; ++j) { const float v = cand[j] < prev ? cand[j] : -2.f; best = fmaxf(best, v); }
                prev = best; }
            const float thr = fmaxf(prev, 0.f);
            sel = 1u | (1u << cur) | (cur > 0 ? (1u << (cur - 1)) : 0u);
#pragma unroll
            for (int j = 1; j < 32; ++j) sel |= (cand[j] >= thr) ? (1u << j) : 0u;
        }
        {
            unsigned um = sel; um |= __shfl_xor(um, 4); um |= __shfl_xor(um, 8); um |= __shfl_xor(um, 16); um = __builtin_amdgcn_readfirstlane(um);
            const char* Kl = (const char*)ws + OFF_BRA + 2 * 32 * MiB + (size_t)bg * 2048 * 128 + lane * 16;
            const char* Vl = (const char*)ws + OFF_BRA + 3 * 32 * MiB + (size_t)bg * 2048 * 128 + lane * 16;
            SoftState st; soft_init(st);
            KFrag A, B; int half = 0, kb = 64 * __builtin_ctz(um), kbn = 0; bool has, first = true;
            load_k(A, Kl + (size_t)kb * 128, Vl + (size_t)kb * 128);
#define SEL_STEP(F, G) do { if (half) um &= um - 1; half ^= 1; has = um != 0u; kbn = has ? 64 * __builtin_ctz(um) + 32 * half : kb; load_k(G, Kl + (size_t)kbn * 128, Vl + (size_t)kbn * 128); \
                { const int jb = kb >> 6, dist0 = s - kb - 4 * h; const unsigned vb = ((sel >> jb) & 1u) ? tb_head + (unsigned)(4 * (dist0 - 27)) : (unsigned)ATT_NEG; \
                  tile_compute(st, qf, F, lds, vb, dist0, 1 << 20, jb >= cur, first); } first = false; kb = kbn; } while (0)
#pragma unroll 1
            for (;;) {
                SEL_STEP(A, B); if (!has) break;
                SEL_STEP(B, A); if (!has) break;
            }
#undef SEL_STEP
            const float lt = st.l + __shfl_xor(st.l, 32), sc = g_sel / fmaxf(lt, 1e-30f);
#pragma unroll
            for (int q = 0; q < 8; ++q) { tp[q] = cvt_pk_bf16(__uint_as_float(tp[q] << 16) + st.o0[2 * q] * sc, __uint_as_float(tp[q] & 0xffff0000u) + st.o0[2 * q + 1] * sc);
                tp[8 + q] = cvt_pk_bf16(__uint_as_float(tp[8 + q] << 16) + st.o1[2 * q] * sc, __uint_as_float(tp[8 + q] & 0xffff0000u) + st.o1[2 * q + 1] * sc); }
        }
        {
            const char* Kl = (const char*)ws + OFF_BRA + 4 * 32 * MiB + (size_t)bg * 2048 * 128 + lane * 16;
            const char* Vl = (const char*)ws + OFF_BRA + 5 * 32 * MiB + (size_t)bg * 2048 * 128 + lane * 16;
            SoftState st; soft_init(st);
            const int lo = s0 - 255, kt_lo = lo < 0 ? 0 : (lo >> 5), kt_hi = (s0 + 7) >> 5;
            run_range(st, qf, Kl, Vl, kt_lo, kt_hi, s, s0, s0 + 7, 255, tb_head, lds, h, true);
            const float lt = st.l + __shfl_xor(st.l, 32), sc = g_win / fmaxf(lt, 1e-30f);
#pragma unroll
            for (int q = 0; q < 8; ++q) { tp[q] = cvt_pk_bf16(__uint_as_float(tp[q] << 16) + st.o0[2 * q] * sc, __uint_as_float(tp[q] & 0xffff0000u) + st.o0[2 * q + 1] * sc);
                tp[8 + q] = cvt_pk_bf16(__uint_as_float(tp[8 + q] << 16) + st.o1[2 * q] * sc, __uint_as_float(tp[8 + q] & 0xffff0000u) + st.o1[2 * q + 1] * sc); }
        }
        { unsigned char* op = ws + OFF_O + (tok * 1024 + head * 64 + 4 * h) * 2;
#pragma unroll
          for (int q = 0; q < 4; ++q) { u32x2 w; w.x = tp[2 * q]; w.y = tp[2 * q + 1]; *(u32x2*)(op + 16 * q) = w; u32x2 w2; w2.x = tp[8 + 2 * q]; w2.y = tp[8 + 2 * q + 1]; *(u32x2*)(op + 64 + 16 * q) = w2; } }
    }
}

__device__ __forceinline__ const char* qb_ptr(const unsigned char* ws, int it, int gi, int xcd, int tk, int rr, int h) {
    const int rnd = it >> 8, bg = xcd * 16 + rnd, cc = ((it >> 4) + rnd) & 15, r16 = it & 15, b = bg >> 2, g = bg & 3, s = cc * 128 + r16 + 16 * tk, head = g * 4 + rr;
    return (const char*)ws + OFF_QB + (((size_t)b * 2048 + s) * 3072 + gi * 1024 + head * 64 + 8 * h) * 2;
}
__device__ __forceinline__ void phaseB_attn(unsigned char* ws, LAS unsigned char* lds, int gw, int NGW) {
    const int lane = threadIdx.x & 63;
    const int r = lane & 31, h = lane >> 5, tk = r >> 2, rr = r & 3;
    const LAS unsigned char* lut = lds + LDS_LUT; const LAS float* bias2 = (const LAS float*)(lds + LDS_BIAS);
    { LAS float* tab = (LAS float*)(lds + ATT_TAB);
      for (int i = threadIdx.x; i < 3 * 16 * ATT_HS_B; i += 512) { const int gh = i / ATT_HS_B, d = i - gh * ATT_HS_B, gi = gh >> 4, hd = gh & 15; int td = d << (2 * gi); td = td > 2047 ? 2047 : td;
          tab[i] = bias2[(int)lut[td] * 16 + hd]; }
      for (int i = threadIdx.x; i < 4 * 16 * ATT_HS_B; i += 512) { const int cp = i / (16 * ATT_HS_B), j = i - cp * 16 * ATT_HS_B, hd = j / ATT_HS_B, d = j - hd * ATT_HS_B; const int td = d > 2047 ? 2047 : d;
          tab[3 * 16 * ATT_HS_B + cp * ATT_B0C + j] = bias2[(int)lut[td] * 16 + hd]; }
      if (threadIdx.x < 256) ((LAS float*)lds)[threadIdx.x] = 0.f;
      __syncthreads(); }
    const int xcd = blockIdx.x & 7, wx = (blockIdx.x >> 3) * 8 + (gw & 7), nwx = (NGW >> 3);
    bf16x8 qn[4];
    { const char* qp = qb_ptr(ws, wx, 0, xcd, tk, rr, h);
#pragma unroll
      for (int ks = 0; ks < 4; ++ks) qn[ks] = *(const bf16x8*)(qp + 32 * ks); }
    for (int it = wx; it < 16 * 256; it += nwx) {
        const int rnd = it >> 8, bg = xcd * 16 + rnd, cc = ((it >> 4) + rnd) & 15  , r16 = it & 15, b = bg >> 2, g = bg & 3, s0 = cc * 128 + r16, s = s0 + 16 * tk, head = g * 4 + rr;
        const size_t tok = (size_t)b * 2048 + s;
        SoftState st; soft_init(st);
#pragma unroll 1
        for (int gi = 0; gi < 3; ++gi) {
            const int dsh = 2 * gi, lsh = 11 - dsh, res = s0 & ((1 << dsh) - 1);
            bf16x8 qf[4];
#pragma unroll
            for (int ks = 0; ks < 4; ++ks) qf[ks] = qn[ks];
            { int ngi = gi + 1, nit = it; if (ngi == 3) { ngi = 0; nit = it + nwx < 16 * 256 ? it + nwx : it; }
              const char* qp = qb_ptr(ws, nit, ngi, xcd, tk, rr, h);
#pragma unroll
              for (int ks = 0; ks < 4; ++ks) qn[ks] = *(const bf16x8*)(qp + 32 * ks); }
            const char* Kl = (const char*)ws + OFF_KVB + (size_t)(gi * 2) * 32 * MiB + ((size_t)bg * 2048 + ((size_t)res << lsh)) * 128 + lane * 16;
            const char* Vl = (const char*)ws + OFF_KVB + (size_t)(gi * 2 + 1) * 32 * MiB + ((size_t)bg * 2048 + ((size_t)res << lsh)) * 128 + lane * 16;
            const int ql = s >> dsh, qmin = s0 >> dsh, qmax = (s0 + 112) >> dsh, ql_lo = qmin - 128, kt_lo = ql_lo < 0 ? 0 : (ql_lo >> 5), kt_hi = qmax >> 5;
            const unsigned tb_head = gi == 0 ? (unsigned)(ATT_TAB + (3 * 16 * ATT_HS_B + (tk >> 1) * ATT_B0C + head * ATT_HS_B) * 4) : (unsigned)(ATT_TAB + (gi * 16 + head) * ATT_HS_B * 4);
            run_range(st, qf, Kl, Vl, kt_lo, kt_hi, ql, qmin, qmax, 128, tb_head, lds, h, gi == 0);
        }
        const float lt = st.l + __shfl_xor(st.l, 32), sc = 1.f / fmaxf(lt, 1e-30f);
        const f32x16 tot0 = st.o0 * sc, tot1 = st.o1 * sc;
        { unsigned char* op = ws + OFF_O + (tok * 1024 + head * 64 + 4 * h) * 2;
#pragma unroll
          for (int q = 0; q < 4; ++q) { u32x2 w; w.x = cvt_pk_bf16(tot0[4 * q], tot0[4 * q + 1]); w.y = cvt_pk_bf16(tot0[4 * q + 2], tot0[4 * q + 3]); *(u32x2*)(op + 16 * q) = w;
              u32x2 w2; w2.x = cvt_pk_bf16(tot1[4 * q], tot1[4 * q + 1]); w2.y = cvt_pk_bf16(tot1[4 * q + 2], tot1[4 * q + 3]); *(u32x2*)(op + 64 + 16 * q) = w2; } }
    }
}

__device__ __forceinline__ void phase_cmp2(unsigned char* ws, int gw, int NGW) {
    const int lane = threadIdx.x & 63;
    const int r = lane & 31, h = lane >> 5;
    for (int item = gw; item < 1024; item += NGW) {
        const int kv = item >> 9, rt = item & 511;
        const char* ap = (const char*)ws + OFF_G1 + (((size_t)kv * 16384 + rt * 32 + r) * 256 + 8 * h) * 2;
        const char* bp = (const char*)ws + OFF_W2 + (size_t)kv * 32768 + ((size_t)r * 256 + 8 * h) * 2;
        f32x16 a0 = {0.f, 0.f, 0.f, 0.f, 0.f, 0.f, 0.f, 0.f, 0.f, 0.f, 0.f, 0.f, 0.f, 0.f, 0.f, 0.f}, a1 = a0;
#pragma unroll
        for (int ks = 0; ks < 16; ++ks) { const bf16x8 a = *(const bf16x8*)(ap + 32 * ks);
            a0 = mfma32(a, *(const bf16x8*)(bp + 32 * ks), a0); a1 = mfma32(a, *(const bf16x8*)(bp + 32 * 256 * 2 + 32 * ks), a1); }
#pragma unroll
        for (int i = 0; i < 16; ++i) { const int row = rt * 32 + (i & 3) + 8 * (i >> 2) + 4 * h, gq = row & 3, n = (row >> 2) & 127, b = row >> 9, bgi = b * 4 + gq;
            if (kv == 0) { bf16_t* o = (bf16_t*)(ws + OFF_KCMP) + (size_t)bgi * 8192 + ((n >> 5) * 4 * 64 + (n & 31)) * 8;
                o[((r >> 4) * 64 + ((r >> 3) & 1) * 32) * 8 + (r & 7)] = f2bf(a0[i]); o[(((r >> 4) + 2) * 64 + ((r >> 3) & 1) * 32) * 8 + (r & 7)] = f2bf(a1[i]); }
            else { const int kk = n & 31, k16 = kk & 15; bf16_t* o = (bf16_t*)(ws + OFF_VCMPT) + (size_t)bgi * 8192 + (((n >> 5) * 4 + (kk >> 4)) * 64 + ((k16 >> 2) & 1) * 32 + r) * 8 + ((k16 >> 3) << 2) + (k16 & 3);
                o[0] = f2bf(a0[i]); o[2 * 64 * 8] = f2bf(a1[i]); } }
    }
}

__global__ __launch_bounds__(512, 2) void yoco_mega(Params p) {
    extern __shared__ __attribute__((aligned(16))) unsigned char shm[];
    cg::grid_group grid = cg::this_grid();
    LAS unsigned char* lds = (LAS unsigned char*)shm;
    const int tid = threadIdx.x, lane = tid & 63, wave = __builtin_amdgcn_readfirstlane(tid >> 6), gw = blockIdx.x * 8 + wave, NGW = gridDim.x * 8;
    unsigned char* ws = p.ws;
    const float* x_in = p.in[0];
    float* X = p.out;
    { LAS unsigned char* lut = lds + LDS_LUT; LAS float* bias2 = (LAS float*)(lds + LDS_BIAS);
      for (int d = tid; d < 2048; d += 512) { int bk = d; if (d >= 16) bk = 16 + (d >= 22) + (d >= 30) + (d >= 40) + (d >= 54) + (d >= 73) + (d >= 99) + (d >= 134) + (d >= 182) + (d >= 246) + (d >= 332) + (d >= 450) + (d >= 609) + (d >= 825) + (d >= 1117) + (d >= 1513); lut[d] = (unsigned char)bk; }
      bias2[tid] = p.in[1][tid] * LOG2E;
      if (tid < 4) ((LAS unsigned*)(lds + LDS_XB))[tid] = 0u;
      __syncthreads(); }
    const XcdBarrier xbar = xcd_barrier_post((unsigned*)(ws + OFF_XBAR), (volatile LAS unsigned*)(lds + LDS_XB));
    {
        LAS float* scr = (LAS float*)(lds + wave * 8448);
        const float* nm = p.in[2]; const float* nf = p.in[3];
        conv_weight(p.in[4], 1024, 2608, nm, (bf16_t*)(ws + OFF_WIN), 0, 0, scr, gw, NGW, lane);
        conv_weight(p.in[7], 2048, 256, nullptr, (bf16_t*)(ws + OFF_W1), 0, 0, scr, gw, NGW, lane);
        conv_weight(p.in[10], 2048, 256, nullptr, (bf16_t*)(ws + OFF_W1), 256, 0, scr, gw, NGW, lane);
        conv_weight(p.in[8], 256, 64, nullptr, (bf16_t*)(ws + OFF_W2), 0, 0, scr, gw, NGW, lane);
        conv_weight(p.in[11], 256, 64, nullptr, (bf16_t*)(ws + OFF_W2), 64, 0, scr, gw, NGW, lane);
        for (int item = gw; item < 512; item += NGW) { const int kv = item >> 8, ksl = (item >> 2) & 63, c = (item & 3) * 64 + lane;
            const float* pe = kv ? p.in[9] : p.in[6]; const float* w1 = kv ? p.in[10] : p.in[7]; float a = 0.f;
#pragma unroll 8
            for (int kk = ksl * 32; kk < ksl * 32 + 32; ++kk) a += pe[kk] * w1[(size_t)kk * 256 + c];
            ((float*)(ws + OFF_BIASP))[(kv * 64 + ksl) * 256 + c] = a; }
        cast_rows(x_in, (bf16_t*)(ws + OFF_H), (float*)(ws + OFF_SSQ), gw, NGW, lane);
    }
    grid.sync();
    pg8::StaticOrder S;
    float* const SSQ = (float*)(ws + OFF_SSQ);
    { pg8::Gemm g{(const char*)ws + OFF_H, (const char*)ws + OFF_WIN, 1024, 1024, 0, 0};
      { S.init(256, 9, gridDim.x, blockIdx.x, 1); EpiWin E{ws, p.in[5], SSQ}; pg8::gemm_phase<false>(lds, g, S, E, STAGGER, SSQ); }
      { S.init(256, 2, gridDim.x, blockIdx.x, 2); EpiV<0> E{ws, SSQ}; pg8::gemm_phase<true>(lds, g, S, E, 0, SSQ); }
      if (gw < 8) { const int o = gw * 64 + lane; const float* pp = (const float*)(ws + OFF_BIASP) + (o >> 8) * 64 * 256 + (o & 255); float a = 0.f;
#pragma unroll 8
          for (int q = 0; q < 64; ++q) a += pp[q * 256];
          ((float*)(ws + OFF_BIAS1))[o] = a; } }
    xcd_barrier(xbar);
    { pg8::Gemm g{(const char*)ws + OFF_BRA, (const char*)ws + OFF_W1, 2048, 0, 1, 32 * MiB}; S.init(64, 2, gridDim.x, blockIdx.x); EpiCmp1 E{ws}; pg8::gemm_phase<false>(lds, g, S, E); }
    if (blockIdx.x >= 128) { LAS float* scr = (LAS float*)(lds + wave * 8448); const float* nm = p.in[2]; const float* nf = p.in[3];
        const int gw2 = (blockIdx.x - 128) * 8 + wave, NGW2 = (gridDim.x - 128) * 8;
            conv_weight(p.in[12], 1024, 1024, nullptr, (bf16_t*)(ws + OFF_WOUTA), 0, 0, scr, gw2, NGW2, lane);
            conv_weight(p.in[15], 1024, 3072, nm + 1024, (bf16_t*)(ws + OFF_WQKVB), 0, 0, scr, gw2, NGW2, lane);
            conv_weight(p.in[14], 1024, 1536, p.in[13], (bf16_t*)(ws + OFF_WQKVB), 3072, 0, scr, gw2, NGW2, lane);
            conv_weight(p.in[16], 1024, 1024, nullptr, (bf16_t*)(ws + OFF_WOUTB), 0, 0, scr, gw2, NGW2, lane);
            conv_weight(p.in[17], 1024, 5632, nf, (bf16_t*)(ws + OFF_WUP0), 0, 1, scr, gw2, NGW2, lane);
            conv_weight(p.in[17] + (size_t)1024 * 5632, 1024, 5632, nf + 1024, (bf16_t*)(ws + OFF_WUP1), 0, 1, scr, gw2, NGW2, lane);
            conv_weight(p.in[18], 2816, 1024, nullptr, (bf16_t*)(ws + OFF_WDN0), 0, 0, scr, gw2, NGW2, lane);
            conv_weight(p.in[18] + (size_t)2816 * 1024, 2816, 1024, nullptr, (bf16_t*)(ws + OFF_WDN1), 0, 0, scr, gw2, NGW2, lane);
    }
    xcd_barrier(xbar);
    phase_cmp2(ws, gw, NGW);
    xcd_barrier(xbar);
    if (__builtin_amdgcn_readfirstlane(threadIdx.x) >= 256) __builtin_amdgcn_s_setprio(1);
    phaseA_attn(ws, lds, gw, NGW);
    __builtin_amdgcn_s_setprio(0);
    xcd_barrier(xbar);
    { pg8::Gemm g{(const char*)ws + OFF_O, (const char*)ws + OFF_WOUTA, 1024, 1024, 0, 0}; S.init(256, 4, gridDim.x, blockIdx.x); EpiResid<0> E{x_in, ws + OFF_H, SSQ + 16 * T_TOK}; pg8::gemm_phase<false>(lds, g, S, E, STAGGER); }
    xcd_barrier(xbar);
    { pg8::Gemm g{(const char*)ws + OFF_H, (const char*)ws + OFF_WUP0, 1024, 1024, 0, 0}; S.init(256, 22, gridDim.x, blockIdx.x); EpiSwiglu E{ws + OFF_ACT, SSQ + 16 * T_TOK}; pg8::gemm_phase<false>(lds, g, S, E, STAGGER, SSQ + 16 * T_TOK); }
    xcd_barrier(xbar);
    { pg8::Gemm g{(const char*)ws + OFF_ACT, (const char*)ws + OFF_WDN0, 2816, 2816, 0, 0}; S.init(256, 4, gridDim.x, blockIdx.x); EpiResid<1> E{x_in, ws + OFF_H, SSQ + 32 * T_TOK}; pg8::gemm_phase<false>(lds, g, S, E, STAGGER); }
    xcd_barrier(xbar);
    { pg8::Gemm g{(const char*)ws + OFF_H, (const char*)ws + OFF_WQKVB, 1024, 1024, 0, 0};
      { S.init(256, 15, gridDim.x, blockIdx.x, 3); EpiQKVB E{ws, SSQ + 32 * T_TOK}; pg8::gemm_phase<false>(lds, g, S, E, STAGGER, SSQ + 32 * T_TOK); }
      { S.init(256, 3, gridDim.x, blockIdx.x, 4); EpiV<1> E{ws, SSQ + 32 * T_TOK}; pg8::gemm_phase<true>(lds, g, S, E, 0, SSQ + 32 * T_TOK); } }
    xcd_barrier(xbar);
    if (__builtin_amdgcn_readfirstlane(threadIdx.x) >= 256) __builtin_amdgcn_s_setprio(1);
    phaseB_attn(ws, lds, gw, NGW);
    __builtin_amdgcn_s_setprio(0);
    xcd_barrier(xbar);
    { pg8::Gemm g{(const char*)ws + OFF_O, (const char*)ws + OFF_WOUTB, 1024, 1024, 0, 0}; S.init(256, 4, gridDim.x, blockIdx.x); EpiResid<1> E{x_in, ws + OFF_H, SSQ + 48 * T_TOK}; pg8::gemm_phase<false>(lds, g, S, E, STAGGER); }
    xcd_barrier(xbar);
    { pg8::Gemm g{(const char*)ws + OFF_H, (const char*)ws + OFF_WUP1, 1024, 1024, 0, 0}; S.init(256, 22, gridDim.x, blockIdx.x); EpiSwiglu E{ws + OFF_ACT, SSQ + 48 * T_TOK}; pg8::gemm_phase<false>(lds, g, S, E, STAGGER, SSQ + 48 * T_TOK); }
    xcd_barrier(xbar);
    { pg8::Gemm g{(const char*)ws + OFF_ACT, (const char*)ws + OFF_WDN1, 2816, 2816, 0, 0}; S.init(256, 4, gridDim.x, blockIdx.x); EpiResid<2> E{x_in, ws + OFF_H, SSQ}; pg8::gemm_phase<false>(lds, g, S, E, STAGGER); }
    xcd_barrier(xbar);
    final_norm_rows((const bf16_t*)(ws + OFF_H), X, p.in[19], gw, NGW);
}

extern "C" void kernel_launch(void* const* d_in, const int* in_sizes, int n_in, void* d_out, int out_size, void* d_ws, size_t ws_size, hipStream_t stream) {
    static int grid_blocks = 0;
    if (grid_blocks == 0) {
        if (n_in != 20 || out_size != T_TOK * DM || ws_size < WS_NEED) { fprintf(stderr, "kernel_launch: unexpected shapes (n_in %d out %d ws %zu)\n", n_in, out_size, ws_size); grid_blocks = -1; return; }
        int dev = 0, cus = 0, per_cu = 0;
        hipGetDevice(&dev); hipDeviceGetAttribute(&cus, hipDeviceAttributeMultiprocessorCount, dev);
        if (hipFuncSetAttribute((const void*)yoco_mega, hipFuncAttributeMaxDynamicSharedMemorySize, LDS_TOTAL) != hipSuccess) { fprintf(stderr, "kernel_launch: hipFuncSetAttribute failed\n"); grid_blocks = -1; return; }
        if (hipOccupancyMaxActiveBlocksPerMultiprocessor(&per_cu, (const void*)yoco_mega, 512, LDS_TOTAL) != hipSuccess || per_cu < 1) { fprintf(stderr, "kernel_launch: occupancy query gave %d\n", per_cu); per_cu = 1; }
        (void)hipGetLastError();
        grid_blocks = cus >= 256 ? 256 : cus;
        if (grid_blocks != 256) { fprintf(stderr, "kernel_launch: built for a 256-CU device (found %d CUs)\n", cus); grid_blocks = -1; return; }
    }
    if (grid_blocks < 0) return;
    if (hipMemsetAsync((unsigned char*)d_ws + OFF_XBAR, 0, XCD_BAR_WORDS * 4, stream) != hipSuccess) { fprintf(stderr, "kernel_launch: memset of the barrier words failed\n"); return; }
    Params p{};
    for (int i = 0; i < 20; ++i) p.in[i] = (const float*)d_in[i];
    p.out = (float*)d_out; p.ws = (unsigned char*)d_ws;
    void* args[] = {&p};
    hipError_t e = hipLaunchCooperativeKernel((const void*)yoco_mega, dim3(grid_blocks), dim3(512), args, LDS_TOTAL, stream);
    if (e != hipSuccess) fprintf(stderr, "cooperative launch failed: %s (grid %d)\n", hipGetErrorString(e), grid_blocks);
}
```
